# Optimizing an MI355X kernel written in HIP

```python
import jax
import jax.numpy as jnp
from jax import lax
import numpy as np

D_MODEL = 1024
BATCH = 4
SEQ = 8192
DEPTH = 1

GM_GROUPS = 4
GM_DIM = 128
GM_WIDTH = GM_GROUPS * GM_DIM
GM_CHUNK = 128
GDN_HEADS = 4
GDN_DK = 128
GDN_DV = 128
GDN_QK_WIDTH = GDN_HEADS * GDN_DK
GDN_V_WIDTH = GDN_HEADS * GDN_DV
GDN_CONV = 4
GDN_CHUNK = 64
D_MIX = GM_WIDTH + GDN_V_WIDTH
IN_SPLITS = (GM_WIDTH, 2 * GM_WIDTH, 2 * GM_WIDTH + GDN_QK_WIDTH, 2 * GM_WIDTH + 2 * GDN_QK_WIDTH, 2 * GM_WIDTH + 2 * GDN_QK_WIDTH + GDN_V_WIDTH, 2 * GM_WIDTH + 2 * GDN_QK_WIDTH + 2 * GDN_V_WIDTH, 2 * GM_WIDTH + 2 * GDN_QK_WIDTH + 2 * GDN_V_WIDTH + GDN_HEADS)
IN_COLS = IN_SPLITS[-1] + GDN_HEADS
N_EXPERTS = 32
TOP_K = 4
D_FF = D_MODEL
SWIGLU_LIMIT = 7.0
SWIGLU_ALPHA = 1.702
MOE_BLOCK = 256
N_MOD = 6
EPS = 1e-6

kernel_name = 'hybrid_gmlp_gdn_moe_adaln'


def _rmsnorm(x, w):
    xf = x.astype(jnp.float32)
    y = xf * lax.rsqrt(jnp.mean(xf * xf, axis=-1, keepdims=True) + EPS)
    return y.astype(x.dtype) * w


def _l2norm(x):
    return x * lax.rsqrt(jnp.sum(x * x, axis=-1, keepdims=True) + EPS)


def _modulate(x, w, shift, scale):
    return _rmsnorm(x, w) * (1 + scale[:, None, :]) + shift[:, None, :]


def _chunked_gmlp(u, v, v_norm_w, w_spatial, b_spatial):
    bsz, seq = u.shape[:2]
    n_chunks = seq // GM_CHUNK
    u = jax.nn.gelu(u, approximate=False)
    v = _rmsnorm(jax.nn.gelu(v, approximate=False), v_norm_w)
    causal = jnp.tril(jnp.ones((GM_CHUNK, GM_CHUNK), dtype=bool))
    ws = jnp.where(causal[None], w_spatial, jnp.zeros_like(w_spatial))
    vc = v.reshape(bsz, n_chunks, GM_CHUNK, GM_GROUPS, GM_DIM)
    z = jnp.einsum('gts,bnsgd->bntgd', ws, vc) + b_spatial.T[None, None, :, :, None]
    return (u * z.reshape(bsz, seq, GM_GROUPS, GM_DIM)).reshape(bsz, seq, GM_WIDTH)


def _chunk_gated_delta(q, k, v, g, beta):
    bsz, seq, nh, dk = q.shape
    dv = v.shape[-1]
    n = seq // GDN_CHUNK

    def to_chunks(t):
        return t.reshape(bsz, n, GDN_CHUNK, nh, -1).transpose(0, 3, 1, 2, 4)

    q, k, v = to_chunks(q), to_chunks(k), to_chunks(v)
    gc = jnp.cumsum(g.reshape(bsz, n, GDN_CHUNK, nh).transpose(0, 3, 1, 2), axis=-1)
    beta = beta.reshape(bsz, n, GDN_CHUNK, nh).transpose(0, 3, 1, 2)[..., None]
    tri = jnp.tril(jnp.ones((GDN_CHUNK, GDN_CHUNK), dtype=bool))
    strict = jnp.tril(jnp.ones((GDN_CHUNK, GDN_CHUNK), dtype=bool), k=-1)
    decay = jnp.exp(jnp.where(tri, gc[..., :, None] - gc[..., None, :], -jnp.inf))
    kb = k * beta
    a_mat = jnp.where(strict, jnp.einsum('bhnid,bhnjd->bhnij', kb, k) * decay, 0.0)
    eye = jnp.eye(GDN_CHUNK, dtype=q.dtype)
    rhs = jnp.concatenate([v * beta, kb * jnp.exp(gc)[..., None]], axis=-1)
    sol = lax.linalg.triangular_solve(a_mat + eye, rhs, left_side=True, lower=True, unit_diagonal=True)
    u_c, w_c = sol[..., :dv], sol[..., dv:]
    qk = jnp.where(tri, jnp.einsum('bhnid,bhnjd->bhnij', q, k) * decay, 0.0)

    def step(state, xs):
        q_i, k_i, u_i, w_i, g_i, qk_i = xs
        v_new = u_i - jnp.einsum('bhcd,bhde->bhce', w_i, state)
        o_i = jnp.einsum('bhcd,bhde->bhce', q_i * jnp.exp(g_i)[..., None], state) + jnp.einsum('bhij,bhje->bhie', qk_i, v_new)
        g_last = g_i[..., -1]
        k_dec = k_i * jnp.exp(g_last[..., None] - g_i)[..., None]
        state = state * jnp.exp(g_last)[..., None, None] + jnp.einsum('bhcd,bhce->bhde', k_dec, v_new)
        return state, o_i

    def front(t):
        return jnp.moveaxis(t, 2, 0)

    state0 = jnp.zeros((bsz, nh, dk, dv), q.dtype)
    _, o = lax.scan(step, state0, (front(q), front(k), front(u_c), front(w_c), front(gc), front(qk)))
    return o.transpose(1, 0, 3, 2, 4).reshape(bsz, seq, nh, dv)


def _gated_deltanet(q, k, v, a, b, z, conv_w, a_log, dt_bias, o_norm_w):
    dtype = v.dtype
    bsz, seq, _ = q.shape
    qkv = jnp.concatenate([q, k, v], axis=-1)
    n_ch = qkv.shape[-1]
    qkv = lax.conv_general_dilated(qkv, conv_w[:, None, :], window_strides=(1,), padding=[(GDN_CONV - 1, 0)], dimension_numbers=('NWC', 'WIO', 'NWC'), feature_group_count=n_ch)
    qkv = jax.nn.silu(qkv).astype(jnp.float32)
    q, k, v = jnp.split(qkv, [GDN_QK_WIDTH, 2 * GDN_QK_WIDTH], axis=-1)
    q = _l2norm(q.reshape(bsz, seq, GDN_HEADS, GDN_DK)) * (GDN_DK ** -0.5)
    k = _l2norm(k.reshape(bsz, seq, GDN_HEADS, GDN_DK))
    v = v.reshape(bsz, seq, GDN_HEADS, GDN_DV)
    beta = jax.nn.sigmoid(b.astype(jnp.float32))
    g = -jnp.exp(a_log.astype(jnp.float32)) * jax.nn.softplus(a.astype(jnp.float32) + dt_bias.astype(jnp.float32))
    o = _chunk_gated_delta(q, k, v, g, beta).astype(dtype)
    o = _rmsnorm(o, o_norm_w) * jax.nn.silu(z.reshape(bsz, seq, GDN_HEADS, GDN_DV))
    return o.reshape(bsz, seq, GDN_V_WIDTH)


def _moe(h, w_router, b_router, w_gu, b_gu, w_down, b_down):
    bsz, seq, d = h.shape
    n_tok = bsz * seq
    hf = h.reshape(n_tok, d)
    logits = (hf @ w_router + b_router).astype(jnp.float32)
    top_val, top_idx = lax.top_k(logits, TOP_K)
    weights = jax.nn.softmax(top_val, axis=-1).astype(h.dtype)
    n_assign = n_tok * TOP_K
    e_flat = top_idx.reshape(-1)
    tok_flat = jnp.repeat(jnp.arange(n_tok, dtype=jnp.int32), TOP_K)
    w_flat = weights.reshape(-1)
    order = jnp.argsort(e_flat)
    e_sorted = e_flat[order]
    counts = jnp.bincount(e_flat, length=N_EXPERTS)
    padded = (counts + MOE_BLOCK - 1) // MOE_BLOCK * MOE_BLOCK
    start = jnp.cumsum(counts) - counts
    pad_end = jnp.cumsum(padded)
    pad_start = pad_end - padded
    dest = pad_start[e_sorted] + jnp.arange(n_assign, dtype=jnp.int32) - start[e_sorted]
    n_slots = n_assign + N_EXPERTS * MOE_BLOCK
    n_blocks = n_slots // MOE_BLOCK
    slot_tok = jnp.full((n_slots,), n_tok, jnp.int32).at[dest].set(tok_flat[order])
    slot_w = jnp.zeros((n_slots,), h.dtype).at[dest].set(w_flat[order])
    block_e = jnp.minimum(jnp.searchsorted(pad_end, jnp.arange(n_blocks, dtype=jnp.int32) * MOE_BLOCK, side='right'), N_EXPERTS - 1)
    h_pad = jnp.concatenate([hf, jnp.zeros((1, d), hf.dtype)], axis=0)

    def expert_block(args):
        tok, wt, e = args
        xb = h_pad[tok]
        gu = xb @ w_gu[e] + b_gu[e]
        gate = jnp.minimum(gu[:, :D_FF], SWIGLU_LIMIT)
        up = jnp.clip(gu[:, D_FF:], -SWIGLU_LIMIT, SWIGLU_LIMIT)
        act = gate * jax.nn.sigmoid(SWIGLU_ALPHA * gate) * (up + 1)
        return (act @ w_down[e] + b_down[e]) * wt[:, None]

    y = lax.map(expert_block, (slot_tok.reshape(n_blocks, MOE_BLOCK), slot_w.reshape(n_blocks, MOE_BLOCK), block_e))
    out = jax.ops.segment_sum(y.reshape(n_slots, d), slot_tok, num_segments=n_tok + 1)[:n_tok]
    return out.reshape(bsz, seq, d)


def setup_inputs(seed: int = 0) -> dict:
    key = jax.random.key(seed)
    ks = jax.random.split(key, 24)
    L, D = DEPTH, D_MODEL

    def nrm(k, shape, s):
        return s * jax.random.normal(k, shape, jnp.float32)

    return {
        'x': nrm(ks[0], (BATCH, SEQ, D), 1.0),
        'c': nrm(ks[1], (BATCH, D), 1.0),
        'w_ada': nrm(ks[2], (L, D, N_MOD * D), 0.5 * D ** -0.5),
        'b_ada': nrm(ks[3], (L, N_MOD * D), 0.02),
        'norm1_w': 1.0 + nrm(ks[4], (L, D), 0.05),
        'w_in': nrm(ks[5], (L, D, IN_COLS), D ** -0.5),
        'gm_vnorm_w': 1.0 + nrm(ks[6], (L, GM_GROUPS, GM_DIM), 0.05),
        'gm_w_spatial': nrm(ks[7], (L, GM_GROUPS, GM_CHUNK, GM_CHUNK), GM_CHUNK ** -0.5),
        'gm_b_spatial': 1.0 + nrm(ks[8], (L, GM_GROUPS, GM_CHUNK), 0.1),
        'gdn_conv_w': nrm(ks[9], (L, GDN_CONV, 2 * GDN_QK_WIDTH + GDN_V_WIDTH), GDN_CONV ** -0.5),
        'gdn_a_log': jnp.log(jax.random.uniform(ks[10], (L, GDN_HEADS), jnp.float32, 1.0, 16.0)),
        'gdn_dt_bias': jnp.log(jnp.expm1(jax.random.uniform(ks[11], (L, GDN_HEADS), jnp.float32, 1e-3, 1e-1))),
        'gdn_onorm_w': 1.0 + nrm(ks[12], (L, GDN_DV), 0.05),
        'w_out': nrm(ks[13], (L, D_MIX, D), D_MIX ** -0.5),
        'norm2_w': 1.0 + nrm(ks[14], (L, D), 0.05),
        'w_router': nrm(ks[15], (L, D, N_EXPERTS), D ** -0.5),
        'b_router': nrm(ks[16], (L, N_EXPERTS), 0.01),
        'w_gu': nrm(ks[17], (L, N_EXPERTS, D, 2 * D_FF), D ** -0.5),
        'b_gu': nrm(ks[18], (L, N_EXPERTS, 2 * D_FF), 0.02),
        'w_down': nrm(ks[19], (L, N_EXPERTS, D_FF, D), D_FF ** -0.5),
        'b_down': nrm(ks[20], (L, N_EXPERTS, D), 0.02),
        'norm_f_w': 1.0 + nrm(ks[21], (D,), 0.05),
    }


def reference(x, c, w_ada, b_ada, norm1_w, w_in, gm_vnorm_w, gm_w_spatial, gm_b_spatial, gdn_conv_w, gdn_a_log, gdn_dt_bias, gdn_onorm_w, w_out, norm2_w, w_router, b_router, w_gu, b_gu, w_down, b_down, norm_f_w):
    bsz, seq, _ = x.shape
    c_act = jax.nn.silu(c)
    for l in range(DEPTH):
        mod = c_act @ w_ada[l] + b_ada[l]
        sh1, sc1, g1, sh2, sc2, g2 = jnp.split(mod, N_MOD, axis=-1)
        h = _modulate(x, norm1_w[l], sh1, sc1)
        proj = h @ w_in[l]
        gm_u, gm_v, q, k, v, z, a, b = jnp.split(proj, IN_SPLITS, axis=-1)
        y_a = _chunked_gmlp(gm_u.reshape(bsz, seq, GM_GROUPS, GM_DIM), gm_v.reshape(bsz, seq, GM_GROUPS, GM_DIM), gm_vnorm_w[l], gm_w_spatial[l], gm_b_spatial[l])
        y_b = _gated_deltanet(q, k, v, a, b, z, gdn_conv_w[l], gdn_a_log[l], gdn_dt_bias[l], gdn_onorm_w[l])
        mix = jnp.concatenate([y_a, y_b], axis=-1) @ w_out[l]
        x = x + g1[:, None, :] * mix
        h = _modulate(x, norm2_w[l], sh2, sc2)
        x = x + g2[:, None, :] * _moe(h, w_router[l], b_router[l], w_gu[l], b_gu[l], w_down[l], b_down[l])
    return _rmsnorm(x, norm_f_w)
```

```cpp
#include <hip/hip_runtime.h>
#include <cstdio>
#include <cstdint>

#ifndef SINGLE_LAUNCH
#define SINGLE_LAUNCH 0
#endif
#if SINGLE_LAUNCH
#include <hip/hip_cooperative_groups.h>
namespace cg = cooperative_groups;
#endif

#define LAS __attribute__((address_space(3)))
typedef unsigned short bf16_t;
typedef short bf16x8 __attribute__((ext_vector_type(8)));
typedef float f32x4 __attribute__((ext_vector_type(4)));
typedef float f32x2 __attribute__((ext_vector_type(2)));
typedef unsigned u32x4 __attribute__((ext_vector_type(4)));
typedef unsigned u32x2 __attribute__((ext_vector_type(2)));

constexpr int DM = 1024, NB = 4, SEQ = 8192, NTOK = NB * SEQ;
constexpr int GM_G = 4, GM_D = 128, GM_W = 512, GM_C = 128;
constexpr int NH = 4, HD = 128, QKW = 512, VW = 512, CONVK = 4;
constexpr int IN_COLS = 3080, PROJ_N = 3072;
constexpr int NE = 32, TOPK = 4, DFF = 1024;
constexpr float EPS = 1e-6f;
constexpr int LIST_CAP = NTOK;
constexpr int MAX_SLOTS = NTOK * TOPK + NE * 256;

constexpr size_t MiB = 1u << 20;
constexpr size_t WS_CTL = 0;
constexpr size_t WS_MOD = 1 * MiB;
constexpr size_t WS_G = 2 * MiB;
constexpr size_t WS_BETA = 3 * MiB;
constexpr size_t WS_ROUTE = 4 * MiB;
constexpr size_t WS_LIST = 6 * MiB;
constexpr size_t WS_LOGITS = 10 * MiB;
constexpr size_t WS_WRT = 14 * MiB;
constexpr size_t WS_WOUTT = 16 * MiB;
constexpr size_t WS_WINT = 18 * MiB;
constexpr size_t WS_WGUT = 24 * MiB;
constexpr size_t WS_WDT = 152 * MiB;
constexpr size_t WS_X1 = 216 * MiB;
constexpr size_t WS_H = 344 * MiB;
constexpr size_t WS_PROJ = 408 * MiB;
constexpr size_t WS_MIXIN = 600 * MiB;
constexpr size_t WS_QN = 664 * MiB;
constexpr size_t WS_KN = 728 * MiB;
constexpr size_t WS_VN = 792 * MiB;
constexpr size_t WS_ORAW = 856 * MiB;
constexpr size_t WS_ACT = 408 * MiB;
constexpr size_t WS_Y = 680 * MiB;
constexpr size_t WS_END = 952 * MiB;

constexpr int LDS_BYTES = 147456;
constexpr int LDS_MISC = 131072;

__device__ __forceinline__ unsigned f2bf(float f) { unsigned u = __builtin_bit_cast(unsigned, f); return (u + 0x7fffu + ((u >> 16) & 1u)) >> 16; }
__device__ __forceinline__ unsigned pk2(float lo, float hi) { return f2bf(lo) | (f2bf(hi) << 16); }
__device__ __forceinline__ float bflo(unsigned w) { return __builtin_bit_cast(float, w << 16); }
__device__ __forceinline__ float bfhi(unsigned w) { return __builtin_bit_cast(float, w & 0xffff0000u); }
__device__ __forceinline__ float wave_sum(float v) {
#pragma unroll
    for (int o = 1; o < 64; o <<= 1) v += __shfl_xor(v, o);
    return v;
}
__device__ __forceinline__ float silu_f(float x) { return x / (1.f + __expf(-x)); }
__device__ __forceinline__ float sigmoid_f(float x) { return 1.f / (1.f + __expf(-x)); }

namespace pg8 {
constexpr int BM = 256, BK = 64, HALF = 128, HTB = HALF * BK * 2, STAGE_BYTES = 8 * HTB, NXCD = 8, WGM = 8, KD = 1024;
__host__ __device__ __forceinline__ int lds_byte(int r, int c) { const int st = (r >> 4) * 2 + (c >> 5), rr = r & 15, cc = c & 31, ob = rr * 64 + cc * 2; return st * 1024 + (ob ^ (((ob >> 9) & 1) << 5)); }
__host__ __device__ __forceinline__ void stage_rc(int b, int& R, int& C) { const int st = b / 1024, sb = b % 1024, swz = sb ^ (((sb >> 9) & 1) << 5); R = (st >> 1) * 16 + swz / 64; C = (st & 1) * 32 + (swz % 64) / 2; }
__host__ __device__ __forceinline__ int perm32(int rho) { const int n = rho >> 4, i = rho & 15; return 8 * (i >> 2) + 4 * n + (i & 3); }

struct Unit { const char* A; const char* B0; const char* B1; unsigned vA0[2], vA1[2]; int pm, pn, e; };

__device__ __forceinline__ bool tile_order(int i, int G, int c, int nM, int nN, int& pm, int& pn) {
    const int nwg = nM * nN; const long L = (long)i * G + c; if (L >= nwg) return false;
    int wgid = (int)L; { const int q = nwg / NXCD, r = nwg % NXCD, xcd = wgid % NXCD, off = wgid / NXCD; wgid = (xcd < r ? xcd * (q + 1) : r * (q + 1) + (xcd - r) * q) + off; }
    const int nig = WGM * nN, gid = wgid / nig, fm = gid * WGM, gsz = (nM - fm) < WGM ? (nM - fm) : WGM;
    pm = fm + ((wgid % nig) % gsz); pn = (wgid % nig) / gsz; return true;
}

__device__ __forceinline__ unsigned cvt_pk_bf16(float lo, float hi) { unsigned r; asm volatile("v_cvt_pk_bf16_f32 %0, %1, %2" : "=v"(r) : "v"(lo), "v"(hi)); return r; }
__device__ __forceinline__ f32x2 gelu_pk(f32x2 v) {
    const f32x2 av = __builtin_elementwise_abs(v), d = av * 0.2316418882f + 1.0f;
    f32x2 t; t.x = __builtin_amdgcn_rcpf(d.x); t.y = __builtin_amdgcn_rcpf(d.y);
    f32x2 q = t * 0.5307027145f + (-0.7265760135f); q = q * t + 0.7107068705f; q = q * t + (-0.142248368f); q = q * t + 0.127414796f; q = q * t;
    const f32x2 s = (v * v) * (-0.72134752044f);
    f32x2 e; e.x = __builtin_amdgcn_exp2f(s.x); e.y = __builtin_amdgcn_exp2f(s.y);
    const f32x2 m = v * (q * e), r = v - m;
    f32x2 o; o.x = v.x < 0.f ? m.x : r.x; o.y = v.y < 0.f ? m.y : r.y; return o;
}

template <class Epi, class Sched>
__device__ __forceinline__ void gemm_phase(LAS unsigned char* lds, const Sched& S, const Epi& E) {
    const int tid = threadIdx.x, wid = __builtin_amdgcn_readfirstlane(tid >> 6), lane = tid & 63, wr = wid >> 2, wc = wid & 3, fr = lane & 15, fq = lane >> 4;
    constexpr int K = KD, nt = K / BK;
    unsigned voffB[2];
#pragma unroll
    for (int i = 0; i < 2; ++i) { int R, C; stage_rc(tid * 16 + i * 8192, R, C); const int Rb = Epi::PERM ? ((R & ~31) + perm32(R & 31)) : R; voffB[i] = (unsigned)(Rb * K + C) * 2u; }
    const size_t kstep = (size_t)(BK * 2);
    const unsigned ldsw = (unsigned)wid * 1024u;
    const int aoff = lds_byte(wr * 64 + fr, fq * 8), boff = lds_byte(wc * 32 + fr, fq * 8);
#define PG8_SA(b, h) (((b) * 2 + (h)) * HTB)
#define PG8_SB(b, h) ((4 + (b) * 2 + (h)) * HTB)
#define PG8_STAGE(bufoff, gbase, voff) do { _Pragma("unroll") for (int _i = 0; _i < 2; ++_i) \
        __builtin_amdgcn_global_load_lds((const unsigned*)((const char*)(gbase) + (voff)[_i]), (LAS unsigned*)(lds + (bufoff) + ldsw + _i * 8192), 16, 0, 0); } while (0)
#define PG8_LDA(dst, b, h) do { _Pragma("unroll") for (int m = 0; m < 4; ++m) _Pragma("unroll") for (int k = 0; k < 2; ++k) dst[m][k] = *(const LAS bf16x8*)(lds + PG8_SA(b, h) + aoff + m * 2048 + k * 1024); } while (0)
#define PG8_LDB(dst, b, h) do { _Pragma("unroll") for (int n = 0; n < 2; ++n) _Pragma("unroll") for (int k = 0; k < 2; ++k) dst[n][k] = *(const LAS bf16x8*)(lds + PG8_SB(b, h) + boff + n * 2048 + k * 1024); } while (0)
#define PG8_MMA(ai, bj, At, Bt) do { __builtin_amdgcn_s_setprio(1); _Pragma("unroll") for (int m = 0; m < 4; ++m) _Pragma("unroll") for (int n = 0; n < 2; ++n) _Pragma("unroll") for (int k = 0; k < 2; ++k) \
        acc[ai][bj][m][n] = __builtin_amdgcn_mfma_f32_16x16x32_bf16(Bt[n][k], At[m][k], acc[ai][bj][m][n], 0, 0, 0); __builtin_amdgcn_s_setprio(0); } while (0)
#define PG8_WAIT_V(n) asm volatile("s_waitcnt vmcnt(" #n ")" ::: "memory")
#define PG8_WAIT_L(n) asm volatile("s_waitcnt lgkmcnt(" #n ")" ::: "memory")
#define PG8_BAR __builtin_amdgcn_s_barrier()
#define PG8_SCHED __builtin_amdgcn_sched_barrier(0)
    Unit cur, nxt; int ui = 0;
    if (!S.next(0, cur)) return;
    f32x4 acc[2][2][4][2];
#pragma unroll
    for (int a = 0; a < 2; ++a)
#pragma unroll
        for (int b = 0; b < 2; ++b)
#pragma unroll
            for (int m = 0; m < 4; ++m)
#pragma unroll
                for (int n = 0; n < 2; ++n) acc[a][b][m][n] = (f32x4){0.f, 0.f, 0.f, 0.f};
    bf16x8 At[4][2], B0[2][2], B1[2][2];
    PG8_STAGE(PG8_SB(0, 0), cur.B0, voffB); PG8_STAGE(PG8_SB(0, 1), cur.B1, voffB); PG8_STAGE(PG8_SA(0, 0), cur.A, cur.vA0); PG8_STAGE(PG8_SA(0, 1), cur.A, cur.vA1);
    if (wr == 1) PG8_BAR;
    PG8_WAIT_V(2); PG8_BAR;
    PG8_STAGE(PG8_SB(1, 0), cur.B0 + kstep, voffB); PG8_STAGE(PG8_SA(1, 0), cur.A + kstep, cur.vA0); PG8_STAGE(PG8_SB(1, 1), cur.B1 + kstep, voffB);
    PG8_WAIT_V(6); PG8_BAR;
    for (;;) {
        const bool has_next = S.next(ui + 1, nxt);
        for (int t = 0; t < nt; t += 2) {
            const bool last = (t == nt - 2);
            const bool fromn = last && has_next;
            const size_t ko = last ? 0 : (size_t)(t + 2) * kstep;
            const char* a2 = (fromn ? nxt.A : cur.A) + ko; const char* b20 = (fromn ? nxt.B0 : cur.B0) + ko; const char* b21 = (fromn ? nxt.B1 : cur.B1) + ko;
            unsigned w0[2], w1[2];
#pragma unroll
            for (int i = 0; i < 2; ++i) { w0[i] = fromn ? nxt.vA0[i] : cur.vA0[i]; w1[i] = fromn ? nxt.vA1[i] : cur.vA1[i]; }
            const char* a1 = cur.A + (size_t)(t + 1) * kstep;
            PG8_LDB(B0, 0, 0); PG8_LDB(B1, 0, 1); PG8_SCHED; PG8_LDA(At, 0, 0); PG8_STAGE(PG8_SA(1, 1), a1, cur.vA1);
            PG8_WAIT_V(8); PG8_WAIT_L(0); PG8_BAR; PG8_MMA(0, 0, At, B0); PG8_MMA(0, 1, At, B1); PG8_BAR; PG8_SCHED;
            PG8_LDA(At, 0, 1); PG8_STAGE(PG8_SB(0, 0), b20, voffB); PG8_STAGE(PG8_SB(0, 1), b21, voffB); PG8_STAGE(PG8_SA(0, 0), a2, w0);
            PG8_WAIT_V(8); PG8_WAIT_L(0); PG8_BAR; PG8_MMA(1, 0, At, B0); PG8_MMA(1, 1, At, B1); PG8_BAR; PG8_SCHED;
            PG8_LDB(B0, 1, 0); PG8_LDB(B1, 1, 1); PG8_SCHED; PG8_LDA(At, 1, 0); PG8_STAGE(PG8_SA(0, 1), a2, w1);
            PG8_WAIT_V(8); PG8_WAIT_L(0); PG8_BAR; PG8_MMA(0, 0, At, B0); PG8_MMA(0, 1, At, B1); PG8_BAR; PG8_SCHED;
            PG8_LDA(At, 1, 1); PG8_STAGE(PG8_SB(1, 0), b20 + kstep, voffB); PG8_STAGE(PG8_SB(1, 1), b21 + kstep, voffB); PG8_STAGE(PG8_SA(1, 0), a2 + kstep, w0);
            PG8_WAIT_V(8); PG8_WAIT_L(0); PG8_BAR; PG8_MMA(1, 0, At, B0); PG8_MMA(1, 1, At, B1); PG8_BAR; PG8_SCHED;
        }
        if (wr == 0) PG8_BAR;
        E(acc, cur, wr, wc, fr, fq);
        if (!has_next) break;
#pragma unroll
        for (int a = 0; a < 2; ++a)
#pragma unroll
            for (int b = 0; b < 2; ++b)
#pragma unroll
                for (int m = 0; m < 4; ++m)
#pragma unroll
                    for (int n = 0; n < 2; ++n) acc[a][b][m][n] = (f32x4){0.f, 0.f, 0.f, 0.f};
        cur = nxt; ++ui;
        if (wr == 1) PG8_BAR;
    }
    PG8_WAIT_V(0);
    PG8_BAR;
#undef PG8_SA
#undef PG8_SB
#undef PG8_STAGE
#undef PG8_LDA
#undef PG8_LDB
#undef PG8_MMA
#undef PG8_WAIT_V
#undef PG8_WAIT_L
#undef PG8_BAR
#undef PG8_SCHED
}

struct DenseSched {
    const char* A; const char* Bt; int nM, nN, G, c; int R[2], C[2];
    __device__ __forceinline__ void init(const void* A_, const void* Bt_, int M, int N, int G_, int c_) {
        A = (const char*)A_; Bt = (const char*)Bt_; nM = M / BM; nN = N / BM; G = G_; c = c_;
#pragma unroll
        for (int i = 0; i < 2; ++i) stage_rc((int)threadIdx.x * 16 + i * 8192, R[i], C[i]);
    }
    __device__ __forceinline__ bool next(int i, Unit& u) const {
        int pm, pn; if (!tile_order(i, G, c, nM, nN, pm, pn)) return false;
        u.pm = pm; u.pn = pn; u.e = 0; u.A = A; u.B0 = Bt + (size_t)pn * 256 * KD * 2; u.B1 = u.B0 + (size_t)128 * KD * 2;
#pragma unroll
        for (int i2 = 0; i2 < 2; ++i2) { u.vA0[i2] = (unsigned)(((pm * 256 + R[i2]) * KD + C[i2]) * 2); u.vA1[i2] = u.vA0[i2] + 128u * KD * 2u; }
        return true;
    }
};
struct MoeTab { const LAS int* tp; const LAS int* cnt; };
__device__ __forceinline__ int moe_find(const MoeTab& T, int pm) { int e = 0; while (e < NE - 1 && T.tp[e + 1] <= pm) ++e; return e; }
struct Moe1Sched {
    const char* A; const char* Bt; const int* list; MoeTab T; int nM, nN, G, c; int R[2], C[2];
    __device__ __forceinline__ void init(const void* A_, const void* Bt_, const int* list_, MoeTab T_, int nM_, int G_, int c_) {
        A = (const char*)A_; Bt = (const char*)Bt_; list = list_; T = T_; nM = nM_; nN = 8; G = G_; c = c_;
#pragma unroll
        for (int i = 0; i < 2; ++i) stage_rc((int)threadIdx.x * 16 + i * 8192, R[i], C[i]);
    }
    __device__ __forceinline__ bool next(int i, Unit& u) const {
        int pm, pn; if (!tile_order(i, G, c, nM, nN, pm, pn)) return false;
        const int e = moe_find(T, pm), ml = pm - T.tp[e], ce = T.cnt[e];
        u.pm = pm; u.pn = pn; u.e = e; u.A = A;
        u.B0 = Bt + ((size_t)e * 2048 + 128 * pn) * KD * 2; u.B1 = Bt + ((size_t)e * 2048 + 1024 + 128 * pn) * KD * 2;
#pragma unroll
        for (int i2 = 0; i2 < 2; ++i2) {
            const int i0 = ml * 256 + R[i2], i1 = i0 + 128;
            const int t0 = i0 < ce ? list[(size_t)e * LIST_CAP + i0] : 0, t1 = i1 < ce ? list[(size_t)e * LIST_CAP + i1] : 0;
            u.vA0[i2] = (unsigned)((t0 * KD + C[i2]) * 2); u.vA1[i2] = (unsigned)((t1 * KD + C[i2]) * 2);
        }
        asm volatile("" : "+v"(u.vA0[0]), "+v"(u.vA0[1]), "+v"(u.vA1[0]), "+v"(u.vA1[1]));
        return true;
    }
};
struct Moe2Sched {
    const char* A; const char* Bt; MoeTab T; int nM, nN, G, c; int R[2], C[2];
    __device__ __forceinline__ void init(const void* A_, const void* Bt_, MoeTab T_, int nM_, int G_, int c_) {
        A = (const char*)A_; Bt = (const char*)Bt_; T = T_; nM = nM_; nN = 4; G = G_; c = c_;
#pragma unroll
        for (int i = 0; i < 2; ++i) stage_rc((int)threadIdx.x * 16 + i * 8192, R[i], C[i]);
    }
    __device__ __forceinline__ bool next(int i, Unit& u) const {
        int pm, pn; if (!tile_order(i, G, c, nM, nN, pm, pn)) return false;
        const int e = moe_find(T, pm);
        u.pm = pm; u.pn = pn; u.e = e; u.A = A;
        u.B0 = Bt + ((size_t)e * 1024 + 256 * pn) * KD * 2; u.B1 = u.B0 + (size_t)128 * KD * 2;
#pragma unroll
        for (int i2 = 0; i2 < 2; ++i2) { u.vA0[i2] = (unsigned)(((pm * 256 + R[i2]) * KD + C[i2]) * 2); u.vA1[i2] = u.vA0[i2] + 128u * KD * 2u; }
        return true;
    }
};

struct EpiProj {
    static constexpr bool PERM = true;
    bf16_t* O;
    __device__ __forceinline__ void operator()(const f32x4 (&acc)[2][2][4][2], const Unit& u, int wr, int wc, int fr, int fq) const {
        const int row0 = u.pm * BM + wr * 64 + fr, col0 = u.pn * BM + wc * 32 + 8 * fq; const bool act = u.pn < 4;
#pragma unroll
        for (int ai = 0; ai < 2; ++ai)
#pragma unroll
            for (int m = 0; m < 4; ++m) { bf16_t* rowp = O + (size_t)(row0 + ai * HALF + m * 16) * PROJ_N + col0;
#pragma unroll
                for (int bj = 0; bj < 2; ++bj) { f32x4 v0 = acc[ai][bj][m][0], v1 = acc[ai][bj][m][1];
                    if (act) { f32x2 a = gelu_pk((f32x2){v0[0], v0[1]}), b = gelu_pk((f32x2){v0[2], v0[3]}), c = gelu_pk((f32x2){v1[0], v1[1]}), d = gelu_pk((f32x2){v1[2], v1[3]});
                        v0 = (f32x4){a.x, a.y, b.x, b.y}; v1 = (f32x4){c.x, c.y, d.x, d.y}; }
                    u32x4 w; w.x = cvt_pk_bf16(v0[0], v0[1]); w.y = cvt_pk_bf16(v0[2], v0[3]); w.z = cvt_pk_bf16(v1[0], v1[1]); w.w = cvt_pk_bf16(v1[2], v1[3]);
                    *(u32x4*)(rowp + bj * HALF) = w; } }
    }
};
struct EpiMix {
    static constexpr bool PERM = false;
    const float* x; const float* mod; float* X1;
    __device__ __forceinline__ void operator()(const f32x4 (&acc)[2][2][4][2], const Unit& u, int wr, int wc, int fr, int fq) const {
        const int row0 = u.pm * BM + wr * 64 + fr, col0 = u.pn * BM + wc * 32 + 4 * fq;
        const int b = (u.pm * BM) / SEQ; const float* g1 = mod + (size_t)b * 6 * DM + 2 * DM;
        f32x4 gv[2][2];
#pragma unroll
        for (int bj = 0; bj < 2; ++bj)
#pragma unroll
            for (int n = 0; n < 2; ++n) gv[bj][n] = *(const f32x4*)(g1 + col0 + bj * HALF + n * 16);
#pragma unroll
        for (int ai = 0; ai < 2; ++ai)
#pragma unroll
            for (int m = 0; m < 4; ++m) { const size_t off = (size_t)(row0 + ai * HALF + m * 16) * DM + col0;
#pragma unroll
                for (int bj = 0; bj < 2; ++bj)
#pragma unroll
                    for (int n = 0; n < 2; ++n) { const f32x4 xv = *(const f32x4*)(x + off + bj * HALF + n * 16); *(f32x4*)(X1 + off + bj * HALF + n * 16) = xv + gv[bj][n] * acc[ai][bj][m][n]; }
                asm volatile("" ::: "memory"); }
    }
};
struct EpiLogits {
    static constexpr bool PERM = false;
    const float* br; float* L;
    __device__ __forceinline__ void operator()(const f32x4 (&acc)[2][2][4][2], const Unit& u, int wr, int wc, int fr, int fq) const {
        if (wc != 0) return;
        const int row0 = u.pm * BM + wr * 64 + fr;
#pragma unroll
        for (int ai = 0; ai < 2; ++ai)
#pragma unroll
            for (int m = 0; m < 4; ++m)
#pragma unroll
                for (int n = 0; n < 2; ++n) { const int c = 16 * n + 4 * fq; const f32x4 bv = *(const f32x4*)(br + c);
                    *(f32x4*)(L + (size_t)(row0 + ai * HALF + m * 16) * NE + c) = acc[ai][0][m][n] + bv; }
    }
};
struct EpiAct {
    static constexpr bool PERM = true;
    const float* bgu; bf16_t* O;
    __device__ __forceinline__ void operator()(const f32x4 (&acc)[2][2][4][2], const Unit& u, int wr, int wc, int fr, int fq) const {
        const int row0 = u.pm * BM + wr * 64 + fr, f0 = u.pn * 128 + wc * 32 + 8 * fq;
        const float* bg = bgu + (size_t)u.e * 2048 + f0; const float* bu = bg + 1024;
        const f32x4 bg0 = *(const f32x4*)bg, bg1 = *(const f32x4*)(bg + 4), bu0 = *(const f32x4*)bu, bu1 = *(const f32x4*)(bu + 4);
#pragma unroll
        for (int ai = 0; ai < 2; ++ai)
#pragma unroll
            for (int m = 0; m < 4; ++m) {
                float r[8];
#pragma unroll
                for (int n = 0; n < 2; ++n)
#pragma unroll
                    for (int j = 0; j < 4; ++j) {
                        float g = acc[ai][0][m][n][j] + (n ? bg1[j] : bg0[j]), up = acc[ai][1][m][n][j] + (n ? bu1[j] : bu0[j]);
                        g = fminf(g, 7.0f); up = fminf(fmaxf(up, -7.0f), 7.0f);
                        r[n * 4 + j] = g * sigmoid_f(1.702f * g) * (up + 1.0f);
                    }
                u32x4 w; w.x = cvt_pk_bf16(r[0], r[1]); w.y = cvt_pk_bf16(r[2], r[3]); w.z = cvt_pk_bf16(r[4], r[5]); w.w = cvt_pk_bf16(r[6], r[7]);
                *(u32x4*)(O + (size_t)(row0 + ai * HALF + m * 16) * DFF + f0) = w;
            }
    }
};
struct EpiY {
    static constexpr bool PERM = true;
    const float* bd; bf16_t* O;
    __device__ __forceinline__ void operator()(const f32x4 (&acc)[2][2][4][2], const Unit& u, int wr, int wc, int fr, int fq) const {
        const int row0 = u.pm * BM + wr * 64 + fr, col0 = u.pn * BM + wc * 32 + 8 * fq;
        const float* b = bd + (size_t)u.e * DM + col0;
        f32x4 bv[2][2];
#pragma unroll
        for (int bj = 0; bj < 2; ++bj)
#pragma unroll
            for (int n = 0; n < 2; ++n) bv[bj][n] = *(const f32x4*)(b + bj * HALF + 4 * n);
#pragma unroll
        for (int ai = 0; ai < 2; ++ai)
#pragma unroll
            for (int m = 0; m < 4; ++m) { bf16_t* rowp = O + (size_t)(row0 + ai * HALF + m * 16) * DM + col0;
#pragma unroll
                for (int bj = 0; bj < 2; ++bj) { const f32x4 v0 = acc[ai][bj][m][0] + bv[bj][0], v1 = acc[ai][bj][m][1] + bv[bj][1];
                    u32x4 w; w.x = cvt_pk_bf16(v0[0], v0[1]); w.y = cvt_pk_bf16(v0[2], v0[3]); w.z = cvt_pk_bf16(v1[0], v1[1]); w.w = cvt_pk_bf16(v1[2], v1[3]);
                    *(u32x4*)(rowp + bj * HALF) = w; } }
    }
};
}

struct Args {
    const float *x, *c, *w_ada, *b_ada, *norm1_w, *w_in, *gm_vnorm_w, *gm_w_spatial, *gm_b_spatial, *gdn_conv_w, *gdn_a_log, *gdn_dt_bias, *gdn_onorm_w,
        *w_out, *norm2_w, *w_router, *b_router, *w_gu, *b_gu, *w_down, *b_down, *norm_f_w;
    float* out; unsigned char* ws; int ph_lo, ph_hi;
};

struct Ctx { LAS unsigned char* lds; int tid, lane, wave, G, bid; };

__device__ __forceinline__ void transpose_item(const float* W, int ld, bf16_t* WT, int Kp, int k0, int n0, int row_off, LAS float* scr, int lane) {
#pragma unroll 8
    for (int i = 0; i < 32; ++i) { const int kk = 2 * i + (lane >> 5); scr[kk * 33 + (lane & 31)] = W[(size_t)(k0 + kk) * ld + n0 + (lane & 31)]; }
    asm volatile("s_waitcnt lgkmcnt(0)" ::: "memory");
    const int c = lane & 7;
#pragma unroll
    for (int j = 0; j < 4; ++j) { const int n = (lane >> 3) + 8 * j; const LAS float* s = scr + (8 * c) * 33 + n;
        u32x4 o; o.x = pk2(s[0 * 33], s[1 * 33]); o.y = pk2(s[2 * 33], s[3 * 33]); o.z = pk2(s[4 * 33], s[5 * 33]); o.w = pk2(s[6 * 33], s[7 * 33]);
        *(u32x4*)(WT + (size_t)(row_off + n0 + n) * Kp + k0 + 8 * c) = o; }
    asm volatile("s_waitcnt lgkmcnt(0)" ::: "memory");
}

__device__ __forceinline__ void phase_prep0(const Args& a, const Ctx& X) {
    unsigned char* ws = a.ws;
    {
        LAS float* cact = (LAS float*)X.lds;
        LAS f32x4* part = (LAS f32x4*)(X.lds + 16384);
        for (int i = X.tid; i < NB * DM; i += 512) cact[i] = silu_f(a.c[i]);
        __syncthreads();
        float* mod = (float*)(ws + WS_MOD);
        for (int cgp = X.bid; cgp < 256; cgp += X.G) {
            const int j0 = 24 * cgp;
            if (X.tid < 384) {
                const int q = X.tid % 6, kc = X.tid / 6;
                f32x4 s[4] = {{0, 0, 0, 0}, {0, 0, 0, 0}, {0, 0, 0, 0}, {0, 0, 0, 0}};
#pragma unroll 4
                for (int kk = 0; kk < 16; ++kk) { const int k = kc * 16 + kk; const f32x4 w = *(const f32x4*)(a.w_ada + (size_t)k * 6144 + j0 + 4 * q);
#pragma unroll
                    for (int b = 0; b < 4; ++b) s[b] += w * cact[b * DM + k]; }
#pragma unroll
                for (int b = 0; b < 4; ++b) part[(kc * 4 + b) * 6 + q] = s[b];
            }
            __syncthreads();
            if (X.tid < 96) { const int b = X.tid / 24, col = X.tid % 24; float s = 0.f;
                for (int kc = 0; kc < 64; ++kc) s += part[(kc * 4 + b) * 6 + (col >> 2)][col & 3];
                mod[b * 6144 + j0 + col] = s + a.b_ada[j0 + col]; }
            __syncthreads();
        }
    }
    {
        LAS float* scr = (LAS float*)(X.lds + X.wave * 16384);
        const int gw = X.bid * 8 + X.wave, NGW = X.G * 8;
        bf16_t* WinT = (bf16_t*)(ws + WS_WINT); bf16_t* WoutT = (bf16_t*)(ws + WS_WOUTT); bf16_t* WrT = (bf16_t*)(ws + WS_WRT);
        bf16_t* WguT = (bf16_t*)(ws + WS_WGUT); bf16_t* WdT = (bf16_t*)(ws + WS_WDT);
        constexpr int I_IN = 16 * 96, I_OUT = 16 * 32, I_R = 16, I_GU = 32 * 16 * 64, I_D = 32 * 16 * 32;
        constexpr int NITEMS = I_IN + I_OUT + I_R + I_GU + I_D;
        for (int it = gw; it < NITEMS; it += NGW) {
            int r = it;
            if (r < I_IN) { transpose_item(a.w_in, IN_COLS, WinT, DM, 64 * (r / 96), 32 * (r % 96), 0, scr, X.lane); continue; } r -= I_IN;
            if (r < I_OUT) { transpose_item(a.w_out, DM, WoutT, DM, 64 * (r / 32), 32 * (r % 32), 0, scr, X.lane); continue; } r -= I_OUT;
            if (r < I_R) { transpose_item(a.w_router, NE, WrT, DM, 64 * r, 0, 0, scr, X.lane); continue; } r -= I_R;
            if (r < I_GU) { const int e = r / 1024, q = r % 1024; transpose_item(a.w_gu + (size_t)e * DM * 2048, 2048, WguT + (size_t)e * 2048 * DM, DM, 64 * (q / 64), 32 * (q % 64), 0, scr, X.lane); continue; } r -= I_GU;
            { const int e = r / 512, q = r % 512; transpose_item(a.w_down + (size_t)e * DFF * DM, DM, WdT + (size_t)e * DM * DFF, DFF, 64 * (q / 32), 32 * (q % 32), 0, scr, X.lane); }
        }
        u32x4* z = (u32x4*)(WrT + 32 * DM); const int nz = 224 * DM * 2 / 16;
        for (int i = X.bid * 512 + X.tid; i < nz; i += X.G * 512) z[i] = (u32x4){0u, 0u, 0u, 0u};
    }
}

template <bool AB>
__device__ __forceinline__ void phase_rows(const Args& a, const Ctx& X, const float* src, const float* nw, int sh_idx, int sc_idx, bf16_t* dst) {
    unsigned char* ws = a.ws; const float* mod = (const float*)(ws + WS_MOD);
    LAS float* scl = (LAS float*)X.lds;
    LAS float* shf = scl + 4 * DM;
    LAS float* w8 = shf + 4 * DM;
    for (int i = X.tid; i < NB * DM; i += 512) { const int b = i >> 10, k = i & 1023; scl[i] = nw[k] * (1.f + mod[b * 6144 + sc_idx * DM + k]); shf[i] = mod[b * 6144 + sh_idx * DM + k]; }
    if (AB) for (int i = X.tid; i < DM * 8; i += 512) w8[i] = a.w_in[(size_t)(i >> 3) * IN_COLS + PROJ_N + (i & 7)];
    __syncthreads();
    float* G = (float*)(ws + WS_G); float* BT = (float*)(ws + WS_BETA);
    const int gw = X.bid * 8 + X.wave, NGW = X.G * 8;
    for (int m = gw; m < NTOK; m += NGW) {
        const int b = m / SEQ;
        const f32x4* xr = (const f32x4*)(src + (size_t)m * DM) + X.lane;
        f32x4 v[4]; float ss = 0.f;
#pragma unroll
        for (int j = 0; j < 4; ++j) { v[j] = xr[64 * j]; ss += (v[j].x * v[j].x + v[j].y * v[j].y) + (v[j].z * v[j].z + v[j].w * v[j].w); }
        const float rstd = 1.0f / sqrtf(wave_sum(ss) * (1.f / DM) + EPS);
        float ab[8] = {0, 0, 0, 0, 0, 0, 0, 0};
        unsigned long long* o8 = (unsigned long long*)(dst + (size_t)m * DM) + X.lane;
#pragma unroll
        for (int j = 0; j < 4; ++j) {
            const int k0 = 4 * X.lane + 256 * j;
            const f32x4 sc = *(const LAS f32x4*)(scl + b * DM + k0), sf = *(const LAS f32x4*)(shf + b * DM + k0);
            const f32x4 h = v[j] * rstd * sc + sf;
            o8[64 * j] = (unsigned long long)pk2(h.x, h.y) | ((unsigned long long)pk2(h.z, h.w) << 32);
            if (AB) {
#pragma unroll
                for (int e = 0; e < 4; ++e) { const f32x4 wa = *(const LAS f32x4*)(w8 + (k0 + e) * 8), wb = *(const LAS f32x4*)(w8 + (k0 + e) * 8 + 4);
                    ab[0] += h[e] * wa.x; ab[1] += h[e] * wa.y; ab[2] += h[e] * wa.z; ab[3] += h[e] * wa.w; ab[4] += h[e] * wb.x; ab[5] += h[e] * wb.y; ab[6] += h[e] * wb.z; ab[7] += h[e] * wb.w; }
            }
        }
        if (AB) {
#pragma unroll
            for (int e = 0; e < 8; ++e) ab[e] = wave_sum(ab[e]);
            if (X.lane < 4) { const int hh = X.lane; const float av = (hh == 0 ? ab[0] : hh == 1 ? ab[1] : hh == 2 ? ab[2] : ab[3]) + a.gdn_dt_bias[hh];
                const float sp = av > 20.f ? av : log1pf(__expf(av)); G[(size_t)m * 4 + hh] = -__expf(a.gdn_a_log[hh]) * sp; }
            else if (X.lane < 8) { const int hh = X.lane - 4; const float bv = (hh == 0 ? ab[4] : hh == 1 ? ab[5] : hh == 2 ? ab[6] : ab[7]); BT[(size_t)m * 4 + hh] = sigmoid_f(bv); }
        }
    }
}

__device__ __forceinline__ void phase_gmlp(const Args& a, const Ctx& X) {
    unsigned char* ws = a.ws; const bf16_t* P = (const bf16_t*)(ws + WS_PROJ); bf16_t* MIX = (bf16_t*)(ws + WS_MIXIN);
    LAS float* Wf = (LAS float*)X.lds;
    LAS float* Vn = Wf + 128 * 129;
    const int t = X.tid >> 2, dp = X.tid & 3;
    for (int it = X.bid; it < NB * 64 * GM_G; it += X.G) {
        const int g = it & 3, n = (it >> 2) & 63, b = it >> 8;
        const size_t row0 = (size_t)b * SEQ + (size_t)n * GM_C;
        __syncthreads();
        for (int i = X.tid; i < 128 * 128; i += 512) { const int tt = i >> 7, s = i & 127; Wf[tt * 129 + s] = s <= tt ? a.gm_w_spatial[(size_t)g * 16384 + i] : 0.f; }
        {
            const u32x4* vp = (const u32x4*)(P + (row0 + t) * PROJ_N + GM_W + g * GM_D + dp * 32);
            float f[32]; float ss = 0.f;
#pragma unroll
            for (int q = 0; q < 4; ++q) { const u32x4 w = vp[q]; const unsigned ww[4] = {w.x, w.y, w.z, w.w};
#pragma unroll
                for (int j = 0; j < 4; ++j) { f[q * 8 + 2 * j] = bflo(ww[j]); f[q * 8 + 2 * j + 1] = bfhi(ww[j]); } }
#pragma unroll
            for (int j = 0; j < 32; ++j) ss += f[j] * f[j];
            ss += __shfl_xor(ss, 1); ss += __shfl_xor(ss, 2);
            const float rstd = 1.0f / sqrtf(ss * (1.f / GM_D) + EPS);
#pragma unroll
            for (int j = 0; j < 32; ++j) Vn[t * 128 + dp * 32 + j] = f[j] * rstd * a.gm_vnorm_w[g * GM_D + dp * 32 + j];
        }
        __syncthreads();
        float acc[32];
#pragma unroll
        for (int j = 0; j < 32; ++j) acc[j] = 0.f;
        const int tmax = (X.tid | 63) >> 2;
        for (int s = 0; s <= tmax; ++s) {
            const float w = Wf[t * 129 + s];
            const LAS f32x4* vr = (const LAS f32x4*)(Vn + s * 128 + dp * 32);
#pragma unroll
            for (int q = 0; q < 8; ++q) { const f32x4 vv = vr[q]; acc[4 * q] += w * vv.x; acc[4 * q + 1] += w * vv.y; acc[4 * q + 2] += w * vv.z; acc[4 * q + 3] += w * vv.w; }
        }
        const float bs = a.gm_b_spatial[g * GM_C + t];
        const u32x4* up = (const u32x4*)(P + (row0 + t) * PROJ_N + g * GM_D + dp * 32);
        u32x4* op = (u32x4*)(MIX + (row0 + t) * DM + g * GM_D + dp * 32);
#pragma unroll
        for (int q = 0; q < 4; ++q) { const u32x4 w = up[q]; const unsigned ww[4] = {w.x, w.y, w.z, w.w}; unsigned r[4];
#pragma unroll
            for (int j = 0; j < 4; ++j) r[j] = pk2(bflo(ww[j]) * (acc[q * 8 + 2 * j] + bs), bfhi(ww[j]) * (acc[q * 8 + 2 * j + 1] + bs));
            op[q] = (u32x4){r[0], r[1], r[2], r[3]}; }
    }
}

__device__ __forceinline__ void phase_conv(const Args& a, const Ctx& X) {
    unsigned char* ws = a.ws; const bf16_t* P = (const bf16_t*)(ws + WS_PROJ);
    float* QN = (float*)(ws + WS_QN); float* KN = (float*)(ws + WS_KN); float* VN = (float*)(ws + WS_VN);
    const int gw = X.bid * 8 + X.wave, NGW = X.G * 8;
    for (int m = gw; m < NTOK; m += NGW) {
        const int tpos = m % SEQ;
#pragma unroll
        for (int seg = 0; seg < 3; ++seg) {
            const int ch = seg * 512 + 8 * X.lane;
            float acc[8] = {0, 0, 0, 0, 0, 0, 0, 0};
#pragma unroll
            for (int j = 0; j < CONVK; ++j) {
                const int tt = tpos - 3 + j;
                if (tt >= 0) {
                    const u32x4 w = *(const u32x4*)(P + (size_t)(m - 3 + j) * PROJ_N + 1024 + ch); const unsigned ww[4] = {w.x, w.y, w.z, w.w};
                    const f32x4 c0 = *(const f32x4*)(a.gdn_conv_w + (size_t)j * 1536 + ch), c1 = *(const f32x4*)(a.gdn_conv_w + (size_t)j * 1536 + ch + 4);
                    acc[0] += c0.x * bflo(ww[0]); acc[1] += c0.y * bfhi(ww[0]); acc[2] += c0.z * bflo(ww[1]); acc[3] += c0.w * bfhi(ww[1]);
                    acc[4] += c1.x * bflo(ww[2]); acc[5] += c1.y * bfhi(ww[2]); acc[6] += c1.z * bflo(ww[3]); acc[7] += c1.w * bfhi(ww[3]);
                }
            }
            float ss = 0.f;
#pragma unroll
            for (int j = 0; j < 8; ++j) { acc[j] = silu_f(acc[j]); ss += acc[j] * acc[j]; }
            float* dstp;
            if (seg < 2) {
                ss += __shfl_xor(ss, 1); ss += __shfl_xor(ss, 2); ss += __shfl_xor(ss, 4); ss += __shfl_xor(ss, 8);
                float sc = 1.0f / sqrtf(ss + EPS); if (seg == 0) sc *= 0.08838834764831845f;
#pragma unroll
                for (int j = 0; j < 8; ++j) acc[j] *= sc;
                dstp = (seg == 0 ? QN : KN) + (size_t)m * 512 + 8 * X.lane;
            } else dstp = VN + (size_t)m * 512 + 8 * X.lane;
            *(f32x4*)dstp = (f32x4){acc[0], acc[1], acc[2], acc[3]}; *(f32x4*)(dstp + 4) = (f32x4){acc[4], acc[5], acc[6], acc[7]};
        }
    }
}

__device__ __forceinline__ void phase_scan_naive(const Args& a, const Ctx& X) {
    unsigned char* ws = a.ws;
    const float* QN = (const float*)(ws + WS_QN); const float* KN = (const float*)(ws + WS_KN); const float* VN = (const float*)(ws + WS_VN);
    const float* G = (const float*)(ws + WS_G); const float* BT = (const float*)(ws + WS_BETA); float* OR = (float*)(ws + WS_ORAW);
    constexpr int TT = 16;
    LAS float* kq = (LAS float*)X.lds;
    LAS float* gb = kq + 4 * TT * 256;
    const int hh = X.tid >> 7, e = X.tid & 127;
    for (int b = X.bid; b < NB; b += X.G) {
        float s[128];
#pragma unroll
        for (int d = 0; d < 128; ++d) s[d] = 0.f;
        for (int t0 = 0; t0 < SEQ; t0 += TT) {
            __syncthreads();
            for (int i = X.tid; i < 4 * TT * 256; i += 512) { const int h2 = i / (TT * 256), r = i % (TT * 256), tt = r >> 8, d = r & 255; const size_t m = (size_t)b * SEQ + t0 + tt;
                kq[i] = d < 128 ? KN[m * 512 + h2 * 128 + d] : QN[m * 512 + h2 * 128 + d - 128]; }
            if (X.tid < TT * 8) { const int tt = X.tid >> 3, j = X.tid & 7; const size_t m = (size_t)b * SEQ + t0 + tt; gb[X.tid] = j < 4 ? G[m * 4 + j] : BT[m * 4 + j - 4]; }
            __syncthreads();
            for (int tt = 0; tt < TT; ++tt) {
                const size_t m = (size_t)b * SEQ + t0 + tt;
                const float alpha = __expf(gb[tt * 8 + hh]), beta = gb[tt * 8 + 4 + hh];
                const float vv = VN[m * 512 + hh * 128 + e];
                const LAS f32x4* kp = (const LAS f32x4*)(kq + (hh * TT + tt) * 256);
                float dot = 0.f;
#pragma unroll
                for (int q = 0; q < 32; ++q) { const f32x4 kk = kp[q]; dot += kk.x * s[4 * q] + kk.y * s[4 * q + 1] + kk.z * s[4 * q + 2] + kk.w * s[4 * q + 3]; if ((q & 3) == 3) asm volatile("" ::: "memory"); }
                const float vn = beta * (vv - alpha * dot);
                float o = 0.f;
#pragma unroll
                for (int q = 0; q < 32; ++q) { const f32x4 kk = kp[q], qq = kp[32 + q];
                    s[4 * q] = alpha * s[4 * q] + kk.x * vn; s[4 * q + 1] = alpha * s[4 * q + 1] + kk.y * vn; s[4 * q + 2] = alpha * s[4 * q + 2] + kk.z * vn; s[4 * q + 3] = alpha * s[4 * q + 3] + kk.w * vn;
                    o += qq.x * s[4 * q] + qq.y * s[4 * q + 1] + qq.z * s[4 * q + 2] + qq.w * s[4 * q + 3]; if ((q & 3) == 3) asm volatile("" ::: "memory"); }
                OR[m * 512 + hh * 128 + e] = o;
            }
        }
    }
}

__device__ __forceinline__ void phase_onorm(const Args& a, const Ctx& X) {
    unsigned char* ws = a.ws; const bf16_t* P = (const bf16_t*)(ws + WS_PROJ); bf16_t* MIX = (bf16_t*)(ws + WS_MIXIN); const float* OR = (const float*)(ws + WS_ORAW);
    const int gw = X.bid * 8 + X.wave, NGW = X.G * 8;
    for (int m = gw; m < NTOK; m += NGW) {
        const f32x4 o0 = *(const f32x4*)(OR + (size_t)m * 512 + 8 * X.lane), o1 = *(const f32x4*)(OR + (size_t)m * 512 + 8 * X.lane + 4);
        float o[8] = {o0.x, o0.y, o0.z, o0.w, o1.x, o1.y, o1.z, o1.w}; float ss = 0.f;
#pragma unroll
        for (int j = 0; j < 8; ++j) ss += o[j] * o[j];
        ss += __shfl_xor(ss, 1); ss += __shfl_xor(ss, 2); ss += __shfl_xor(ss, 4); ss += __shfl_xor(ss, 8);
        const float rstd = 1.0f / sqrtf(ss * (1.f / HD) + EPS);
        const u32x4 zw = *(const u32x4*)(P + (size_t)m * PROJ_N + 2560 + 8 * X.lane); const unsigned zz[4] = {zw.x, zw.y, zw.z, zw.w};
        const int d0 = (8 * X.lane) & 127;
        float r[8];
#pragma unroll
        for (int j = 0; j < 8; ++j) { const float z = (j & 1) ? bfhi(zz[j >> 1]) : bflo(zz[j >> 1]); r[j] = o[j] * rstd * a.gdn_onorm_w[d0 + j] * silu_f(z); }
        *(u32x4*)(MIX + (size_t)m * DM + 512 + 8 * X.lane) = (u32x4){pk2(r[0], r[1]), pk2(r[2], r[3]), pk2(r[4], r[5]), pk2(r[6], r[7])};
    }
}

__device__ __forceinline__ void phase_route(const Args& a, const Ctx& X) {
    unsigned char* ws = a.ws; const float* L = (const float*)(ws + WS_LOGITS); int* cnt = (int*)(ws + WS_CTL); int* list = (int*)(ws + WS_LIST); int* route = (int*)(ws + WS_ROUTE);
    for (int m = X.bid * 512 + X.tid; m < NTOK; m += X.G * 512) {
        float v[32];
#pragma unroll
        for (int q = 0; q < 8; ++q) { const f32x4 t = *(const f32x4*)(L + (size_t)m * NE + 4 * q); v[4 * q] = t.x; v[4 * q + 1] = t.y; v[4 * q + 2] = t.z; v[4 * q + 3] = t.w; }
        int ei[4]; float ev[4];
#pragma unroll
        for (int k = 0; k < 4; ++k) {
            float best = -INFINITY; int bi = 0;
#pragma unroll
            for (int j = 0; j < 32; ++j) { if (v[j] > best) { best = v[j]; bi = j; } }
            ei[k] = bi; ev[k] = best;
#pragma unroll
            for (int j = 0; j < 32; ++j) if (j == bi) v[j] = -INFINITY;
        }
        float w[4]; float sum = 0.f;
#pragma unroll
        for (int k = 0; k < 4; ++k) { w[k] = __expf(ev[k] - ev[0]); sum += w[k]; }
        const float inv = 1.0f / sum;
#pragma unroll
        for (int k = 0; k < 4; ++k) {
            const int rank = atomicAdd(cnt + ei[k], 1);
            list[(size_t)ei[k] * LIST_CAP + rank] = m;
            route[(size_t)m * 12 + k] = ei[k]; route[(size_t)m * 12 + 4 + k] = rank; ((float*)route)[(size_t)m * 12 + 8 + k] = w[k] * inv;
        }
    }
}

__device__ __forceinline__ int moe_tables(const Args& a, const Ctx& X, pg8::MoeTab& T) {
    LAS int* tp = (LAS int*)(X.lds + LDS_MISC); LAS int* cn = (LAS int*)(X.lds + LDS_MISC + 256);
    const int* cnt = (const int*)(a.ws + WS_CTL);
    __syncthreads();
    if (X.tid == 0) { int acc = 0; for (int e = 0; e < NE; ++e) { const int c = cnt[e]; cn[e] = c; tp[e] = acc; acc += (c + 255) >> 8; } tp[NE] = acc; }
    __syncthreads();
    T.tp = tp; T.cnt = cn;
    return tp[NE];
}

__device__ __forceinline__ void phase_combine(const Args& a, const Ctx& X) {
    unsigned char* ws = a.ws; pg8::MoeTab T; (void)moe_tables(a, X, T);
    const float* X1 = (const float*)(ws + WS_X1); const bf16_t* Y = (const bf16_t*)(ws + WS_Y); const int* route = (const int*)(ws + WS_ROUTE); const float* mod = (const float*)(ws + WS_MOD);
    const int gw = X.bid * 8 + X.wave, NGW = X.G * 8;
    for (int m = gw; m < NTOK; m += NGW) {
        const int b = m / SEQ;
        f32x4 acc[4] = {{0, 0, 0, 0}, {0, 0, 0, 0}, {0, 0, 0, 0}, {0, 0, 0, 0}};
#pragma unroll
        for (int k = 0; k < 4; ++k) {
            const int e = route[(size_t)m * 12 + k], rank = route[(size_t)m * 12 + 4 + k]; const float w = ((const float*)route)[(size_t)m * 12 + 8 + k];
            const size_t slot = (size_t)T.tp[e] * 256 + rank;
            const u32x2* yp = (const u32x2*)(Y + slot * DM) + X.lane;
#pragma unroll
            for (int j = 0; j < 4; ++j) { const u32x2 t = yp[64 * j]; acc[j].x += w * bflo(t.x); acc[j].y += w * bfhi(t.x); acc[j].z += w * bflo(t.y); acc[j].w += w * bfhi(t.y); }
        }
        const f32x4* xr = (const f32x4*)(X1 + (size_t)m * DM) + X.lane;
        const f32x4* g2 = (const f32x4*)(mod + (size_t)b * 6144 + 5 * DM) + X.lane;
        f32x4 v[4]; float ss = 0.f;
#pragma unroll
        for (int j = 0; j < 4; ++j) { v[j] = xr[64 * j] + g2[64 * j] * acc[j]; ss += (v[j].x * v[j].x + v[j].y * v[j].y) + (v[j].z * v[j].z + v[j].w * v[j].w); }
        const float rstd = 1.0f / sqrtf(wave_sum(ss) * (1.f / DM) + EPS);
        f32x4* orow = (f32x4*)(a.out + (size_t)m * DM) + X.lane; const f32x4* nf = (const f32x4*)a.norm_f_w + X.lane;
#pragma unroll
        for (int j = 0; j < 4; ++j) orow[64 * j] = v[j] * rstd * nf[64 * j];
    }
}

enum { PH_PREP0 = 0, PH_ROWS1, PH_PROJ, PH_GMLP, PH_CONV, PH_SCAN, PH_ONORM, PH_MIX, PH_ROWS2, PH_ROUTER, PH_ROUTE, PH_MOE1, PH_MOE2, PH_COMBINE, PH_COUNT };

__global__ void __launch_bounds__(512, 2) mega(Args a) {
    extern __shared__ __attribute__((aligned(16))) unsigned char lds_raw[];
    Ctx X; X.lds = (LAS unsigned char*)lds_raw; X.tid = threadIdx.x; X.lane = X.tid & 63; X.wave = __builtin_amdgcn_readfirstlane(X.tid >> 6); X.G = gridDim.x; X.bid = blockIdx.x;
    unsigned char* ws = a.ws;
#if SINGLE_LAUNCH
    cg::grid_group grid = cg::this_grid();
#define SEAM(k) do { if (a.ph_lo <= (k) && (k) + 1 < a.ph_hi) grid.sync(); } while (0)
#else
#define SEAM(k) do { } while (0)
#endif
#ifndef PHMASK
#define PHMASK 0xffffffffu
#endif
#define IN(k) (((PHMASK >> (k)) & 1u) && a.ph_lo <= (k) && (k) < a.ph_hi)
    if (IN(PH_PREP0)) { phase_prep0(a, X); SEAM(PH_PREP0); }
    if (IN(PH_ROWS1)) { phase_rows<true>(a, X, a.x, a.norm1_w, 0, 1, (bf16_t*)(ws + WS_H)); SEAM(PH_ROWS1); }
    if (IN(PH_PROJ)) {
        __syncthreads();
        pg8::DenseSched S; S.init(ws + WS_H, ws + WS_WINT, NTOK, PROJ_N, X.G, X.bid);
        pg8::EpiProj E{(bf16_t*)(ws + WS_PROJ)};
        pg8::gemm_phase(X.lds, S, E); SEAM(PH_PROJ);
    }
    if (IN(PH_GMLP)) { phase_gmlp(a, X); SEAM(PH_GMLP); }
    if (IN(PH_CONV)) { phase_conv(a, X); SEAM(PH_CONV); }
    if (IN(PH_SCAN)) { phase_scan_naive(a, X); SEAM(PH_SCAN); }
    if (IN(PH_ONORM)) { phase_onorm(a, X); SEAM(PH_ONORM); }
    if (IN(PH_MIX)) {
        __syncthreads();
        pg8::DenseSched S; S.init(ws + WS_MIXIN, ws + WS_WOUTT, NTOK, DM, X.G, X.bid);
        pg8::EpiMix E{a.x, (const float*)(ws + WS_MOD), (float*)(ws + WS_X1)};
        pg8::gemm_phase(X.lds, S, E); SEAM(PH_MIX);
    }
    if (IN(PH_ROWS2)) { __syncthreads(); phase_rows<false>(a, X, (const float*)(ws + WS_X1), a.norm2_w, 3, 4, (bf16_t*)(ws + WS_H)); SEAM(PH_ROWS2); }
    if (IN(PH_ROUTER)) {
        __syncthreads();
        pg8::DenseSched S; S.init(ws + WS_H, ws + WS_WRT, NTOK, 256, X.G, X.bid);
        pg8::EpiLogits E{a.b_router, (float*)(ws + WS_LOGITS)};
        pg8::gemm_phase(X.lds, S, E); SEAM(PH_ROUTER);
    }
    if (IN(PH_ROUTE)) { phase_route(a, X); SEAM(PH_ROUTE); }
    if (IN(PH_MOE1)) {
        pg8::MoeTab T; const int nM = moe_tables(a, X, T);
        pg8::Moe1Sched S; S.init(ws + WS_H, ws + WS_WGUT, (const int*)(ws + WS_LIST), T, nM, X.G, X.bid);
        pg8::EpiAct E{a.b_gu, (bf16_t*)(ws + WS_ACT)};
        pg8::gemm_phase(X.lds, S, E); SEAM(PH_MOE1);
    }
    if (IN(PH_MOE2)) {
        pg8::MoeTab T; const int nM = moe_tables(a, X, T);
        pg8::Moe2Sched S; S.init(ws + WS_ACT, ws + WS_WDT, T, nM, X.G, X.bid);
        pg8::EpiY E{a.b_down, (bf16_t*)(ws + WS_Y)};
        pg8::gemm_phase(X.lds, S, E); SEAM(PH_MOE2);
    }
    if (IN(PH_COMBINE)) { phase_combine(a, X); }
#undef IN
#undef SEAM
}

extern "C" void kernel_launch(void* const* d_in, const int* in_sizes, int n_in, void* d_out, int out_size, void* d_ws, size_t ws_size, hipStream_t stream) {
    static int grid = 0;
    if (grid == 0) {
        if (n_in != 22 || out_size != NTOK * DM || ws_size < WS_END) { fprintf(stderr, "kernel_launch: unexpected shapes (n_in %d out %d ws %zu)\n", n_in, out_size, ws_size); grid = -1; return; }
        int dev = 0, cus = 0, per_cu = 0;
        hipGetDevice(&dev); hipDeviceGetAttribute(&cus, hipDeviceAttributeMultiprocessorCount, dev);
        hipFuncSetAttribute((const void*)mega, hipFuncAttributeMaxDynamicSharedMemorySize, LDS_BYTES);
        hipOccupancyMaxActiveBlocksPerMultiprocessor(&per_cu, (const void*)mega, 512, LDS_BYTES);
        if (per_cu < 1) { fprintf(stderr, "kernel_launch: occupancy query says %d blocks per CU\n", per_cu); }
        (void)hipGetLastError();
        grid = cus > 0 ? cus : 256;
    }
    if (grid < 0) return;
    hipMemsetAsync((char*)d_ws + WS_CTL, 0, 4096, stream);
    Args a{};
    const float** p = (const float**)&a;
    for (int i = 0; i < 22; ++i) p[i] = (const float*)d_in[i];
    a.out = (float*)d_out; a.ws = (unsigned char*)d_ws;
#if SINGLE_LAUNCH
    a.ph_lo = 0; a.ph_hi = PH_COUNT;
    void* args[] = {&a};
    hipError_t e = hipLaunchCooperativeKernel((const void*)mega, dim3(grid), dim3(512), args, LDS_BYTES, stream);
    if (e != hipSuccess) fprintf(stderr, "cooperative launch failed: %s (grid %d)\n", hipGetErrorString(e), grid);
#else
    for (int ph = 0; ph < PH_COUNT; ++ph) { a.ph_lo = ph; a.ph_hi = ph + 1; hipLaunchKernelGGL(mega, dim3(grid), dim3(512), LDS_BYTES, stream, a); }
#endif
}
```

```cpp
#include <hip/hip_runtime.h>
#include <cstdio>
#include <cstdint>

#ifndef SINGLE_LAUNCH
#define SINGLE_LAUNCH 1
#endif
#if SINGLE_LAUNCH
#include <hip/hip_cooperative_groups.h>
namespace cg = cooperative_groups;
#endif

#define LAS __attribute__((address_space(3)))
typedef unsigned short bf16_t;
typedef short bf16x8 __attribute__((ext_vector_type(8)));
typedef float f32x4 __attribute__((ext_vector_type(4)));
typedef float f32x2 __attribute__((ext_vector_type(2)));
typedef unsigned u32x4 __attribute__((ext_vector_type(4)));
typedef unsigned u32x2 __attribute__((ext_vector_type(2)));

constexpr int DM = 1024, NB = 4, SEQ = 8192, NTOK = NB * SEQ;
constexpr int GM_G = 4, GM_D = 128, GM_W = 512, GM_C = 128;
constexpr int NH = 4, HD = 128, QKW = 512, VW = 512, CONVK = 4;
constexpr int IN_COLS = 3080, PROJ_N = 3072;
constexpr int NE = 32, TOPK = 4, DFF = 1024;
constexpr float EPS = 1e-6f;
constexpr int LIST_CAP = NTOK;
constexpr int MAX_SLOTS = NTOK * TOPK + NE * 256;

constexpr size_t MiB = 1u << 20;
constexpr size_t WS_CTL = 0;
constexpr size_t WS_MOD = 1 * MiB;
constexpr size_t WS_G = 2 * MiB;
constexpr size_t WS_BETA = 3 * MiB;
constexpr size_t WS_ROUTE = 4 * MiB;
constexpr size_t WS_LIST = 6 * MiB;
constexpr size_t WS_LOGITS = 10 * MiB;
constexpr size_t WS_WRT = 14 * MiB;
constexpr size_t WS_WOUTT = 16 * MiB;
constexpr size_t WS_WINT = 18 * MiB;
constexpr size_t WS_WGUT = 24 * MiB;
constexpr size_t WS_WDT = 152 * MiB;
constexpr size_t WS_X1 = 216 * MiB;
constexpr size_t WS_H = 344 * MiB;
constexpr size_t WS_PROJ = 408 * MiB;
constexpr size_t WS_MIXIN = 600 * MiB;
constexpr size_t WS_QN = 664 * MiB;
constexpr size_t WS_KN = 728 * MiB;
constexpr size_t WS_VN = 792 * MiB;
constexpr size_t WS_ORAW = 856 * MiB;
constexpr size_t WS_WN = 664 * MiB;
constexpr size_t WS_QG = 696 * MiB;
constexpr size_t WS_KDT = 728 * MiB;
constexpr size_t WS_QK = 760 * MiB;
constexpr size_t WS_UF = 776 * MiB;
constexpr size_t WS_EG = 840 * MiB;
constexpr size_t WS_ACT = 408 * MiB;
constexpr size_t WS_Y = 680 * MiB;
constexpr size_t WS_END = 952 * MiB;

constexpr int LDS_BYTES = 147456;
constexpr int LDS_MISC = 131072;

__device__ __forceinline__ unsigned f2bf(float f) { unsigned u = __builtin_bit_cast(unsigned, f); return (u + 0x7fffu + ((u >> 16) & 1u)) >> 16; }
__device__ __forceinline__ unsigned pk2(float lo, float hi) { return f2bf(lo) | (f2bf(hi) << 16); }
__device__ __forceinline__ float bflo(unsigned w) { return __builtin_bit_cast(float, w << 16); }
__device__ __forceinline__ float bfhi(unsigned w) { return __builtin_bit_cast(float, w & 0xffff0000u); }
__device__ __forceinline__ float wave_sum(float v) {
#pragma unroll
    for (int o = 1; o < 64; o <<= 1) v += __shfl_xor(v, o);
    return v;
}
__device__ __forceinline__ float silu_f(float x) { return x / (1.f + __expf(-x)); }
__device__ __forceinline__ float sigmoid_f(float x) { return 1.f / (1.f + __expf(-x)); }

namespace pg8 {
constexpr int BM = 256, BK = 64, HALF = 128, HTB = HALF * BK * 2, STAGE_BYTES = 8 * HTB, NXCD = 8, WGM = 8, KD = 1024;
__host__ __device__ __forceinline__ int lds_byte(int r, int c) { const int st = (r >> 4) * 2 + (c >> 5), rr = r & 15, cc = c & 31, ob = rr * 64 + cc * 2; return st * 1024 + (ob ^ (((ob >> 9) & 1) << 5)); }
__host__ __device__ __forceinline__ void stage_rc(int b, int& R, int& C) { const int st = b / 1024, sb = b % 1024, swz = sb ^ (((sb >> 9) & 1) << 5); R = (st >> 1) * 16 + swz / 64; C = (st & 1) * 32 + (swz % 64) / 2; }
__host__ __device__ __forceinline__ int perm32(int rho) { const int n = rho >> 4, i = rho & 15; return 8 * (i >> 2) + 4 * n + (i & 3); }

struct Unit { const char* A; const char* B0; const char* B1; unsigned vA0[2], vA1[2]; int pm, pn, e; };

__device__ __forceinline__ bool tile_order(int i, int G, int c, int nM, int nN, int& pm, int& pn) {
    const int nwg = nM * nN; const long L = (long)i * G + c; if (L >= nwg) return false;
    int wgid = (int)L; { const int q = nwg / NXCD, r = nwg % NXCD, xcd = wgid % NXCD, off = wgid / NXCD; wgid = (xcd < r ? xcd * (q + 1) : r * (q + 1) + (xcd - r) * q) + off; }
    const int nig = WGM * nN, gid = wgid / nig, fm = gid * WGM, gsz = (nM - fm) < WGM ? (nM - fm) : WGM;
    pm = fm + ((wgid % nig) % gsz); pn = (wgid % nig) / gsz; return true;
}

__device__ __forceinline__ unsigned cvt_pk_bf16(float lo, float hi) { unsigned r; asm volatile("v_cvt_pk_bf16_f32 %0, %1, %2" : "=v"(r) : "v"(lo), "v"(hi)); return r; }
__device__ __forceinline__ f32x2 gelu_pk(f32x2 v) {
    const f32x2 av = __builtin_elementwise_abs(v), d = av * 0.2316418882f + 1.0f;
    f32x2 t; t.x = __builtin_amdgcn_rcpf(d.x); t.y = __builtin_amdgcn_rcpf(d.y);
    f32x2 q = t * 0.5307027145f + (-0.7265760135f); q = q * t + 0.7107068705f; q = q * t + (-0.142248368f); q = q * t + 0.127414796f; q = q * t;
    const f32x2 s = (v * v) * (-0.72134752044f);
    f32x2 e; e.x = __builtin_amdgcn_exp2f(s.x); e.y = __builtin_amdgcn_exp2f(s.y);
    const f32x2 m = v * (q * e), r = v - m;
    f32x2 o; o.x = v.x < 0.f ? m.x : r.x; o.y = v.y < 0.f ? m.y : r.y; return o;
}

template <class Epi, class Sched>
__device__ __forceinline__ void gemm_phase(LAS unsigned char* lds, const Sched& S, const Epi& E) {
    const int tid = threadIdx.x, wid = __builtin_amdgcn_readfirstlane(tid >> 6), lane = tid & 63, wr = wid >> 2, wc = wid & 3, fr = lane & 15, fq = lane >> 4;
    constexpr int K = KD, nt = K / BK;
    unsigned voffB[2];
#pragma unroll
    for (int i = 0; i < 2; ++i) { int R, C; stage_rc(tid * 16 + i * 8192, R, C); const int Rb = Epi::PERM ? ((R & ~31) + perm32(R & 31)) : R; voffB[i] = (unsigned)(Rb * K + C) * 2u; }
    const size_t kstep = (size_t)(BK * 2);
    const unsigned ldsw = (unsigned)wid * 1024u;
    const int aoff = lds_byte(wr * 64 + fr, fq * 8), boff = lds_byte(wc * 32 + fr, fq * 8);
#define PG8_SA(b, h) (((b) * 2 + (h)) * HTB)
#define PG8_SB(b, h) ((4 + (b) * 2 + (h)) * HTB)
#define PG8_STAGE(bufoff, gbase, voff) do { _Pragma("unroll") for (int _i = 0; _i < 2; ++_i) \
        __builtin_amdgcn_global_load_lds((const unsigned*)((const char*)(gbase) + (voff)[_i]), (LAS unsigned*)(lds + (bufoff) + ldsw + _i * 8192), 16, 0, 0); } while (0)
#define PG8_LDA(dst, b, h) do { _Pragma("unroll") for (int m = 0; m < 4; ++m) _Pragma("unroll") for (int k = 0; k < 2; ++k) dst[m][k] = *(const LAS bf16x8*)(lds + PG8_SA(b, h) + aoff + m * 2048 + k * 1024); } while (0)
#define PG8_LDB(dst, b, h) do { _Pragma("unroll") for (int n = 0; n < 2; ++n) _Pragma("unroll") for (int k = 0; k < 2; ++k) dst[n][k] = *(const LAS bf16x8*)(lds + PG8_SB(b, h) + boff + n * 2048 + k * 1024); } while (0)
#define PG8_MMA(ai, bj, At, Bt) do { __builtin_amdgcn_s_setprio(1); _Pragma("unroll") for (int m = 0; m < 4; ++m) _Pragma("unroll") for (int n = 0; n < 2; ++n) _Pragma("unroll") for (int k = 0; k < 2; ++k) \
        acc[ai][bj][m][n] = __builtin_amdgcn_mfma_f32_16x16x32_bf16(Bt[n][k], At[m][k], acc[ai][bj][m][n], 0, 0, 0); __builtin_amdgcn_s_setprio(0); } while (0)
#define PG8_WAIT_V(n) asm volatile("s_waitcnt vmcnt(" #n ")" ::: "memory")
#define PG8_WAIT_L(n) asm volatile("s_waitcnt lgkmcnt(" #n ")" ::: "memory")
#define PG8_BAR __builtin_amdgcn_s_barrier()
#define PG8_SCHED __builtin_amdgcn_sched_barrier(0)
    Unit cur, nxt; int ui = 0;
    if (!S.next(0, cur)) return;
    f32x4 acc[2][2][4][2];
#pragma unroll
    for (int a = 0; a < 2; ++a)
#pragma unroll
        for (int b = 0; b < 2; ++b)
#pragma unroll
            for (int m = 0; m < 4; ++m)
#pragma unroll
                for (int n = 0; n < 2; ++n) acc[a][b][m][n] = (f32x4){0.f, 0.f, 0.f, 0.f};
    bf16x8 At[4][2], B0[2][2], B1[2][2];
    PG8_STAGE(PG8_SB(0, 0), cur.B0, voffB); PG8_STAGE(PG8_SB(0, 1), cur.B1, voffB); PG8_STAGE(PG8_SA(0, 0), cur.A, cur.vA0); PG8_STAGE(PG8_SA(0, 1), cur.A, cur.vA1);
    if (wr == 1) PG8_BAR;
    PG8_WAIT_V(2); PG8_BAR;
    PG8_STAGE(PG8_SB(1, 0), cur.B0 + kstep, voffB); PG8_STAGE(PG8_SA(1, 0), cur.A + kstep, cur.vA0); PG8_STAGE(PG8_SB(1, 1), cur.B1 + kstep, voffB);
    PG8_WAIT_V(6); PG8_BAR;
    for (;;) {
        const bool has_next = S.next(ui + 1, nxt);
        for (int t = 0; t < nt; t += 2) {
            const bool last = (t == nt - 2);
            const bool fromn = last && has_next;
            const size_t ko = last ? 0 : (size_t)(t + 2) * kstep;
            const char* a2 = (fromn ? nxt.A : cur.A) + ko; const char* b20 = (fromn ? nxt.B0 : cur.B0) + ko; const char* b21 = (fromn ? nxt.B1 : cur.B1) + ko;
            unsigned w0[2], w1[2];
#pragma unroll
            for (int i = 0; i < 2; ++i) { w0[i] = fromn ? nxt.vA0[i] : cur.vA0[i]; w1[i] = fromn ? nxt.vA1[i] : cur.vA1[i]; }
            const char* a1 = cur.A + (size_t)(t + 1) * kstep;
            PG8_LDB(B0, 0, 0); PG8_LDB(B1, 0, 1); PG8_SCHED; PG8_LDA(At, 0, 0); PG8_STAGE(PG8_SA(1, 1), a1, cur.vA1);
            PG8_WAIT_V(8); PG8_WAIT_L(0); PG8_BAR; PG8_MMA(0, 0, At, B0); PG8_MMA(0, 1, At, B1); PG8_BAR; PG8_SCHED;
            PG8_LDA(At, 0, 1); PG8_STAGE(PG8_SB(0, 0), b20, voffB); PG8_STAGE(PG8_SB(0, 1), b21, voffB); PG8_STAGE(PG8_SA(0, 0), a2, w0);
            PG8_WAIT_V(8); PG8_WAIT_L(0); PG8_BAR; PG8_MMA(1, 0, At, B0); PG8_MMA(1, 1, At, B1); PG8_BAR; PG8_SCHED;
            PG8_LDB(B0, 1, 0); PG8_LDB(B1, 1, 1); PG8_SCHED; PG8_LDA(At, 1, 0); PG8_STAGE(PG8_SA(0, 1), a2, w1);
            PG8_WAIT_V(8); PG8_WAIT_L(0); PG8_BAR; PG8_MMA(0, 0, At, B0); PG8_MMA(0, 1, At, B1); PG8_BAR; PG8_SCHED;
            PG8_LDA(At, 1, 1); PG8_STAGE(PG8_SB(1, 0), b20 + kstep, voffB); PG8_STAGE(PG8_SB(1, 1), b21 + kstep, voffB); PG8_STAGE(PG8_SA(1, 0), a2 + kstep, w0);
            PG8_WAIT_V(8); PG8_WAIT_L(0); PG8_BAR; PG8_MMA(1, 0, At, B0); PG8_MMA(1, 1, At, B1); PG8_BAR; PG8_SCHED;
        }
        if (wr == 0) PG8_BAR;
        E(acc, cur, wr, wc, fr, fq);
        if (!has_next) break;
#pragma unroll
        for (int a = 0; a < 2; ++a)
#pragma unroll
            for (int b = 0; b < 2; ++b)
#pragma unroll
                for (int m = 0; m < 4; ++m)
#pragma unroll
                    for (int n = 0; n < 2; ++n) acc[a][b][m][n] = (f32x4){0.f, 0.f, 0.f, 0.f};
        cur = nxt; ++ui;
        if (wr == 1) PG8_BAR;
    }
    PG8_WAIT_V(0);
    PG8_BAR;
#undef PG8_SA
#undef PG8_SB
#undef PG8_STAGE
#undef PG8_LDA
#undef PG8_LDB
#undef PG8_MMA
#undef PG8_WAIT_V
#undef PG8_WAIT_L
#undef PG8_BAR
#undef PG8_SCHED
}

struct DenseSched {
    const char* A; const char* Bt; int nM, nN, G, c; int R[2], C[2];
    __device__ __forceinline__ void init(const void* A_, const void* Bt_, int M, int N, int G_, int c_) {
        A = (const char*)A_; Bt = (const char*)Bt_; nM = M / BM; nN = N / BM; G = G_; c = c_;
#pragma unroll
        for (int i = 0; i < 2; ++i) stage_rc((int)threadIdx.x * 16 + i * 8192, R[i], C[i]);
    }
    __device__ __forceinline__ bool next(int i, Unit& u) const {
        int pm, pn; if (!tile_order(i, G, c, nM, nN, pm, pn)) return false;
        u.pm = pm; u.pn = pn; u.e = 0; u.A = A; u.B0 = Bt + (size_t)pn * 256 * KD * 2; u.B1 = u.B0 + (size_t)128 * KD * 2;
#pragma unroll
        for (int i2 = 0; i2 < 2; ++i2) { u.vA0[i2] = (unsigned)(((pm * 256 + R[i2]) * KD + C[i2]) * 2); u.vA1[i2] = u.vA0[i2] + 128u * KD * 2u; }
        return true;
    }
};
struct MoeTab { const LAS int* tp; const LAS int* cnt; };
__device__ __forceinline__ int moe_find(const MoeTab& T, int pm) { int e = 0; while (e < NE - 1 && T.tp[e + 1] <= pm) ++e; return e; }
struct Moe1Sched {
    const char* A; const char* Bt; const int* list; MoeTab T; int nM, nN, G, c; int R[2], C[2];
    __device__ __forceinline__ void init(const void* A_, const void* Bt_, const int* list_, MoeTab T_, int nM_, int G_, int c_) {
        A = (const char*)A_; Bt = (const char*)Bt_; list = list_; T = T_; nM = nM_; nN = 8; G = G_; c = c_;
#pragma unroll
        for (int i = 0; i < 2; ++i) stage_rc((int)threadIdx.x * 16 + i * 8192, R[i], C[i]);
    }
    __device__ __forceinline__ bool next(int i, Unit& u) const {
        int pm, pn; if (!tile_order(i, G, c, nM, nN, pm, pn)) return false;
        const int e = moe_find(T, pm), ml = pm - T.tp[e], ce = T.cnt[e];
        u.pm = pm; u.pn = pn; u.e = e; u.A = A;
        u.B0 = Bt + ((size_t)e * 2048 + 128 * pn) * KD * 2; u.B1 = Bt + ((size_t)e * 2048 + 1024 + 128 * pn) * KD * 2;
#pragma unroll
        for (int i2 = 0; i2 < 2; ++i2) {
            const int i0 = ml * 256 + R[i2], i1 = i0 + 128;
            const int t0 = i0 < ce ? list[(size_t)e * LIST_CAP + i0] : 0, t1 = i1 < ce ? list[(size_t)e * LIST_CAP + i1] : 0;
            u.vA0[i2] = (unsigned)((t0 * KD + C[i2]) * 2); u.vA1[i2] = (unsigned)((t1 * KD + C[i2]) * 2);
        }
        asm volatile("" : "+v"(u.vA0[0]), "+v"(u.vA0[1]), "+v"(u.vA1[0]), "+v"(u.vA1[1]));
        return true;
    }
};
struct Moe2Sched {
    const char* A; const char* Bt; MoeTab T; int nM, nN, G, c; int R[2], C[2];
    __device__ __forceinline__ void init(const void* A_, const void* Bt_, MoeTab T_, int nM_, int G_, int c_) {
        A = (const char*)A_; Bt = (const char*)Bt_; T = T_; nM = nM_; nN = 4; G = G_; c = c_;
#pragma unroll
        for (int i = 0; i < 2; ++i) stage_rc((int)threadIdx.x * 16 + i * 8192, R[i], C[i]);
    }
    __device__ __forceinline__ bool next(int i, Unit& u) const {
        int pm, pn; if (!tile_order(i, G, c, nM, nN, pm, pn)) return false;
        const int e = moe_find(T, pm);
        u.pm = pm; u.pn = pn; u.e = e; u.A = A;
        u.B0 = Bt + ((size_t)e * 1024 + 256 * pn) * KD * 2; u.B1 = u.B0 + (size_t)128 * KD * 2;
#pragma unroll
        for (int i2 = 0; i2 < 2; ++i2) { u.vA0[i2] = (unsigned)(((pm * 256 + R[i2]) * KD + C[i2]) * 2); u.vA1[i2] = u.vA0[i2] + 128u * KD * 2u; }
        return true;
    }
};

struct EpiProj {
    static constexpr bool PERM = true;
    bf16_t* O;
    __device__ __forceinline__ void operator()(const f32x4 (&acc)[2][2][4][2], const Unit& u, int wr, int wc, int fr, int fq) const {
        const int row0 = u.pm * BM + wr * 64 + fr, col0 = u.pn * BM + wc * 32 + 8 * fq; const bool act = u.pn < 4;
#pragma unroll
        for (int ai = 0; ai < 2; ++ai)
#pragma unroll
            for (int m = 0; m < 4; ++m) { bf16_t* rowp = O + (size_t)(row0 + ai * HALF + m * 16) * PROJ_N + col0;
#pragma unroll
                for (int bj = 0; bj < 2; ++bj) { f32x4 v0 = acc[ai][bj][m][0], v1 = acc[ai][bj][m][1];
                    if (act) { f32x2 a = gelu_pk((f32x2){v0[0], v0[1]}), b = gelu_pk((f32x2){v0[2], v0[3]}), c = gelu_pk((f32x2){v1[0], v1[1]}), d = gelu_pk((f32x2){v1[2], v1[3]});
                        v0 = (f32x4){a.x, a.y, b.x, b.y}; v1 = (f32x4){c.x, c.y, d.x, d.y}; }
                    u32x4 w; w.x = cvt_pk_bf16(v0[0], v0[1]); w.y = cvt_pk_bf16(v0[2], v0[3]); w.z = cvt_pk_bf16(v1[0], v1[1]); w.w = cvt_pk_bf16(v1[2], v1[3]);
                    *(u32x4*)(rowp + bj * HALF) = w; } }
    }
};
struct EpiMix {
    static constexpr bool PERM = false;
    const float* x; const float* mod; float* X1;
    __device__ __forceinline__ void operator()(const f32x4 (&acc)[2][2][4][2], const Unit& u, int wr, int wc, int fr, int fq) const {
        const int row0 = u.pm * BM + wr * 64 + fr, col0 = u.pn * BM + wc * 32 + 4 * fq;
        const int b = (u.pm * BM) / SEQ; const float* g1 = mod + (size_t)b * 6 * DM + 2 * DM;
        f32x4 gv[2][2];
#pragma unroll
        for (int bj = 0; bj < 2; ++bj)
#pragma unroll
            for (int n = 0; n < 2; ++n) gv[bj][n] = *(const f32x4*)(g1 + col0 + bj * HALF + n * 16);
#pragma unroll
        for (int ai = 0; ai < 2; ++ai)
#pragma unroll
            for (int m = 0; m < 4; ++m) { const size_t off = (size_t)(row0 + ai * HALF + m * 16) * DM + col0;
#pragma unroll
                for (int bj = 0; bj < 2; ++bj)
#pragma unroll
                    for (int n = 0; n < 2; ++n) { const f32x4 xv = *(const f32x4*)(x + off + bj * HALF + n * 16); *(f32x4*)(X1 + off + bj * HALF + n * 16) = xv + gv[bj][n] * acc[ai][bj][m][n]; }
                asm volatile("" ::: "memory"); }
    }
};
struct EpiLogits {
    static constexpr bool PERM = false;
    const float* br; float* L;
    __device__ __forceinline__ void operator()(const f32x4 (&acc)[2][2][4][2], const Unit& u, int wr, int wc, int fr, int fq) const {
        if (wc != 0) return;
        const int row0 = u.pm * BM + wr * 64 + fr;
#pragma unroll
        for (int ai = 0; ai < 2; ++ai)
#pragma unroll
            for (int m = 0; m < 4; ++m)
#pragma unroll
                for (int n = 0; n < 2; ++n) { const int c = 16 * n + 4 * fq; const f32x4 bv = *(const f32x4*)(br + c);
                    *(f32x4*)(L + (size_t)(row0 + ai * HALF + m * 16) * NE + c) = acc[ai][0][m][n] + bv; }
    }
};
struct EpiAct {
    static constexpr bool PERM = true;
    const float* bgu; bf16_t* O;
    __device__ __forceinline__ void operator()(const f32x4 (&acc)[2][2][4][2], const Unit& u, int wr, int wc, int fr, int fq) const {
        const int row0 = u.pm * BM + wr * 64 + fr, f0 = u.pn * 128 + wc * 32 + 8 * fq;
        const float* bg = bgu + (size_t)u.e * 2048 + f0; const float* bu = bg + 1024;
        const f32x4 bg0 = *(const f32x4*)bg, bg1 = *(const f32x4*)(bg + 4), bu0 = *(const f32x4*)bu, bu1 = *(const f32x4*)(bu + 4);
#pragma unroll
        for (int ai = 0; ai < 2; ++ai)
#pragma unroll
            for (int m = 0; m < 4; ++m) {
                float r[8];
#pragma unroll
                for (int n = 0; n < 2; ++n)
#pragma unroll
                    for (int j = 0; j < 4; ++j) {
                        float g = acc[ai][0][m][n][j] + (n ? bg1[j] : bg0[j]), up = acc[ai][1][m][n][j] + (n ? bu1[j] : bu0[j]);
                        g = fminf(g, 7.0f); up = fminf(fmaxf(up, -7.0f), 7.0f);
                        r[n * 4 + j] = g * sigmoid_f(1.702f * g) * (up + 1.0f);
                    }
                u32x4 w; w.x = cvt_pk_bf16(r[0], r[1]); w.y = cvt_pk_bf16(r[2], r[3]); w.z = cvt_pk_bf16(r[4], r[5]); w.w = cvt_pk_bf16(r[6], r[7]);
                *(u32x4*)(O + (size_t)(row0 + ai * HALF + m * 16) * DFF + f0) = w;
            }
    }
};
struct EpiY {
    static constexpr bool PERM = true;
    const float* bd; bf16_t* O;
    __device__ __forceinline__ void operator()(const f32x4 (&acc)[2][2][4][2], const Unit& u, int wr, int wc, int fr, int fq) const {
        const int row0 = u.pm * BM + wr * 64 + fr, col0 = u.pn * BM + wc * 32 + 8 * fq;
        const float* b = bd + (size_t)u.e * DM + col0;
        f32x4 bv[2][2];
#pragma unroll
        for (int bj = 0; bj < 2; ++bj)
#pragma unroll
            for (int n = 0; n < 2; ++n) bv[bj][n] = *(const f32x4*)(b + bj * HALF + 4 * n);
#pragma unroll
        for (int ai = 0; ai < 2; ++ai)
#pragma unroll
            for (int m = 0; m < 4; ++m) { bf16_t* rowp = O + (size_t)(row0 + ai * HALF + m * 16) * DM + col0;
#pragma unroll
                for (int bj = 0; bj < 2; ++bj) { const f32x4 v0 = acc[ai][bj][m][0] + bv[bj][0], v1 = acc[ai][bj][m][1] + bv[bj][1];
                    u32x4 w; w.x = cvt_pk_bf16(v0[0], v0[1]); w.y = cvt_pk_bf16(v0[2], v0[3]); w.z = cvt_pk_bf16(v1[0], v1[1]); w.w = cvt_pk_bf16(v1[2], v1[3]);
                    *(u32x4*)(rowp + bj * HALF) = w; } }
    }
};
}

struct Args {
    const float *x, *c, *w_ada, *b_ada, *norm1_w, *w_in, *gm_vnorm_w, *gm_w_spatial, *gm_b_spatial, *gdn_conv_w, *gdn_a_log, *gdn_dt_bias, *gdn_onorm_w,
        *w_out, *norm2_w, *w_router, *b_router, *w_gu, *b_gu, *w_down, *b_down, *norm_f_w;
    float* out; unsigned char* ws; int ph_lo, ph_hi;
};

struct Ctx { LAS unsigned char* lds; int tid, lane, wave, G, bid; };

__device__ __forceinline__ void transpose_item(const float* W, int ld, bf16_t* WT, int Kp, int k0, int n0, int row_off, LAS float* scr, int lane) {
#pragma unroll 8
    for (int i = 0; i < 32; ++i) { const int kk = 2 * i + (lane >> 5); scr[kk * 33 + (lane & 31)] = W[(size_t)(k0 + kk) * ld + n0 + (lane & 31)]; }
    asm volatile("s_waitcnt lgkmcnt(0)" ::: "memory");
    const int c = lane & 7;
#pragma unroll
    for (int j = 0; j < 4; ++j) { const int n = (lane >> 3) + 8 * j; const LAS float* s = scr + (8 * c) * 33 + n;
        u32x4 o; o.x = pk2(s[0 * 33], s[1 * 33]); o.y = pk2(s[2 * 33], s[3 * 33]); o.z = pk2(s[4 * 33], s[5 * 33]); o.w = pk2(s[6 * 33], s[7 * 33]);
        *(u32x4*)(WT + (size_t)(row_off + n0 + n) * Kp + k0 + 8 * c) = o; }
    asm volatile("s_waitcnt lgkmcnt(0)" ::: "memory");
}

__device__ __forceinline__ void phase_prep0(const Args& a, const Ctx& X) {
    unsigned char* ws = a.ws;
    {
        LAS float* cact = (LAS float*)X.lds;
        LAS f32x4* part = (LAS f32x4*)(X.lds + 16384);
        for (int i = X.tid; i < NB * DM; i += 512) cact[i] = silu_f(a.c[i]);
        __syncthreads();
        float* mod = (float*)(ws + WS_MOD);
        for (int cgp = X.bid; cgp < 256; cgp += X.G) {
            const int j0 = 24 * cgp;
            if (X.tid < 384) {
                const int q = X.tid % 6, kc = X.tid / 6;
                f32x4 s[4] = {{0, 0, 0, 0}, {0, 0, 0, 0}, {0, 0, 0, 0}, {0, 0, 0, 0}};
#pragma unroll 4
                for (int kk = 0; kk < 16; ++kk) { const int k = kc * 16 + kk; const f32x4 w = *(const f32x4*)(a.w_ada + (size_t)k * 6144 + j0 + 4 * q);
#pragma unroll
                    for (int b = 0; b < 4; ++b) s[b] += w * cact[b * DM + k]; }
#pragma unroll
                for (int b = 0; b < 4; ++b) part[(kc * 4 + b) * 6 + q] = s[b];
            }
            __syncthreads();
            if (X.tid < 96) { const int b = X.tid / 24, col = X.tid % 24; float s = 0.f;
                for (int kc = 0; kc < 64; ++kc) s += part[(kc * 4 + b) * 6 + (col >> 2)][col & 3];
                mod[b * 6144 + j0 + col] = s + a.b_ada[j0 + col]; }
            __syncthreads();
        }
    }
    {
        LAS float* scr = (LAS float*)(X.lds + X.wave * 16384);
        const int gw = X.bid * 8 + X.wave, NGW = X.G * 8;
        bf16_t* WinT = (bf16_t*)(ws + WS_WINT); bf16_t* WoutT = (bf16_t*)(ws + WS_WOUTT); bf16_t* WrT = (bf16_t*)(ws + WS_WRT);
        bf16_t* WguT = (bf16_t*)(ws + WS_WGUT); bf16_t* WdT = (bf16_t*)(ws + WS_WDT);
        constexpr int I_IN = 16 * 96, I_OUT = 16 * 32, I_R = 16, I_GU = 32 * 16 * 64, I_D = 32 * 16 * 32;
        constexpr int NITEMS = I_IN + I_OUT + I_R + I_GU + I_D;
        for (int it = gw; it < NITEMS; it += NGW) {
            int r = it;
            if (r < I_IN) { transpose_item(a.w_in, IN_COLS, WinT, DM, 64 * (r / 96), 32 * (r % 96), 0, scr, X.lane); continue; } r -= I_IN;
            if (r < I_OUT) { transpose_item(a.w_out, DM, WoutT, DM, 64 * (r / 32), 32 * (r % 32), 0, scr, X.lane); continue; } r -= I_OUT;
            if (r < I_R) { transpose_item(a.w_router, NE, WrT, DM, 64 * r, 0, 0, scr, X.lane); continue; } r -= I_R;
            if (r < I_GU) { const int e = r / 1024, q = r % 1024; transpose_item(a.w_gu + (size_t)e * DM * 2048, 2048, WguT + (size_t)e * 2048 * DM, DM, 64 * (q / 64), 32 * (q % 64), 0, scr, X.lane); continue; } r -= I_GU;
            { const int e = r / 512, q = r % 512; transpose_item(a.w_down + (size_t)e * DFF * DM, DM, WdT + (size_t)e * DM * DFF, DFF, 64 * (q / 32), 32 * (q % 32), 0, scr, X.lane); }
        }
        u32x4* z = (u32x4*)(WrT + 32 * DM); const int nz = 224 * DM * 2 / 16;
        for (int i = X.bid * 512 + X.tid; i < nz; i += X.G * 512) z[i] = (u32x4){0u, 0u, 0u, 0u};
    }
}

template <bool AB>
__device__ __forceinline__ void phase_rows(const Args& a, const Ctx& X, const float* src, const float* nw, int sh_idx, int sc_idx, bf16_t* dst) {
    unsigned char* ws = a.ws; const float* mod = (const float*)(ws + WS_MOD);
    LAS float* scl = (LAS float*)X.lds;
    LAS float* shf = scl + 4 * DM;
    LAS float* w8 = shf + 4 * DM;
    for (int i = X.tid; i < NB * DM; i += 512) { const int b = i >> 10, k = i & 1023; scl[i] = nw[k] * (1.f + mod[b * 6144 + sc_idx * DM + k]); shf[i] = mod[b * 6144 + sh_idx * DM + k]; }
    if (AB) for (int i = X.tid; i < DM * 8; i += 512) w8[i] = a.w_in[(size_t)(i >> 3) * IN_COLS + PROJ_N + (i & 7)];
    __syncthreads();
    float* G = (float*)(ws + WS_G); float* BT = (float*)(ws + WS_BETA);
    const int gw = X.bid * 8 + X.wave, NGW = X.G * 8;
    for (int m = gw; m < NTOK; m += NGW) {
        const int b = m / SEQ;
        const f32x4* xr = (const f32x4*)(src + (size_t)m * DM) + X.lane;
        f32x4 v[4]; float ss = 0.f;
#pragma unroll
        for (int j = 0; j < 4; ++j) { v[j] = xr[64 * j]; ss += (v[j].x * v[j].x + v[j].y * v[j].y) + (v[j].z * v[j].z + v[j].w * v[j].w); }
        const float rstd = 1.0f / sqrtf(wave_sum(ss) * (1.f / DM) + EPS);
        float ab[8] = {0, 0, 0, 0, 0, 0, 0, 0};
        unsigned long long* o8 = (unsigned long long*)(dst + (size_t)m * DM) + X.lane;
#pragma unroll
        for (int j = 0; j < 4; ++j) {
            const int k0 = 4 * X.lane + 256 * j;
            const f32x4 sc = *(const LAS f32x4*)(scl + b * DM + k0), sf = *(const LAS f32x4*)(shf + b * DM + k0);
            const f32x4 h = v[j] * rstd * sc + sf;
            o8[64 * j] = (unsigned long long)pk2(h.x, h.y) | ((unsigned long long)pk2(h.z, h.w) << 32);
            if (AB) {
#pragma unroll
                for (int e = 0; e < 4; ++e) { const f32x4 wa = *(const LAS f32x4*)(w8 + (k0 + e) * 8), wb = *(const LAS f32x4*)(w8 + (k0 + e) * 8 + 4);
                    ab[0] += h[e] * wa.x; ab[1] += h[e] * wa.y; ab[2] += h[e] * wa.z; ab[3] += h[e] * wa.w; ab[4] += h[e] * wb.x; ab[5] += h[e] * wb.y; ab[6] += h[e] * wb.z; ab[7] += h[e] * wb.w; }
            }
        }
        if (AB) {
#pragma unroll
            for (int e = 0; e < 8; ++e) ab[e] = wave_sum(ab[e]);
            if (X.lane < 4) { const int hh = X.lane; const float av = (hh == 0 ? ab[0] : hh == 1 ? ab[1] : hh == 2 ? ab[2] : ab[3]) + a.gdn_dt_bias[hh];
                const float sp = av > 20.f ? av : log1pf(__expf(av)); G[(size_t)m * 4 + hh] = -__expf(a.gdn_a_log[hh]) * sp; }
            else if (X.lane < 8) { const int hh = X.lane - 4; const float bv = (hh == 0 ? ab[4] : hh == 1 ? ab[5] : hh == 2 ? ab[6] : ab[7]); BT[(size_t)m * 4 + hh] = sigmoid_f(bv); }
        }
    }
}

__device__ __forceinline__ void phase_gmlp(const Args& a, const Ctx& X) {
    unsigned char* ws = a.ws; const bf16_t* P = (const bf16_t*)(ws + WS_PROJ); bf16_t* MIX = (bf16_t*)(ws + WS_MIXIN);
    LAS float* Wf = (LAS float*)X.lds;
    LAS float* Vn = Wf + 128 * 129;
    const int t = X.tid >> 2, dp = X.tid & 3;
    for (int it = X.bid; it < NB * 64 * GM_G; it += X.G) {
        const int g = it & 3, n = (it >> 2) & 63, b = it >> 8;
        const size_t row0 = (size_t)b * SEQ + (size_t)n * GM_C;
        __syncthreads();
        for (int i = X.tid; i < 128 * 128; i += 512) { const int tt = i >> 7, s = i & 127; Wf[tt * 129 + s] = s <= tt ? a.gm_w_spatial[(size_t)g * 16384 + i] : 0.f; }
        {
            const u32x4* vp = (const u32x4*)(P + (row0 + t) * PROJ_N + GM_W + g * GM_D + dp * 32);
            float f[32]; float ss = 0.f;
#pragma unroll
            for (int q = 0; q < 4; ++q) { const u32x4 w = vp[q]; const unsigned ww[4] = {w.x, w.y, w.z, w.w};
#pragma unroll
                for (int j = 0; j < 4; ++j) { f[q * 8 + 2 * j] = bflo(ww[j]); f[q * 8 + 2 * j + 1] = bfhi(ww[j]); } }
#pragma unroll
            for (int j = 0; j < 32; ++j) ss += f[j] * f[j];
            ss += __shfl_xor(ss, 1); ss += __shfl_xor(ss, 2);
            const float rstd = 1.0f / sqrtf(ss * (1.f / GM_D) + EPS);
#pragma unroll
            for (int j = 0; j < 32; ++j) Vn[t * 128 + dp * 32 + j] = f[j] * rstd * a.gm_vnorm_w[g * GM_D + dp * 32 + j];
        }
        __syncthreads();
        float acc[32];
#pragma unroll
        for (int j = 0; j < 32; ++j) acc[j] = 0.f;
        const int tmax = (X.tid | 63) >> 2;
        for (int s = 0; s <= tmax; ++s) {
            const float w = Wf[t * 129 + s];
            const LAS f32x4* vr = (const LAS f32x4*)(Vn + s * 128 + dp * 32);
#pragma unroll
            for (int q = 0; q < 8; ++q) { const f32x4 vv = vr[q]; acc[4 * q] += w * vv.x; acc[4 * q + 1] += w * vv.y; acc[4 * q + 2] += w * vv.z; acc[4 * q + 3] += w * vv.w; }
        }
        const float bs = a.gm_b_spatial[g * GM_C + t];
        const u32x4* up = (const u32x4*)(P + (row0 + t) * PROJ_N + g * GM_D + dp * 32);
        u32x4* op = (u32x4*)(MIX + (row0 + t) * DM + g * GM_D + dp * 32);
#pragma unroll
        for (int q = 0; q < 4; ++q) { const u32x4 w = up[q]; const unsigned ww[4] = {w.x, w.y, w.z, w.w}; unsigned r[4];
#pragma unroll
            for (int j = 0; j < 4; ++j) r[j] = pk2(bflo(ww[j]) * (acc[q * 8 + 2 * j] + bs), bfhi(ww[j]) * (acc[q * 8 + 2 * j + 1] + bs));
            op[q] = (u32x4){r[0], r[1], r[2], r[3]}; }
    }
}

__device__ __forceinline__ void phase_conv(const Args& a, const Ctx& X) {
    unsigned char* ws = a.ws; const bf16_t* P = (const bf16_t*)(ws + WS_PROJ);
    float* QN = (float*)(ws + WS_QN); float* KN = (float*)(ws + WS_KN); float* VN = (float*)(ws + WS_VN);
    const int gw = X.bid * 8 + X.wave, NGW = X.G * 8;
    for (int m = gw; m < NTOK; m += NGW) {
        const int tpos = m % SEQ;
#pragma unroll
        for (int seg = 0; seg < 3; ++seg) {
            const int ch = seg * 512 + 8 * X.lane;
            float acc[8] = {0, 0, 0, 0, 0, 0, 0, 0};
#pragma unroll
            for (int j = 0; j < CONVK; ++j) {
                const int tt = tpos - 3 + j;
                if (tt >= 0) {
                    const u32x4 w = *(const u32x4*)(P + (size_t)(m - 3 + j) * PROJ_N + 1024 + ch); const unsigned ww[4] = {w.x, w.y, w.z, w.w};
                    const f32x4 c0 = *(const f32x4*)(a.gdn_conv_w + (size_t)j * 1536 + ch), c1 = *(const f32x4*)(a.gdn_conv_w + (size_t)j * 1536 + ch + 4);
                    acc[0] += c0.x * bflo(ww[0]); acc[1] += c0.y * bfhi(ww[0]); acc[2] += c0.z * bflo(ww[1]); acc[3] += c0.w * bfhi(ww[1]);
                    acc[4] += c1.x * bflo(ww[2]); acc[5] += c1.y * bfhi(ww[2]); acc[6] += c1.z * bflo(ww[3]); acc[7] += c1.w * bfhi(ww[3]);
                }
            }
            float ss = 0.f;
#pragma unroll
            for (int j = 0; j < 8; ++j) { acc[j] = silu_f(acc[j]); ss += acc[j] * acc[j]; }
            float* dstp;
            if (seg < 2) {
                ss += __shfl_xor(ss, 1); ss += __shfl_xor(ss, 2); ss += __shfl_xor(ss, 4); ss += __shfl_xor(ss, 8);
                float sc = 1.0f / sqrtf(ss + EPS); if (seg == 0) sc *= 0.08838834764831845f;
#pragma unroll
                for (int j = 0; j < 8; ++j) acc[j] *= sc;
                dstp = (seg == 0 ? QN : KN) + (size_t)m * 512 + 8 * X.lane;
            } else dstp = VN + (size_t)m * 512 + 8 * X.lane;
            *(f32x4*)dstp = (f32x4){acc[0], acc[1], acc[2], acc[3]}; *(f32x4*)(dstp + 4) = (f32x4){acc[4], acc[5], acc[6], acc[7]};
        }
    }
}

__device__ __forceinline__ void phase_scan_naive(const Args& a, const Ctx& X) {
    unsigned char* ws = a.ws;
    const float* QN = (const float*)(ws + WS_QN); const float* KN = (const float*)(ws + WS_KN); const float* VN = (const float*)(ws + WS_VN);
    const float* G = (const float*)(ws + WS_G); const float* BT = (const float*)(ws + WS_BETA); float* OR = (float*)(ws + WS_ORAW);
    constexpr int TT = 16;
    LAS float* kq = (LAS float*)X.lds;
    LAS float* gb = kq + 4 * TT * 256;
    const int hh = X.tid >> 7, e = X.tid & 127;
    for (int b = X.bid; b < NB; b += X.G) {
        float s[128];
#pragma unroll
        for (int d = 0; d < 128; ++d) s[d] = 0.f;
        for (int t0 = 0; t0 < SEQ; t0 += TT) {
            __syncthreads();
            for (int i = X.tid; i < 4 * TT * 256; i += 512) { const int h2 = i / (TT * 256), r = i % (TT * 256), tt = r >> 8, d = r & 255; const size_t m = (size_t)b * SEQ + t0 + tt;
                kq[i] = d < 128 ? KN[m * 512 + h2 * 128 + d] : QN[m * 512 + h2 * 128 + d - 128]; }
            if (X.tid < TT * 8) { const int tt = X.tid >> 3, j = X.tid & 7; const size_t m = (size_t)b * SEQ + t0 + tt; gb[X.tid] = j < 4 ? G[m * 4 + j] : BT[m * 4 + j - 4]; }
            __syncthreads();
            for (int tt = 0; tt < TT; ++tt) {
                const size_t m = (size_t)b * SEQ + t0 + tt;
                const float alpha = __expf(gb[tt * 8 + hh]), beta = gb[tt * 8 + 4 + hh];
                const float vv = VN[m * 512 + hh * 128 + e];
                const LAS f32x4* kp = (const LAS f32x4*)(kq + (hh * TT + tt) * 256);
                float dot = 0.f;
#pragma unroll
                for (int q = 0; q < 32; ++q) { const f32x4 kk = kp[q]; dot += kk.x * s[4 * q] + kk.y * s[4 * q + 1] + kk.z * s[4 * q + 2] + kk.w * s[4 * q + 3]; if ((q & 3) == 3) asm volatile("" ::: "memory"); }
                const float vn = beta * (vv - alpha * dot);
                float o = 0.f;
#pragma unroll
                for (int q = 0; q < 32; ++q) { const f32x4 kk = kp[q], qq = kp[32 + q];
                    s[4 * q] = alpha * s[4 * q] + kk.x * vn; s[4 * q + 1] = alpha * s[4 * q + 1] + kk.y * vn; s[4 * q + 2] = alpha * s[4 * q + 2] + kk.z * vn; s[4 * q + 3] = alpha * s[4 * q + 3] + kk.w * vn;
                    o += qq.x * s[4 * q] + qq.y * s[4 * q + 1] + qq.z * s[4 * q + 2] + qq.w * s[4 * q + 3]; if ((q & 3) == 3) asm volatile("" ::: "memory"); }
                OR[m * 512 + hh * 128 + e] = o;
            }
        }
    }
}

__device__ __forceinline__ int off256(int row, int col) { return row * 256 + ((((col >> 3) ^ row) & 15) << 4) + ((col & 7) << 1); }
__device__ __forceinline__ int off128(int row, int col) { return row * 128 + ((((col >> 3) ^ row) & 7) << 4) + ((col & 7) << 1); }
__device__ __forceinline__ bf16x8 frag256(const LAS unsigned char* img, int r0, int ks, int lane) { return *(const LAS bf16x8*)(img + off256(r0 + (lane & 15), 32 * ks + 8 * (lane >> 4))); }
__device__ __forceinline__ bf16x8 frag128(const LAS unsigned char* img, int r0, int ks, int lane) { return *(const LAS bf16x8*)(img + off128(r0 + (lane & 15), 32 * ks + 8 * (lane >> 4))); }
#define MFMA16(a, b, c) __builtin_amdgcn_mfma_f32_16x16x32_bf16((a), (b), (c), 0, 0, 0)

constexpr int SA_KR = 0, SA_QR = 16384, SA_VBT = 32768, SA_KBGT = 49152, SA_KDT = 65536, SA_AM = 81920, SA_TM = 98304, SA_GC = 106496, SA_BETA = 106752;

__device__ __forceinline__ void phase_stepa(const Args& a, const Ctx& X) {
    unsigned char* ws = a.ws; const bf16_t* P = (const bf16_t*)(ws + WS_PROJ);
    const float* G = (const float*)(ws + WS_G); const float* BT = (const float*)(ws + WS_BETA);
    bf16_t* WN = (bf16_t*)(ws + WS_WN); bf16_t* QG = (bf16_t*)(ws + WS_QG); bf16_t* KDT = (bf16_t*)(ws + WS_KDT); bf16_t* QK = (bf16_t*)(ws + WS_QK);
    float* UF = (float*)(ws + WS_UF); float* EG = (float*)(ws + WS_EG);
    LAS unsigned char* L = X.lds;
    LAS float* GC = (LAS float*)(L + SA_GC); LAS float* BE = (LAS float*)(L + SA_BETA); LAS float* AM = (LAS float*)(L + SA_AM);
    const int w = X.wave;
    for (int ci = X.bid; ci < 2048; ci += X.G) {
        int tid_o = X.tid; asm volatile("" : "+v"(tid_o));
        const int t = tid_o >> 3, cp = tid_o & 7, lane = tid_o & 63, fr = lane & 15, fq = lane >> 4;
        const int n = ci & 127, h = (ci >> 7) & 3, b = ci >> 9;
        const size_t m0 = (size_t)b * SEQ + (size_t)n * 64;
        __syncthreads();
        if (w == 0) {
            float gv = G[(m0 + lane) * 4 + h]; const float bv = BT[(m0 + lane) * 4 + h];
#pragma unroll
            for (int o = 1; o < 64; o <<= 1) { const float up = __shfl_up(gv, o); if (lane >= o) gv += up; }
            GC[lane] = gv; BE[lane] = bv;
        }
        float val[3][16];
#pragma unroll
        for (int seg = 0; seg < 3; ++seg) {
            const int ch = seg * 512 + h * 128 + 16 * cp;
#pragma unroll
            for (int c = 0; c < 16; ++c) val[seg][c] = 0.f;
#pragma unroll
            for (int j = 0; j < CONVK; ++j) {
                if (n * 64 + t - 3 + j >= 0) {
                    const u32x4* pp = (const u32x4*)(P + (m0 + t - 3 + j) * PROJ_N + 1024 + ch);
                    const u32x4 x0 = pp[0], x1 = pp[1]; const unsigned xx[8] = {x0.x, x0.y, x0.z, x0.w, x1.x, x1.y, x1.z, x1.w};
                    const f32x4* cw = (const f32x4*)(a.gdn_conv_w + (size_t)j * 1536 + ch);
#pragma unroll
                    for (int q4 = 0; q4 < 4; ++q4) { const f32x4 c4 = cw[q4];
                        val[seg][4 * q4] += c4.x * bflo(xx[2 * q4]); val[seg][4 * q4 + 1] += c4.y * bfhi(xx[2 * q4]); val[seg][4 * q4 + 2] += c4.z * bflo(xx[2 * q4 + 1]); val[seg][4 * q4 + 3] += c4.w * bfhi(xx[2 * q4 + 1]); }
                }
                asm volatile("" ::: "memory");
            }
            float ss = 0.f;
#pragma unroll
            for (int c = 0; c < 16; ++c) { val[seg][c] = silu_f(val[seg][c]); ss += val[seg][c] * val[seg][c]; }
            if (seg < 2) {
                ss += __shfl_xor(ss, 1); ss += __shfl_xor(ss, 2); ss += __shfl_xor(ss, 4);
                float sc = 1.0f / sqrtf(ss + EPS); if (seg == 0) sc *= 0.08838834764831845f;
#pragma unroll
                for (int c = 0; c < 16; ++c) val[seg][c] *= sc;
            }
        }
        __syncthreads();
        {
            const float gct = GC[t], bt = BE[t], gl = GC[63];
            const float eg = __expf(gct), ekd = __expf(gl - gct);
#pragma unroll
            for (int hf = 0; hf < 2; ++hf) {
                u32x4 kq, qq, qg;
                kq.x = pk2(val[1][8 * hf], val[1][8 * hf + 1]); kq.y = pk2(val[1][8 * hf + 2], val[1][8 * hf + 3]); kq.z = pk2(val[1][8 * hf + 4], val[1][8 * hf + 5]); kq.w = pk2(val[1][8 * hf + 6], val[1][8 * hf + 7]);
                qq.x = pk2(val[0][8 * hf], val[0][8 * hf + 1]); qq.y = pk2(val[0][8 * hf + 2], val[0][8 * hf + 3]); qq.z = pk2(val[0][8 * hf + 4], val[0][8 * hf + 5]); qq.w = pk2(val[0][8 * hf + 6], val[0][8 * hf + 7]);
                qg.x = pk2(val[0][8 * hf] * eg, val[0][8 * hf + 1] * eg); qg.y = pk2(val[0][8 * hf + 2] * eg, val[0][8 * hf + 3] * eg); qg.z = pk2(val[0][8 * hf + 4] * eg, val[0][8 * hf + 5] * eg); qg.w = pk2(val[0][8 * hf + 6] * eg, val[0][8 * hf + 7] * eg);
                *(LAS u32x4*)(L + SA_KR + off256(t, 16 * cp + 8 * hf)) = kq;
                *(LAS u32x4*)(L + SA_QR + off256(t, 16 * cp + 8 * hf)) = qq;
                *(u32x4*)(QG + (size_t)ci * 8192 + t * 128 + 16 * cp + 8 * hf) = qg;
            }
#pragma unroll
            for (int c = 0; c < 16; ++c) {
                *(LAS bf16_t*)(L + SA_VBT + off128(16 * cp + c, t)) = (bf16_t)f2bf(bt * val[2][c]);
                *(LAS bf16_t*)(L + SA_KBGT + off128(16 * cp + c, t)) = (bf16_t)f2bf(bt * eg * val[1][c]);
                *(LAS bf16_t*)(L + SA_KDT + (16 * cp + c) * 128 + t * 2) = (bf16_t)f2bf(val[1][c] * ekd);
            }
        }
        __syncthreads();
#pragma unroll
        for (int q2 = 0; q2 < 2; ++q2) {
            const int id = 2 * w + q2, it = id >> 2, jt = id & 3;
            if (jt > it) {
                *(u32x2*)(QK + (size_t)ci * 4096 + (16 * it + fr) * 64 + 16 * jt + 4 * fq) = (u32x2){0u, 0u};
            } else {
                f32x4 kk = {0.f, 0.f, 0.f, 0.f}, qk = {0.f, 0.f, 0.f, 0.f};
#pragma unroll
                for (int ks = 0; ks < 4; ++ks) {
                    const bf16x8 ki = frag256(L + SA_KR, 16 * it, ks, lane), kj = frag256(L + SA_KR, 16 * jt, ks, lane), qi = frag256(L + SA_QR, 16 * it, ks, lane);
                    kk = MFMA16(ki, kj, kk);
                    qk = MFMA16(kj, qi, qk);
                }
                {
                    const int j = 16 * jt + fr; const float gj = GC[j];
#pragma unroll
                    for (int r = 0; r < 4; ++r) { const int i = 16 * it + 4 * fq + r; AM[i * 64 + j] = (i > j) ? BE[i] * kk[r] * __expf(GC[i] - gj) : 0.f; }
                }
                {
                    const int i = 16 * it + fr; const float gi = GC[i]; float o[4];
#pragma unroll
                    for (int r = 0; r < 4; ++r) { const int j = 16 * jt + 4 * fq + r; o[r] = (i >= j) ? qk[r] * __expf(gi - GC[j]) : 0.f; }
                    *(u32x2*)(QK + (size_t)ci * 4096 + i * 64 + 16 * jt + 4 * fq) = (u32x2){pk2(o[0], o[1]), pk2(o[2], o[3])};
                }
            }
        }
        __syncthreads();
        if (w == 0) {
            float Tc[64];
#pragma unroll
            for (int i = 0; i < 64; ++i) {
                float acc = (i == lane) ? 1.f : 0.f;
#pragma unroll
                for (int j = 0; j < i; j += 4) {
                    const f32x4 av = *(const LAS f32x4*)(AM + i * 64 + j);
                    acc -= av.x * Tc[j];
                    if (j + 1 < i) acc -= av.y * Tc[j + 1];
                    if (j + 2 < i) acc -= av.z * Tc[j + 2];
                    if (j + 3 < i) acc -= av.w * Tc[j + 3];
                    if ((j & 15) == 12) asm volatile("" ::: "memory");
                }
                Tc[i] = acc;
                *(LAS bf16_t*)(L + SA_TM + off128(i, lane)) = (bf16_t)f2bf(acc);
                asm volatile("" ::: "memory");
            }
        }
        __syncthreads();
        {
            const int tt = w >> 1, dh = w & 1;
            const bf16x8 t0 = frag128(L + SA_TM, 16 * tt, 0, lane), t1 = frag128(L + SA_TM, 16 * tt, 1, lane);
#pragma unroll
            for (int j = 0; j < 4; ++j) {
                const int ct = 4 * dh + j;
                f32x4 u = {0.f, 0.f, 0.f, 0.f}, wv = {0.f, 0.f, 0.f, 0.f};
                u = MFMA16(t0, frag128(L + SA_VBT, 16 * ct, 0, lane), u); u = MFMA16(t1, frag128(L + SA_VBT, 16 * ct, 1, lane), u);
                wv = MFMA16(frag128(L + SA_KBGT, 16 * ct, 0, lane), t0, wv); wv = MFMA16(frag128(L + SA_KBGT, 16 * ct, 1, lane), t1, wv);
                *(f32x4*)(UF + (((size_t)ci * 32 + tt * 8 + ct) * 64 + lane) * 4) = u;
                *(u32x2*)(WN + (size_t)ci * 8192 + (16 * tt + fr) * 128 + 16 * ct + 4 * fq) = (u32x2){pk2(-wv[0], -wv[1]), pk2(-wv[2], -wv[3])};
            }
            const LAS u32x4* ks = (const LAS u32x4*)(L + SA_KDT) + tid_o * 2; u32x4* kd = (u32x4*)(KDT + (size_t)ci * 8192) + tid_o * 2;
            kd[0] = ks[0]; kd[1] = ks[1];
            if (tid_o == 0) EG[ci] = __expf(GC[63]);
        }
    }
}

constexpr int SC_ST = 0, SC_VT = 32768, SC_OSS = 49152;
struct ScanSet { bf16x8 wn[4], qg[4], qkf[2], kdt[2]; f32x4 uf[4]; u32x2 zz[4]; float eg; };
__device__ __forceinline__ void scan_load(ScanSet& s, const unsigned char* ws, int ci, size_t m0, int h, int w, int lane) {
    const int fr = lane & 15, fq = lane >> 4, tt = w >> 1, dh = w & 1;
    const bf16_t* WN = (const bf16_t*)(ws + WS_WN) + (size_t)ci * 8192 + (16 * tt + fr) * 128 + 8 * fq;
    const bf16_t* QG = (const bf16_t*)(ws + WS_QG) + (size_t)ci * 8192 + (16 * tt + fr) * 128 + 8 * fq;
    const bf16_t* QK = (const bf16_t*)(ws + WS_QK) + (size_t)ci * 4096 + (16 * tt + fr) * 64 + 8 * fq;
    const bf16_t* KD = (const bf16_t*)(ws + WS_KDT) + (size_t)ci * 8192 + (16 * w + fr) * 64 + 8 * fq;
    const float* UF = (const float*)(ws + WS_UF) + (((size_t)ci * 32 + tt * 8 + 4 * dh) * 64 + lane) * 4;
    const bf16_t* Z = (const bf16_t*)(ws + WS_PROJ) + (m0 + 16 * tt + fr) * PROJ_N + 2560 + h * 128 + 64 * dh + 4 * fq;
#pragma unroll
    for (int ks = 0; ks < 4; ++ks) { s.wn[ks] = *(const bf16x8*)(WN + 32 * ks); s.qg[ks] = *(const bf16x8*)(QG + 32 * ks); }
#pragma unroll
    for (int ks = 0; ks < 2; ++ks) { s.qkf[ks] = *(const bf16x8*)(QK + 32 * ks); s.kdt[ks] = *(const bf16x8*)(KD + 32 * ks); }
#pragma unroll
    for (int j = 0; j < 4; ++j) { s.uf[j] = *(const f32x4*)(UF + j * 256); s.zz[j] = *(const u32x2*)(Z + 16 * j); }
    s.eg = ((const float*)(ws + WS_EG))[ci];
}
__device__ __forceinline__ void phase_scan(const Args& a, const Ctx& X) {
    if (X.bid >= 16) return;
    unsigned char* ws = a.ws; bf16_t* MIX = (bf16_t*)(ws + WS_MIXIN);
    LAS unsigned char* L = X.lds; LAS float* OSS = (LAS float*)(L + SC_OSS);
    const int bh = X.bid, b = bh >> 2, h = bh & 3, w = X.wave, lane = X.lane, fr = lane & 15, fq = lane >> 4, tt = w >> 1, dh = w & 1;
    __syncthreads();
    for (int i = X.tid; i < 2048; i += 512) ((LAS u32x4*)(L + SC_ST))[i] = (u32x4){0u, 0u, 0u, 0u};
    f32x4 Sacc[8];
#pragma unroll
    for (int j = 0; j < 8; ++j) Sacc[j] = (f32x4){0.f, 0.f, 0.f, 0.f};
    f32x4 onw[4];
#pragma unroll
    for (int j = 0; j < 4; ++j) onw[j] = *(const f32x4*)(a.gdn_onorm_w + 64 * dh + 16 * j + 4 * fq);
    ScanSet cur, nxt;
    scan_load(cur, ws, bh * 128, (size_t)b * SEQ, h, w, lane);
    __syncthreads();
    for (int n = 0; n < 128; ++n) {
        const size_t m0 = (size_t)b * SEQ + (size_t)n * 64;
        { const int n1 = n + 1 < 128 ? n + 1 : n; scan_load(nxt, ws, bh * 128 + n1, (size_t)b * SEQ + (size_t)n1 * 64, h, w, lane); }
        f32x4 vacc[4], oacc[4];
#pragma unroll
        for (int j = 0; j < 4; ++j) { vacc[j] = cur.uf[j]; oacc[j] = (f32x4){0.f, 0.f, 0.f, 0.f}; }
#pragma unroll
        for (int j = 0; j < 4; ++j)
#pragma unroll
            for (int ks = 0; ks < 4; ++ks) { const bf16x8 sb = frag256(L + SC_ST, 16 * (4 * dh + j), ks, lane); vacc[j] = MFMA16(cur.wn[ks], sb, vacc[j]); oacc[j] = MFMA16(sb, cur.qg[ks], oacc[j]); }
#pragma unroll
        for (int j = 0; j < 4; ++j) *(LAS u32x2*)(L + SC_VT + off128(16 * (4 * dh + j) + fr, 16 * tt + 4 * fq)) = (u32x2){pk2(vacc[j][0], vacc[j][1]), pk2(vacc[j][2], vacc[j][3])};
        __syncthreads();
#pragma unroll
        for (int j = 0; j < 4; ++j)
#pragma unroll
            for (int ks = 0; ks < 2; ++ks) oacc[j] = MFMA16(frag128(L + SC_VT, 16 * (4 * dh + j), ks, lane), cur.qkf[ks], oacc[j]);
#pragma unroll
        for (int j = 0; j < 8; ++j) {
            Sacc[j] = Sacc[j] * cur.eg;
#pragma unroll
            for (int ks = 0; ks < 2; ++ks) Sacc[j] = MFMA16(cur.kdt[ks], frag128(L + SC_VT, 16 * j, ks, lane), Sacc[j]);
        }
#pragma unroll
        for (int j = 0; j < 8; ++j) *(LAS u32x2*)(L + SC_ST + off256(16 * j + fr, 16 * w + 4 * fq)) = (u32x2){pk2(Sacc[j][0], Sacc[j][1]), pk2(Sacc[j][2], Sacc[j][3])};
        float ss = 0.f;
#pragma unroll
        for (int j = 0; j < 4; ++j) ss += (oacc[j][0] * oacc[j][0] + oacc[j][1] * oacc[j][1]) + (oacc[j][2] * oacc[j][2] + oacc[j][3] * oacc[j][3]);
        ss += __shfl_xor(ss, 16); ss += __shfl_xor(ss, 32);
        if (fq == 0) OSS[((n & 1) * 64 + 16 * tt + fr) * 2 + dh] = ss;
        __syncthreads();
        {
            const float tot = OSS[((n & 1) * 64 + 16 * tt + fr) * 2] + OSS[((n & 1) * 64 + 16 * tt + fr) * 2 + 1];
            const float rstd = 1.0f / sqrtf(tot * (1.f / HD) + EPS);
            bf16_t* op = MIX + (m0 + 16 * tt + fr) * DM + 512 + h * 128 + 64 * dh + 4 * fq;
#pragma unroll
            for (int j = 0; j < 4; ++j) {
                const float z0 = bflo(cur.zz[j].x), z1 = bfhi(cur.zz[j].x), z2 = bflo(cur.zz[j].y), z3 = bfhi(cur.zz[j].y);
                const float y0 = oacc[j][0] * rstd * onw[j][0] * silu_f(z0), y1 = oacc[j][1] * rstd * onw[j][1] * silu_f(z1), y2 = oacc[j][2] * rstd * onw[j][2] * silu_f(z2), y3 = oacc[j][3] * rstd * onw[j][3] * silu_f(z3);
                *(u32x2*)(op + 16 * j) = (u32x2){pk2(y0, y1), pk2(y2, y3)};
            }
        }
        cur = nxt;
    }
}

__device__ __forceinline__ void phase_onorm(const Args& a, const Ctx& X) {
    unsigned char* ws = a.ws; const bf16_t* P = (const bf16_t*)(ws + WS_PROJ); bf16_t* MIX = (bf16_t*)(ws + WS_MIXIN); const float* OR = (const float*)(ws + WS_ORAW);
    const int gw = X.bid * 8 + X.wave, NGW = X.G * 8;
    for (int m = gw; m < NTOK; m += NGW) {
        const f32x4 o0 = *(const f32x4*)(OR + (size_t)m * 512 + 8 * X.lane), o1 = *(const f32x4*)(OR + (size_t)m * 512 + 8 * X.lane + 4);
        float o[8] = {o0.x, o0.y, o0.z, o0.w, o1.x, o1.y, o1.z, o1.w}; float ss = 0.f;
#pragma unroll
        for (int j = 0; j < 8; ++j) ss += o[j] * o[j];
        ss += __shfl_xor(ss, 1); ss += __shfl_xor(ss, 2); ss += __shfl_xor(ss, 4); ss += __shfl_xor(ss, 8);
        const float rstd = 1.0f / sqrtf(ss * (1.f / HD) + EPS);
        const u32x4 zw = *(const u32x4*)(P + (size_t)m * PROJ_N + 2560 + 8 * X.lane); const unsigned zz[4] = {zw.x, zw.y, zw.z, zw.w};
        const int d0 = (8 * X.lane) & 127;
        float r[8];
#pragma unroll
        for (int j = 0; j < 8; ++j) { const float z = (j & 1) ? bfhi(zz[j >> 1]) : bflo(zz[j >> 1]); r[j] = o[j] * rstd * a.gdn_onorm_w[d0 + j] * silu_f(z); }
        *(u32x4*)(MIX + (size_t)m * DM + 512 + 8 * X.lane) = (u32x4){pk2(r[0], r[1]), pk2(r[2], r[3]), pk2(r[4], r[5]), pk2(r[6], r[7])};
    }
}

__device__ __forceinline__ void phase_route(const Args& a, const Ctx& X) {
    unsigned char* ws = a.ws; const float* L = (const float*)(ws + WS_LOGITS); int* cnt = (int*)(ws + WS_CTL); int* list = (int*)(ws + WS_LIST); int* route = (int*)(ws + WS_ROUTE);
    for (int m = X.bid * 512 + X.tid; m < NTOK; m += X.G * 512) {
        float v[32];
#pragma unroll
        for (int q = 0; q < 8; ++q) { const f32x4 t = *(const f32x4*)(L + (size_t)m * NE + 4 * q); v[4 * q] = t.x; v[4 * q + 1] = t.y; v[4 * q + 2] = t.z; v[4 * q + 3] = t.w; }
        int ei[4]; float ev[4];
#pragma unroll
        for (int k = 0; k < 4; ++k) {
            float best = -INFINITY; int bi = 0;
#pragma unroll
            for (int j = 0; j < 32; ++j) { if (v[j] > best) { best = v[j]; bi = j; } }
            ei[k] = bi; ev[k] = best;
#pragma unroll
            for (int j = 0; j < 32; ++j) if (j == bi) v[j] = -INFINITY;
        }
        float w[4]; float sum = 0.f;
#pragma unroll
        for (int k = 0; k < 4; ++k) { w[k] = __expf(ev[k] - ev[0]); sum += w[k]; }
        const float inv = 1.0f / sum;
#pragma unroll
        for (int k = 0; k < 4; ++k) {
            const int rank = atomicAdd(cnt + ei[k], 1);
            list[(size_t)ei[k] * LIST_CAP + rank] = m;
            route[(size_t)m * 12 + k] = ei[k]; route[(size_t)m * 12 + 4 + k] = rank; ((float*)route)[(size_t)m * 12 + 8 + k] = w[k] * inv;
        }
    }
}

__device__ __forceinline__ int moe_tables(const Args& a, const Ctx& X, pg8::MoeTab& T) {
    LAS int* tp = (LAS int*)(X.lds + LDS_MISC); LAS int* cn = (LAS int*)(X.lds + LDS_MISC + 256);
    const int* cnt = (const int*)(a.ws + WS_CTL);
    __syncthreads();
    if (X.tid == 0) { int acc = 0; for (int e = 0; e < NE; ++e) { const int c = cnt[e]; cn[e] = c; tp[e] = acc; acc += (c + 255) >> 8; } tp[NE] = acc; }
    __syncthreads();
    T.tp = tp; T.cnt = cn;
    return tp[NE];
}

__device__ __forceinline__ void phase_combine(const Args& a, const Ctx& X) {
    unsigned char* ws = a.ws; pg8::MoeTab T; (void)moe_tables(a, X, T);
    const float* X1 = (const float*)(ws + WS_X1); const bf16_t* Y = (const bf16_t*)(ws + WS_Y); const int* route = (const int*)(ws + WS_ROUTE); const float* mod = (const float*)(ws + WS_MOD);
    const int gw = X.bid * 8 + X.wave, NGW = X.G * 8;
    for (int m = gw; m < NTOK; m += NGW) {
        const int b = m / SEQ;
        f32x4 acc[4] = {{0, 0, 0, 0}, {0, 0, 0, 0}, {0, 0, 0, 0}, {0, 0, 0, 0}};
#pragma unroll
        for (int k = 0; k < 4; ++k) {
            const int e = route[(size_t)m * 12 + k], rank = route[(size_t)m * 12 + 4 + k]; const float w = ((const float*)route)[(size_t)m * 12 + 8 + k];
            const size_t slot = (size_t)T.tp[e] * 256 + rank;
            const u32x2* yp = (const u32x2*)(Y + slot * DM) + X.lane;
#pragma unroll
            for (int j = 0; j < 4; ++j) { const u32x2 t = yp[64 * j]; acc[j].x += w * bflo(t.x); acc[j].y += w * bfhi(t.x); acc[j].z += w * bflo(t.y); acc[j].w += w * bfhi(t.y); }
        }
        const f32x4* xr = (const f32x4*)(X1 + (size_t)m * DM) + X.lane;
        const f32x4* g2 = (const f32x4*)(mod + (size_t)b * 6144 + 5 * DM) + X.lane;
        f32x4 v[4]; float ss = 0.f;
#pragma unroll
        for (int j = 0; j < 4; ++j) { v[j] = xr[64 * j] + g2[64 * j] * acc[j]; ss += (v[j].x * v[j].x + v[j].y * v[j].y) + (v[j].z * v[j].z + v[j].w * v[j].w); }
        const float rstd = 1.0f / sqrtf(wave_sum(ss) * (1.f / DM) + EPS);
        f32x4* orow = (f32x4*)(a.out + (size_t)m * DM) + X.lane; const f32x4* nf = (const f32x4*)a.norm_f_w + X.lane;
#pragma unroll
        for (int j = 0; j < 4; ++j) orow[64 * j] = v[j] * rstd * nf[64 * j];
    }
}

enum { PH_PREP0 = 0, PH_ROWS1, PH_PROJ, PH_GMLP, PH_CONV, PH_SCAN, PH_MIX, PH_ROWS2, PH_ROUTER, PH_ROUTE, PH_MOE1, PH_MOE2, PH_COMBINE, PH_COUNT };

__global__ void __launch_bounds__(512, 2) mega(Args a) {
    extern __shared__ __attribute__((aligned(16))) unsigned char lds_raw[];
    Ctx X; X.lds = (LAS unsigned char*)lds_raw; X.tid = threadIdx.x; X.lane = X.tid & 63; X.wave = __builtin_amdgcn_readfirstlane(X.tid >> 6); X.G = gridDim.x; X.bid = blockIdx.x;
    unsigned char* ws = a.ws;
#if SINGLE_LAUNCH
    cg::grid_group grid = cg::this_grid();
#define SEAM(k) do { if (a.ph_lo <= (k) && (k) + 1 < a.ph_hi) grid.sync(); } while (0)
#else
#define SEAM(k) do { } while (0)
#endif
#ifndef PHMASK
#define PHMASK 0xffffffffu
#endif
#define IN(k) (((PHMASK >> (k)) & 1u) && a.ph_lo <= (k) && (k) < a.ph_hi)
    if (IN(PH_PREP0)) { phase_prep0(a, X); SEAM(PH_PREP0); }
    if (IN(PH_ROWS1)) { phase_rows<true>(a, X, a.x, a.norm1_w, 0, 1, (bf16_t*)(ws + WS_H)); SEAM(PH_ROWS1); }
    if (IN(PH_PROJ)) {
        __syncthreads();
        pg8::DenseSched S; S.init(ws + WS_H, ws + WS_WINT, NTOK, PROJ_N, X.G, X.bid);
        pg8::EpiProj E{(bf16_t*)(ws + WS_PROJ)};
        pg8::gemm_phase(X.lds, S, E); SEAM(PH_PROJ);
    }
    if (IN(PH_GMLP)) { phase_gmlp(a, X); SEAM(PH_GMLP); }
    if (IN(PH_CONV)) { phase_stepa(a, X); SEAM(PH_CONV); }
    if (IN(PH_SCAN)) { phase_scan(a, X); SEAM(PH_SCAN); }
    if (IN(PH_MIX)) {
        __syncthreads();
        pg8::DenseSched S; S.init(ws + WS_MIXIN, ws + WS_WOUTT, NTOK, DM, X.G, X.bid);
        pg8::EpiMix E{a.x, (const float*)(ws + WS_MOD), (float*)(ws + WS_X1)};
        pg8::gemm_phase(X.lds, S, E); SEAM(PH_MIX);
    }
    if (IN(PH_ROWS2)) { __syncthreads(); phase_rows<false>(a, X, (const float*)(ws + WS_X1), a.norm2_w, 3, 4, (bf16_t*)(ws + WS_H)); SEAM(PH_ROWS2); }
    if (IN(PH_ROUTER)) {
        __syncthreads();
        pg8::DenseSched S; S.init(ws + WS_H, ws + WS_WRT, NTOK, 256, X.G, X.bid);
        pg8::EpiLogits E{a.b_router, (float*)(ws + WS_LOGITS)};
        pg8::gemm_phase(X.lds, S, E); SEAM(PH_ROUTER);
    }
    if (IN(PH_ROUTE)) { phase_route(a, X); SEAM(PH_ROUTE); }
    if (IN(PH_MOE1)) {
        pg8::MoeTab T; const int nM = moe_tables(a, X, T);
        pg8::Moe1Sched S; S.init(ws + WS_H, ws + WS_WGUT, (const int*)(ws + WS_LIST), T, nM, X.G, X.bid);
        pg8::EpiAct E{a.b_gu, (bf16_t*)(ws + WS_ACT)};
        pg8::gemm_phase(X.lds, S, E); SEAM(PH_MOE1);
    }
    if (IN(PH_MOE2)) {
        pg8::MoeTab T; const int nM = moe_tables(a, X, T);
        pg8::Moe2Sched S; S.init(ws + WS_ACT, ws + WS_WDT, T, nM, X.G, X.bid);
        pg8::EpiY E{a.b_down, (bf16_t*)(ws + WS_Y)};
        pg8::gemm_phase(X.lds, S, E); SEAM(PH_MOE2);
    }
    if (IN(PH_COMBINE)) { phase_combine(a, X); }
#undef IN
#undef SEAM
}

extern "C" void kernel_launch(void* const* d_in, const int* in_sizes, int n_in, void* d_out, int out_size, void* d_ws, size_t ws_size, hipStream_t stream) {
    static int grid = 0;
    if (grid == 0) {
        if (n_in != 22 || out_size != NTOK * DM || ws_size < WS_END) { fprintf(stderr, "kernel_launch: unexpected shapes (n_in %d out %d ws %zu)\n", n_in, out_size, ws_size); grid = -1; return; }
        int dev = 0, cus = 0, per_cu = 0;
        hipGetDevice(&dev); hipDeviceGetAttribute(&cus, hipDeviceAttributeMultiprocessorCount, dev);
        hipFuncSetAttribute((const void*)mega, hipFuncAttributeMaxDynamicSharedMemorySize, LDS_BYTES);
        hipOccupancyMaxActiveBlocksPerMultiprocessor(&per_cu, (const void*)mega, 512, LDS_BYTES);
        if (per_cu < 1) { fprintf(stderr, "kernel_launch: occupancy query says %d blocks per CU\n", per_cu); }
        (void)hipGetLastError();
        grid = cus > 0 ? cus : 256;
    }
    if (grid < 0) return;
    hipMemsetAsync((char*)d_ws + WS_CTL, 0, 4096, stream);
    Args a{};
    const float** p = (const float**)&a;
    for (int i = 0; i < 22; ++i) p[i] = (const float*)d_in[i];
    a.out = (float*)d_out; a.ws = (unsigned char*)d_ws;
#if SINGLE_LAUNCH
    a.ph_lo = 0; a.ph_hi = PH_COUNT;
    void* args[] = {&a};
    hipError_t e = hipLaunchCooperativeKernel((const void*)mega, dim3(grid), dim3(512), args, LDS_BYTES, stream);
    if (e != hipSuccess) fprintf(stderr, "cooperative launch failed: %s (grid %d)\n", hipGetErrorString(e), grid);
#else
    for (int ph = 0; ph < PH_COUNT; ++ph) { a.ph_lo = ph; a.ph_hi = ph + 1; hipLaunchKernelGGL(mega, dim3(grid), dim3(512), LDS_BYTES, stream, a); }
#endif
}
```

```cpp
#include <hip/hip_runtime.h>
#include <cstdio>
#include <cstdint>

#ifndef SINGLE_LAUNCH
#define SINGLE_LAUNCH 1
#endif
#if SINGLE_LAUNCH
#include <hip/hip_cooperative_groups.h>
namespace cg = cooperative_groups;
#endif

#define LAS __attribute__((address_space(3)))
typedef unsigned short bf16_t;
typedef short bf16x8 __attribute__((ext_vector_type(8)));
typedef float f32x4 __attribute__((ext_vector_type(4)));
typedef float f32x2 __attribute__((ext_vector_type(2)));
typedef unsigned u32x4 __attribute__((ext_vector_type(4)));
typedef unsigned u32x2 __attribute__((ext_vector_type(2)));

constexpr int DM = 1024, NB = 4, SEQ = 8192, NTOK = NB * SEQ;
constexpr int GM_G = 4, GM_D = 128, GM_W = 512, GM_C = 128;
constexpr int NH = 4, HD = 128, QKW = 512, VW = 512, CONVK = 4;
constexpr int IN_COLS = 3080, PROJ_N = 3072;
constexpr int NE = 32, TOPK = 4, DFF = 1024;
constexpr float EPS = 1e-6f;
constexpr int LIST_CAP = NTOK;
constexpr int MAX_SLOTS = NTOK * TOPK + NE * 256;

constexpr size_t MiB = 1u << 20;
constexpr size_t WS_CTL = 0;
constexpr size_t WS_MOD = 1 * MiB;
constexpr size_t WS_G = 2 * MiB;
constexpr size_t WS_BETA = 3 * MiB;
constexpr size_t WS_ROUTE = 4 * MiB;
constexpr size_t WS_LIST = 6 * MiB;
constexpr size_t WS_LOGITS = 10 * MiB;
constexpr size_t WS_WRT = 14 * MiB;
constexpr size_t WS_WOUTT = 16 * MiB;
constexpr size_t WS_WINT = 18 * MiB;
constexpr size_t WS_WGUT = 24 * MiB;
constexpr size_t WS_WDT = 152 * MiB;
constexpr size_t WS_X1 = 216 * MiB;
constexpr size_t WS_H = 344 * MiB;
constexpr size_t WS_PROJ = 408 * MiB;
constexpr size_t WS_MIXIN = 600 * MiB;
constexpr size_t WS_QN = 664 * MiB;
constexpr size_t WS_KN = 728 * MiB;
constexpr size_t WS_VN = 792 * MiB;
constexpr size_t WS_ORAW = 856 * MiB;
constexpr size_t WS_WN = 664 * MiB;
constexpr size_t WS_QG = 696 * MiB;
constexpr size_t WS_KDT = 728 * MiB;
constexpr size_t WS_QK = 760 * MiB;
constexpr size_t WS_UF = 776 * MiB;
constexpr size_t WS_EG = 840 * MiB;
constexpr size_t WS_ACT = 408 * MiB;
constexpr size_t WS_Y = 680 * MiB;
constexpr size_t WS_END = 952 * MiB;

constexpr int LDS_BYTES = 147456;
constexpr int LDS_MISC = 131072;
constexpr int LDS_BARST = LDS_MISC + 1024;
constexpr size_t CTL_BAR = 4096;
constexpr size_t CTL_ZERO = 32768;

__device__ __forceinline__ unsigned f2bf(float f) { unsigned u = __builtin_bit_cast(unsigned, f); return (u + 0x7fffu + ((u >> 16) & 1u)) >> 16; }
__device__ __forceinline__ unsigned pk2(float lo, float hi) { return f2bf(lo) | (f2bf(hi) << 16); }
__device__ __forceinline__ float bflo(unsigned w) { return __builtin_bit_cast(float, w << 16); }
__device__ __forceinline__ float bfhi(unsigned w) { return __builtin_bit_cast(float, w & 0xffff0000u); }
__device__ __forceinline__ float wave_sum(float v) {
#pragma unroll
    for (int o = 1; o < 64; o <<= 1) v += __shfl_xor(v, o);
    return v;
}
__device__ __forceinline__ float silu_f(float x) { return x / (1.f + __expf(-x)); }
__device__ __forceinline__ float sigmoid_f(float x) { return 1.f / (1.f + __expf(-x)); }

namespace pg8 {
constexpr int BM = 256, BK = 64, HALF = 128, HTB = HALF * BK * 2, STAGE_BYTES = 8 * HTB, NXCD = 8, WGM = 8, KD = 1024;
__host__ __device__ __forceinline__ int lds_byte(int r, int c) { const int st = (r >> 4) * 2 + (c >> 5), rr = r & 15, cc = c & 31, ob = rr * 64 + cc * 2; return st * 1024 + (ob ^ (((ob >> 9) & 1) << 5)); }
__host__ __device__ __forceinline__ void stage_rc(int b, int& R, int& C) { const int st = b / 1024, sb = b % 1024, swz = sb ^ (((sb >> 9) & 1) << 5); R = (st >> 1) * 16 + swz / 64; C = (st & 1) * 32 + (swz % 64) / 2; }
__host__ __device__ __forceinline__ int perm32(int rho) { const int n = rho >> 4, i = rho & 15; return 8 * (i >> 2) + 4 * n + (i & 3); }

struct Unit { const char* A; const char* B0; const char* B1; unsigned vA0[2], vA1[2]; int pm, pn, e; };

__device__ __forceinline__ bool tile_order(int i, int G, int c, int nM, int nN, int& pm, int& pn) {
    const int nwg = nM * nN; const long L = (long)i * G + c; if (L >= nwg) return false;
    int wgid = (int)L; { const int q = nwg / NXCD, r = nwg % NXCD, xcd = wgid % NXCD, off = wgid / NXCD; wgid = (xcd < r ? xcd * (q + 1) : r * (q + 1) + (xcd - r) * q) + off; }
    const int nig = WGM * nN, gid = wgid / nig, fm = gid * WGM, gsz = (nM - fm) < WGM ? (nM - fm) : WGM;
    pm = fm + ((wgid % nig) % gsz); pn = (wgid % nig) / gsz; return true;
}

__device__ __forceinline__ unsigned cvt_pk_bf16(float lo, float hi) { unsigned r; asm volatile("v_cvt_pk_bf16_f32 %0, %1, %2" : "=v"(r) : "v"(lo), "v"(hi)); return r; }
__device__ __forceinline__ f32x2 gelu_pk(f32x2 v) {
    const f32x2 av = __builtin_elementwise_abs(v), d = av * 0.2316418882f + 1.0f;
    f32x2 t; t.x = __builtin_amdgcn_rcpf(d.x); t.y = __builtin_amdgcn_rcpf(d.y);
    f32x2 q = t * 0.5307027145f + (-0.7265760135f); q = q * t + 0.7107068705f; q = q * t + (-0.142248368f); q = q * t + 0.127414796f; q = q * t;
    const f32x2 s = (v * v) * (-0.72134752044f);
    f32x2 e; e.x = __builtin_amdgcn_exp2f(s.x); e.y = __builtin_amdgcn_exp2f(s.y);
    const f32x2 m = v * (q * e), r = v - m;
    f32x2 o; o.x = v.x < 0.f ? m.x : r.x; o.y = v.y < 0.f ? m.y : r.y; return o;
}

template <class Epi, class Sched>
__device__ __forceinline__ void gemm_phase(LAS unsigned char* lds, const Sched& S, const Epi& E) {
    const int tid = threadIdx.x, wid = __builtin_amdgcn_readfirstlane(tid >> 6), lane = tid & 63, wr = wid >> 2, wc = wid & 3, fr = lane & 15, fq = lane >> 4;
    constexpr int K = KD, nt = K / BK;
    unsigned voffB[2];
#pragma unroll
    for (int i = 0; i < 2; ++i) { int R, C; stage_rc(tid * 16 + i * 8192, R, C); const int Rb = Epi::PERM ? ((R & ~31) + perm32(R & 31)) : R; voffB[i] = (unsigned)(Rb * K + C) * 2u; }
    const size_t kstep = (size_t)(BK * 2);
    const unsigned ldsw = (unsigned)wid * 1024u;
    const int aoff = lds_byte(wr * 64 + fr, fq * 8), boff = lds_byte(wc * 32 + fr, fq * 8);
#define PG8_SA(b, h) (((b) * 2 + (h)) * HTB)
#define PG8_SB(b, h) ((4 + (b) * 2 + (h)) * HTB)
#define PG8_STAGE(bufoff, gbase, voff) do { _Pragma("unroll") for (int _i = 0; _i < 2; ++_i) \
        __builtin_amdgcn_global_load_lds((const unsigned*)((const char*)(gbase) + (voff)[_i]), (LAS unsigned*)(lds + (bufoff) + ldsw + _i * 8192), 16, 0, 0); } while (0)
#define PG8_LDA(dst, b, h) do { _Pragma("unroll") for (int m = 0; m < 4; ++m) _Pragma("unroll") for (int k = 0; k < 2; ++k) dst[m][k] = *(const LAS bf16x8*)(lds + PG8_SA(b, h) + aoff + m * 2048 + k * 1024); } while (0)
#define PG8_LDB(dst, b, h) do { _Pragma("unroll") for (int n = 0; n < 2; ++n) _Pragma("unroll") for (int k = 0; k < 2; ++k) dst[n][k] = *(const LAS bf16x8*)(lds + PG8_SB(b, h) + boff + n * 2048 + k * 1024); } while (0)
#define PG8_MMA(ai, bj, At, Bt) do { __builtin_amdgcn_s_setprio(1); _Pragma("unroll") for (int m = 0; m < 4; ++m) _Pragma("unroll") for (int n = 0; n < 2; ++n) _Pragma("unroll") for (int k = 0; k < 2; ++k) \
        acc[ai][bj][m][n] = __builtin_amdgcn_mfma_f32_16x16x32_bf16(Bt[n][k], At[m][k], acc[ai][bj][m][n], 0, 0, 0); __builtin_amdgcn_s_setprio(0); } while (0)
#define PG8_WAIT_V(n) asm volatile("s_waitcnt vmcnt(" #n ")" ::: "memory")
#define PG8_WAIT_L(n) asm volatile("s_waitcnt lgkmcnt(" #n ")" ::: "memory")
#define PG8_BAR __builtin_amdgcn_s_barrier()
#define PG8_SCHED __builtin_amdgcn_sched_barrier(0)
    Unit cur, nxt; int ui = 0;
    if (!S.next(0, cur)) return;
    f32x4 acc[2][2][4][2];
#pragma unroll
    for (int a = 0; a < 2; ++a)
#pragma unroll
        for (int b = 0; b < 2; ++b)
#pragma unroll
            for (int m = 0; m < 4; ++m)
#pragma unroll
                for (int n = 0; n < 2; ++n) acc[a][b][m][n] = (f32x4){0.f, 0.f, 0.f, 0.f};
    bf16x8 At[4][2], B0[2][2], B1[2][2];
    PG8_STAGE(PG8_SB(0, 0), cur.B0, voffB); PG8_STAGE(PG8_SB(0, 1), cur.B1, voffB); PG8_STAGE(PG8_SA(0, 0), cur.A, cur.vA0); PG8_STAGE(PG8_SA(0, 1), cur.A, cur.vA1);
    if (wr == 1) PG8_BAR;
    PG8_WAIT_V(2); PG8_BAR;
    PG8_STAGE(PG8_SB(1, 0), cur.B0 + kstep, voffB); PG8_STAGE(PG8_SA(1, 0), cur.A + kstep, cur.vA0); PG8_STAGE(PG8_SB(1, 1), cur.B1 + kstep, voffB);
    PG8_WAIT_V(6); PG8_BAR;
    for (;;) {
        const bool has_next = S.next(ui + 1, nxt);
        for (int t = 0; t < nt; t += 2) {
            const bool last = (t == nt - 2);
            const bool fromn = last && has_next;
            const size_t ko = last ? 0 : (size_t)(t + 2) * kstep;
            const char* a2 = (fromn ? nxt.A : cur.A) + ko; const char* b20 = (fromn ? nxt.B0 : cur.B0) + ko; const char* b21 = (fromn ? nxt.B1 : cur.B1) + ko;
            unsigned w0[2], w1[2];
#pragma unroll
            for (int i = 0; i < 2; ++i) { w0[i] = fromn ? nxt.vA0[i] : cur.vA0[i]; w1[i] = fromn ? nxt.vA1[i] : cur.vA1[i]; }
            const char* a1 = cur.A + (size_t)(t + 1) * kstep;
            PG8_LDB(B0, 0, 0); PG8_LDB(B1, 0, 1); PG8_SCHED; PG8_LDA(At, 0, 0); PG8_STAGE(PG8_SA(1, 1), a1, cur.vA1);
            PG8_WAIT_V(8); PG8_WAIT_L(0); PG8_BAR; PG8_MMA(0, 0, At, B0); PG8_MMA(0, 1, At, B1); PG8_BAR; PG8_SCHED;
            PG8_LDA(At, 0, 1); PG8_STAGE(PG8_SB(0, 0), b20, voffB); PG8_STAGE(PG8_SB(0, 1), b21, voffB); PG8_STAGE(PG8_SA(0, 0), a2, w0);
            PG8_WAIT_V(8); PG8_WAIT_L(0); PG8_BAR; PG8_MMA(1, 0, At, B0); PG8_MMA(1, 1, At, B1); PG8_BAR; PG8_SCHED;
            PG8_LDB(B0, 1, 0); PG8_LDB(B1, 1, 1); PG8_SCHED; PG8_LDA(At, 1, 0); PG8_STAGE(PG8_SA(0, 1), a2, w1);
            PG8_WAIT_V(8); PG8_WAIT_L(0); PG8_BAR; PG8_MMA(0, 0, At, B0); PG8_MMA(0, 1, At, B1); PG8_BAR; PG8_SCHED;
            PG8_LDA(At, 1, 1); PG8_STAGE(PG8_SB(1, 0), b20 + kstep, voffB); PG8_STAGE(PG8_SB(1, 1), b21 + kstep, voffB); PG8_STAGE(PG8_SA(1, 0), a2 + kstep, w0);
            PG8_WAIT_V(8); PG8_WAIT_L(0); PG8_BAR; PG8_MMA(1, 0, At, B0); PG8_MMA(1, 1, At, B1); PG8_BAR; PG8_SCHED;
        }
        if (wr == 0) PG8_BAR;
        E(acc, cur, wr, wc, fr, fq);
        if (!has_next) break;
#pragma unroll
        for (int a = 0; a < 2; ++a)
#pragma unroll
            for (int b = 0; b < 2; ++b)
#pragma unroll
                for (int m = 0; m < 4; ++m)
#pragma unroll
                    for (int n = 0; n < 2; ++n) acc[a][b][m][n] = (f32x4){0.f, 0.f, 0.f, 0.f};
        cur = nxt; ++ui;
        if (wr == 1) PG8_BAR;
    }
    PG8_WAIT_V(0);
    PG8_BAR;
#undef PG8_SA
#undef PG8_SB
#undef PG8_STAGE
#undef PG8_LDA
#undef PG8_LDB
#undef PG8_MMA
#undef PG8_WAIT_V
#undef PG8_WAIT_L
#undef PG8_BAR
#undef PG8_SCHED
}

struct DenseSched {
    const char* A; const char* Bt; int nM, nN, G, c; int R[2], C[2];
    __device__ __forceinline__ void init(const void* A_, const void* Bt_, int M, int N, int G_, int c_) {
        A = (const char*)A_; Bt = (const char*)Bt_; nM = M / BM; nN = N / BM; G = G_; c = c_;
#pragma unroll
        for (int i = 0; i < 2; ++i) stage_rc((int)threadIdx.x * 16 + i * 8192, R[i], C[i]);
    }
    __device__ __forceinline__ bool next(int i, Unit& u) const {
        int pm, pn; if (!tile_order(i, G, c, nM, nN, pm, pn)) return false;
        u.pm = pm; u.pn = pn; u.e = 0; u.A = A; u.B0 = Bt + (size_t)pn * 256 * KD * 2; u.B1 = u.B0 + (size_t)128 * KD * 2;
#pragma unroll
        for (int i2 = 0; i2 < 2; ++i2) { u.vA0[i2] = (unsigned)(((pm * 256 + R[i2]) * KD + C[i2]) * 2); u.vA1[i2] = u.vA0[i2] + 128u * KD * 2u; }
        return true;
    }
};
struct MoeTab { const LAS int* tp; const LAS int* cnt; };
__device__ __forceinline__ int moe_find(const MoeTab& T, int pm) { int e = 0; while (e < NE - 1 && T.tp[e + 1] <= pm) ++e; return e; }
struct Moe1Sched {
    const char* A; const char* Bt; const int* list; MoeTab T; int nM, nN, G, c; int R[2], C[2];
    __device__ __forceinline__ void init(const void* A_, const void* Bt_, const int* list_, MoeTab T_, int nM_, int G_, int c_) {
        A = (const char*)A_; Bt = (const char*)Bt_; list = list_; T = T_; nM = nM_; nN = 8; G = G_; c = c_;
#pragma unroll
        for (int i = 0; i < 2; ++i) stage_rc((int)threadIdx.x * 16 + i * 8192, R[i], C[i]);
    }
    __device__ __forceinline__ bool next(int i, Unit& u) const {
        int pm, pn; if (!tile_order(i, G, c, nM, nN, pm, pn)) return false;
        const int e = moe_find(T, pm), ml = pm - T.tp[e], ce = T.cnt[e];
        u.pm = pm; u.pn = pn; u.e = e; u.A = A;
        u.B0 = Bt + ((size_t)e * 2048 + 128 * pn) * KD * 2; u.B1 = Bt + ((size_t)e * 2048 + 1024 + 128 * pn) * KD * 2;
#pragma unroll
        for (int i2 = 0; i2 < 2; ++i2) {
            const int i0 = ml * 256 + R[i2], i1 = i0 + 128;
            const int t0 = i0 < ce ? list[(size_t)e * LIST_CAP + i0] : 0, t1 = i1 < ce ? list[(size_t)e * LIST_CAP + i1] : 0;
            u.vA0[i2] = (unsigned)((t0 * KD + C[i2]) * 2); u.vA1[i2] = (unsigned)((t1 * KD + C[i2]) * 2);
        }
        asm volatile("" : "+v"(u.vA0[0]), "+v"(u.vA0[1]), "+v"(u.vA1[0]), "+v"(u.vA1[1]));
        return true;
    }
};
struct Moe2Sched {
    const char* A; const char* Bt; MoeTab T; int nM, nN, G, c; int R[2], C[2];
    __device__ __forceinline__ void init(const void* A_, const void* Bt_, MoeTab T_, int nM_, int G_, int c_) {
        A = (const char*)A_; Bt = (const char*)Bt_; T = T_; nM = nM_; nN = 4; G = G_; c = c_;
#pragma unroll
        for (int i = 0; i < 2; ++i) stage_rc((int)threadIdx.x * 16 + i * 8192, R[i], C[i]);
    }
    __device__ __forceinline__ bool next(int i, Unit& u) const {
        int pm, pn; if (!tile_order(i, G, c, nM, nN, pm, pn)) return false;
        const int e = moe_find(T, pm);
        u.pm = pm; u.pn = pn; u.e = e; u.A = A;
        u.B0 = Bt + ((size_t)e * 1024 + 256 * pn) * KD * 2; u.B1 = u.B0 + (size_t)128 * KD * 2;
#pragma unroll
        for (int i2 = 0; i2 < 2; ++i2) { u.vA0[i2] = (unsigned)(((pm * 256 + R[i2]) * KD + C[i2]) * 2); u.vA1[i2] = u.vA0[i2] + 128u * KD * 2u; }
        return true;
    }
};

struct EpiProj {
    static constexpr bool PERM = true;
    bf16_t* O;
    __device__ __forceinline__ void operator()(const f32x4 (&acc)[2][2][4][2], const Unit& u, int wr, int wc, int fr, int fq) const {
        const int row0 = u.pm * BM + wr * 64 + fr, col0 = u.pn * BM + wc * 32 + 8 * fq; const bool act = u.pn < 4;
#pragma unroll
        for (int ai = 0; ai < 2; ++ai)
#pragma unroll
            for (int m = 0; m < 4; ++m) { bf16_t* rowp = O + (size_t)(row0 + ai * HALF + m * 16) * PROJ_N + col0;
#pragma unroll
                for (int bj = 0; bj < 2; ++bj) { f32x4 v0 = acc[ai][bj][m][0], v1 = acc[ai][bj][m][1];
                    if (act) { f32x2 a = gelu_pk((f32x2){v0[0], v0[1]}), b = gelu_pk((f32x2){v0[2], v0[3]}), c = gelu_pk((f32x2){v1[0], v1[1]}), d = gelu_pk((f32x2){v1[2], v1[3]});
                        v0 = (f32x4){a.x, a.y, b.x, b.y}; v1 = (f32x4){c.x, c.y, d.x, d.y}; }
                    u32x4 w; w.x = cvt_pk_bf16(v0[0], v0[1]); w.y = cvt_pk_bf16(v0[2], v0[3]); w.z = cvt_pk_bf16(v1[0], v1[1]); w.w = cvt_pk_bf16(v1[2], v1[3]);
                    *(u32x4*)(rowp + bj * HALF) = w; } }
    }
};
struct EpiMix {
    static constexpr bool PERM = false;
    const float* x; const float* mod; float* X1;
    __device__ __forceinline__ void operator()(const f32x4 (&acc)[2][2][4][2], const Unit& u, int wr, int wc, int fr, int fq) const {
        const int row0 = u.pm * BM + wr * 64 + fr, col0 = u.pn * BM + wc * 32 + 4 * fq;
        const int b = (u.pm * BM) / SEQ; const float* g1 = mod + (size_t)b * 6 * DM + 2 * DM;
        f32x4 gv[2][2];
#pragma unroll
        for (int bj = 0; bj < 2; ++bj)
#pragma unroll
            for (int n = 0; n < 2; ++n) gv[bj][n] = *(const f32x4*)(g1 + col0 + bj * HALF + n * 16);
#pragma unroll
        for (int ai = 0; ai < 2; ++ai)
#pragma unroll
            for (int m = 0; m < 4; ++m) { const size_t off = (size_t)(row0 + ai * HALF + m * 16) * DM + col0;
#pragma unroll
                for (int bj = 0; bj < 2; ++bj)
#pragma unroll
                    for (int n = 0; n < 2; ++n) { const f32x4 xv = *(const f32x4*)(x + off + bj * HALF + n * 16); *(f32x4*)(X1 + off + bj * HALF + n * 16) = xv + gv[bj][n] * acc[ai][bj][m][n]; }
                asm volatile("" ::: "memory"); }
    }
};
struct EpiLogits {
    static constexpr bool PERM = false;
    const float* br; float* L;
    __device__ __forceinline__ void operator()(const f32x4 (&acc)[2][2][4][2], const Unit& u, int wr, int wc, int fr, int fq) const {
        if (wc != 0) return;
        const int row0 = u.pm * BM + wr * 64 + fr;
#pragma unroll
        for (int ai = 0; ai < 2; ++ai)
#pragma unroll
            for (int m = 0; m < 4; ++m)
#pragma unroll
                for (int n = 0; n < 2; ++n) { const int c = 16 * n + 4 * fq; const f32x4 bv = *(const f32x4*)(br + c);
                    *(f32x4*)(L + (size_t)(row0 + ai * HALF + m * 16) * NE + c) = acc[ai][0][m][n] + bv; }
    }
};
struct EpiAct {
    static constexpr bool PERM = true;
    const float* bgu; bf16_t* O;
    __device__ __forceinline__ void operator()(const f32x4 (&acc)[2][2][4][2], const Unit& u, int wr, int wc, int fr, int fq) const {
        const int row0 = u.pm * BM + wr * 64 + fr, f0 = u.pn * 128 + wc * 32 + 8 * fq;
        const float* bg = bgu + (size_t)u.e * 2048 + f0; const float* bu = bg + 1024;
        const f32x4 bg0 = *(const f32x4*)bg, bg1 = *(const f32x4*)(bg + 4), bu0 = *(const f32x4*)bu, bu1 = *(const f32x4*)(bu + 4);
#pragma unroll
        for (int ai = 0; ai < 2; ++ai)
#pragma unroll
            for (int m = 0; m < 4; ++m) {
                float r[8];
#pragma unroll
                for (int n = 0; n < 2; ++n)
#pragma unroll
                    for (int j = 0; j < 4; ++j) {
                        float g = acc[ai][0][m][n][j] + (n ? bg1[j] : bg0[j]), up = acc[ai][1][m][n][j] + (n ? bu1[j] : bu0[j]);
                        g = fminf(g, 7.0f); up = fminf(fmaxf(up, -7.0f), 7.0f);
                        r[n * 4 + j] = g * sigmoid_f(1.702f * g) * (up + 1.0f);
                    }
                u32x4 w; w.x = cvt_pk_bf16(r[0], r[1]); w.y = cvt_pk_bf16(r[2], r[3]); w.z = cvt_pk_bf16(r[4], r[5]); w.w = cvt_pk_bf16(r[6], r[7]);
                *(u32x4*)(O + (size_t)(row0 + ai * HALF + m * 16) * DFF + f0) = w;
            }
    }
};
struct EpiY {
    static constexpr bool PERM = true;
    const float* bd; bf16_t* O;
    __device__ __forceinline__ void operator()(const f32x4 (&acc)[2][2][4][2], const Unit& u, int wr, int wc, int fr, int fq) const {
        const int row0 = u.pm * BM + wr * 64 + fr, col0 = u.pn * BM + wc * 32 + 8 * fq;
        const float* b = bd + (size_t)u.e * DM + col0;
        f32x4 bv[2][2];
#pragma unroll
        for (int bj = 0; bj < 2; ++bj)
#pragma unroll
            for (int n = 0; n < 2; ++n) bv[bj][n] = *(const f32x4*)(b + bj * HALF + 4 * n);
#pragma unroll
        for (int ai = 0; ai < 2; ++ai)
#pragma unroll
            for (int m = 0; m < 4; ++m) { bf16_t* rowp = O + (size_t)(row0 + ai * HALF + m * 16) * DM + col0;
#pragma unroll
                for (int bj = 0; bj < 2; ++bj) { const f32x4 v0 = acc[ai][bj][m][0] + bv[bj][0], v1 = acc[ai][bj][m][1] + bv[bj][1];
                    u32x4 w; w.x = cvt_pk_bf16(v0[0], v0[1]); w.y = cvt_pk_bf16(v0[2], v0[3]); w.z = cvt_pk_bf16(v1[0], v1[1]); w.w = cvt_pk_bf16(v1[2], v1[3]);
                    *(u32x4*)(rowp + bj * HALF) = w; } }
    }
};
}

struct Args {
    const float *x, *c, *w_ada, *b_ada, *norm1_w, *w_in, *gm_vnorm_w, *gm_w_spatial, *gm_b_spatial, *gdn_conv_w, *gdn_a_log, *gdn_dt_bias, *gdn_onorm_w,
        *w_out, *norm2_w, *w_router, *b_router, *w_gu, *b_gu, *w_down, *b_down, *norm_f_w;
    float* out; unsigned char* ws; int ph_lo, ph_hi;
};

struct Ctx { LAS unsigned char* lds; int tid, lane, wave, G, bid; };

__device__ __forceinline__ void transpose_item(const float* W, int ld, bf16_t* WT, int Kp, int k0, int n0, int row_off, LAS float* scr, int lane) {
#pragma unroll 8
    for (int i = 0; i < 32; ++i) { const int kk = 2 * i + (lane >> 5); scr[kk * 33 + (lane & 31)] = W[(size_t)(k0 + kk) * ld + n0 + (lane & 31)]; }
    asm volatile("s_waitcnt lgkmcnt(0)" ::: "memory");
    const int c = lane & 7;
#pragma unroll
    for (int j = 0; j < 4; ++j) { const int n = (lane >> 3) + 8 * j; const LAS float* s = scr + (8 * c) * 33 + n;
        u32x4 o; o.x = pk2(s[0 * 33], s[1 * 33]); o.y = pk2(s[2 * 33], s[3 * 33]); o.z = pk2(s[4 * 33], s[5 * 33]); o.w = pk2(s[6 * 33], s[7 * 33]);
        *(u32x4*)(WT + (size_t)(row_off + n0 + n) * Kp + k0 + 8 * c) = o; }
    asm volatile("s_waitcnt lgkmcnt(0)" ::: "memory");
}

__device__ __forceinline__ void phase_prep0(const Args& a, const Ctx& X) {
    unsigned char* ws = a.ws;
    {
        LAS float* cact = (LAS float*)X.lds;
        LAS f32x4* part = (LAS f32x4*)(X.lds + 16384);
        for (int i = X.tid; i < NB * DM; i += 512) cact[i] = silu_f(a.c[i]);
        __syncthreads();
        float* mod = (float*)(ws + WS_MOD);
        for (int cgp = X.bid; cgp < 256; cgp += X.G) {
            const int j0 = 24 * cgp;
            if (X.tid < 384) {
                const int q = X.tid % 6, kc = X.tid / 6;
                f32x4 s[4] = {{0, 0, 0, 0}, {0, 0, 0, 0}, {0, 0, 0, 0}, {0, 0, 0, 0}};
#pragma unroll 4
                for (int kk = 0; kk < 16; ++kk) { const int k = kc * 16 + kk; const f32x4 w = *(const f32x4*)(a.w_ada + (size_t)k * 6144 + j0 + 4 * q);
#pragma unroll
                    for (int b = 0; b < 4; ++b) s[b] += w * cact[b * DM + k]; }
#pragma unroll
                for (int b = 0; b < 4; ++b) part[(kc * 4 + b) * 6 + q] = s[b];
            }
            __syncthreads();
            if (X.tid < 96) { const int b = X.tid / 24, col = X.tid % 24; float s = 0.f;
                for (int kc = 0; kc < 64; ++kc) s += part[(kc * 4 + b) * 6 + (col >> 2)][col & 3];
                mod[b * 6144 + j0 + col] = s + a.b_ada[j0 + col]; }
            __syncthreads();
        }
    }
    {
        LAS float* scr = (LAS float*)(X.lds + X.wave * 16384);
        const int gw = X.bid * 8 + X.wave, NGW = X.G * 8;
        bf16_t* WinT = (bf16_t*)(ws + WS_WINT); bf16_t* WoutT = (bf16_t*)(ws + WS_WOUTT); bf16_t* WrT = (bf16_t*)(ws + WS_WRT);
        bf16_t* WguT = (bf16_t*)(ws + WS_WGUT); bf16_t* WdT = (bf16_t*)(ws + WS_WDT);
        constexpr int I_IN = 16 * 96, I_OUT = 16 * 32, I_R = 16, I_GU = 32 * 16 * 64, I_D = 32 * 16 * 32;
        constexpr int NITEMS = I_IN + I_OUT + I_R + I_GU + I_D;
        for (int it = gw; it < NITEMS; it += NGW) {
            int r = it;
            if (r < I_IN) { transpose_item(a.w_in, IN_COLS, WinT, DM, 64 * (r / 96), 32 * (r % 96), 0, scr, X.lane); continue; } r -= I_IN;
            if (r < I_OUT) { transpose_item(a.w_out, DM, WoutT, DM, 64 * (r / 32), 32 * (r % 32), 0, scr, X.lane); continue; } r -= I_OUT;
            if (r < I_R) { transpose_item(a.w_router, NE, WrT, DM, 64 * r, 0, 0, scr, X.lane); continue; } r -= I_R;
            if (r < I_GU) { const int e = r / 1024, q = r % 1024; transpose_item(a.w_gu + (size_t)e * DM * 2048, 2048, WguT + (size_t)e * 2048 * DM, DM, 64 * (q / 64), 32 * (q % 64), 0, scr, X.lane); continue; } r -= I_GU;
            { const int e = r / 512, q = r % 512; transpose_item(a.w_down + (size_t)e * DFF * DM, DM, WdT + (size_t)e * DM * DFF, DFF, 64 * (q / 32), 32 * (q % 32), 0, scr, X.lane); }
        }
        u32x4* z = (u32x4*)(WrT + 32 * DM); const int nz = 224 * DM * 2 / 16;
        for (int i = X.bid * 512 + X.tid; i < nz; i += X.G * 512) z[i] = (u32x4){0u, 0u, 0u, 0u};
    }
}

template <bool AB>
__device__ __forceinline__ void phase_rows(const Args& a, const Ctx& X, const float* src, const float* nw, int sh_idx, int sc_idx, bf16_t* dst) {
    unsigned char* ws = a.ws; const float* mod = (const float*)(ws + WS_MOD);
    LAS float* scl = (LAS float*)X.lds;
    LAS float* shf = scl + 4 * DM;
    LAS float* w8 = shf + 4 * DM;
    for (int i = X.tid; i < NB * DM; i += 512) { const int b = i >> 10, k = i & 1023; scl[i] = nw[k] * (1.f + mod[b * 6144 + sc_idx * DM + k]); shf[i] = mod[b * 6144 + sh_idx * DM + k]; }
    if (AB) for (int i = X.tid; i < DM * 8; i += 512) w8[i] = a.w_in[(size_t)(i >> 3) * IN_COLS + PROJ_N + (i & 7)];
    __syncthreads();
    float* G = (float*)(ws + WS_G); float* BT = (float*)(ws + WS_BETA);
    const int gw = X.bid * 8 + X.wave, NGW = X.G * 8;
    for (int m = gw; m < NTOK; m += NGW) {
        const int b = m / SEQ;
        const f32x4* xr = (const f32x4*)(src + (size_t)m * DM) + X.lane;
        f32x4 v[4]; float ss = 0.f;
#pragma unroll
        for (int j = 0; j < 4; ++j) { v[j] = xr[64 * j]; ss += (v[j].x * v[j].x + v[j].y * v[j].y) + (v[j].z * v[j].z + v[j].w * v[j].w); }
        const float rstd = 1.0f / sqrtf(wave_sum(ss) * (1.f / DM) + EPS);
        float ab[8] = {0, 0, 0, 0, 0, 0, 0, 0};
        unsigned long long* o8 = (unsigned long long*)(dst + (size_t)m * DM) + X.lane;
#pragma unroll
        for (int j = 0; j < 4; ++j) {
            const int k0 = 4 * X.lane + 256 * j;
            const f32x4 sc = *(const LAS f32x4*)(scl + b * DM + k0), sf = *(const LAS f32x4*)(shf + b * DM + k0);
            const f32x4 h = v[j] * rstd * sc + sf;
            o8[64 * j] = (unsigned long long)pk2(h.x, h.y) | ((unsigned long long)pk2(h.z, h.w) << 32);
            if (AB) {
#pragma unroll
                for (int e = 0; e < 4; ++e) { const f32x4 wa = *(const LAS f32x4*)(w8 + (k0 + e) * 8), wb = *(const LAS f32x4*)(w8 + (k0 + e) * 8 + 4);
                    ab[0] += h[e] * wa.x; ab[1] += h[e] * wa.y; ab[2] += h[e] * wa.z; ab[3] += h[e] * wa.w; ab[4] += h[e] * wb.x; ab[5] += h[e] * wb.y; ab[6] += h[e] * wb.z; ab[7] += h[e] * wb.w; }
            }
        }
        if (AB) {
#pragma unroll
            for (int e = 0; e < 8; ++e) ab[e] = wave_sum(ab[e]);
            if (X.lane < 4) { const int hh = X.lane; const float av = (hh == 0 ? ab[0] : hh == 1 ? ab[1] : hh == 2 ? ab[2] : ab[3]) + a.gdn_dt_bias[hh];
                const float sp = av > 20.f ? av : log1pf(__expf(av)); G[(size_t)m * 4 + hh] = -__expf(a.gdn_a_log[hh]) * sp; }
            else if (X.lane < 8) { const int hh = X.lane - 4; const float bv = (hh == 0 ? ab[4] : hh == 1 ? ab[5] : hh == 2 ? ab[6] : ab[7]); BT[(size_t)m * 4 + hh] = sigmoid_f(bv); }
        }
    }
}

__device__ __forceinline__ void phase_gmlp(const Args& a, const Ctx& X) {
    unsigned char* ws = a.ws; const bf16_t* P = (const bf16_t*)(ws + WS_PROJ); bf16_t* MIX = (bf16_t*)(ws + WS_MIXIN);
    LAS float* Wf = (LAS float*)X.lds;
    LAS float* Vn = Wf + 128 * 129;
    const int t = X.tid >> 2, dp = X.tid & 3;
    for (int it = X.bid; it < NB * 64 * GM_G; it += X.G) {
        const int g = it & 3, n = (it >> 2) & 63, b = it >> 8;
        const size_t row0 = (size_t)b * SEQ + (size_t)n * GM_C;
        __syncthreads();
        for (int i = X.tid; i < 128 * 128; i += 512) { const int tt = i >> 7, s = i & 127; Wf[tt * 129 + s] = s <= tt ? a.gm_w_spatial[(size_t)g * 16384 + i] : 0.f; }
        {
            const u32x4* vp = (const u32x4*)(P + (row0 + t) * PROJ_N + GM_W + g * GM_D + dp * 32);
            float f[32]; float ss = 0.f;
#pragma unroll
            for (int q = 0; q < 4; ++q) { const u32x4 w = vp[q]; const unsigned ww[4] = {w.x, w.y, w.z, w.w};
#pragma unroll
                for (int j = 0; j < 4; ++j) { f[q * 8 + 2 * j] = bflo(ww[j]); f[q * 8 + 2 * j + 1] = bfhi(ww[j]); } }
#pragma unroll
            for (int j = 0; j < 32; ++j) ss += f[j] * f[j];
            ss += __shfl_xor(ss, 1); ss += __shfl_xor(ss, 2);
            const float rstd = 1.0f / sqrtf(ss * (1.f / GM_D) + EPS);
#pragma unroll
            for (int j = 0; j < 32; ++j) Vn[t * 128 + dp * 32 + j] = f[j] * rstd * a.gm_vnorm_w[g * GM_D + dp * 32 + j];
        }
        __syncthreads();
        float acc[32];
#pragma unroll
        for (int j = 0; j < 32; ++j) acc[j] = 0.f;
        const int tmax = (X.tid | 63) >> 2;
        for (int s = 0; s <= tmax; ++s) {
            const float w = Wf[t * 129 + s];
            const LAS f32x4* vr = (const LAS f32x4*)(Vn + s * 128 + dp * 32);
#pragma unroll
            for (int q = 0; q < 8; ++q) { const f32x4 vv = vr[q]; acc[4 * q] += w * vv.x; acc[4 * q + 1] += w * vv.y; acc[4 * q + 2] += w * vv.z; acc[4 * q + 3] += w * vv.w; }
        }
        const float bs = a.gm_b_spatial[g * GM_C + t];
        const u32x4* up = (const u32x4*)(P + (row0 + t) * PROJ_N + g * GM_D + dp * 32);
        u32x4* op = (u32x4*)(MIX + (row0 + t) * DM + g * GM_D + dp * 32);
#pragma unroll
        for (int q = 0; q < 4; ++q) { const u32x4 w = up[q]; const unsigned ww[4] = {w.x, w.y, w.z, w.w}; unsigned r[4];
#pragma unroll
            for (int j = 0; j < 4; ++j) r[j] = pk2(bflo(ww[j]) * (acc[q * 8 + 2 * j] + bs), bfhi(ww[j]) * (acc[q * 8 + 2 * j + 1] + bs));
            op[q] = (u32x4){r[0], r[1], r[2], r[3]}; }
    }
}

__device__ __forceinline__ void phase_conv(const Args& a, const Ctx& X) {
    unsigned char* ws = a.ws; const bf16_t* P = (const bf16_t*)(ws + WS_PROJ);
    float* QN = (float*)(ws + WS_QN); float* KN = (float*)(ws + WS_KN); float* VN = (float*)(ws + WS_VN);
    const int gw = X.bid * 8 + X.wave, NGW = X.G * 8;
    for (int m = gw; m < NTOK; m += NGW) {
        const int tpos = m % SEQ;
#pragma unroll
        for (int seg = 0; seg < 3; ++seg) {
            const int ch = seg * 512 + 8 * X.lane;
            float acc[8] = {0, 0, 0, 0, 0, 0, 0, 0};
#pragma unroll
            for (int j = 0; j < CONVK; ++j) {
                const int tt = tpos - 3 + j;
                if (tt >= 0) {
                    const u32x4 w = *(const u32x4*)(P + (size_t)(m - 3 + j) * PROJ_N + 1024 + ch); const unsigned ww[4] = {w.x, w.y, w.z, w.w};
                    const f32x4 c0 = *(const f32x4*)(a.gdn_conv_w + (size_t)j * 1536 + ch), c1 = *(const f32x4*)(a.gdn_conv_w + (size_t)j * 1536 + ch + 4);
                    acc[0] += c0.x * bflo(ww[0]); acc[1] += c0.y * bfhi(ww[0]); acc[2] += c0.z * bflo(ww[1]); acc[3] += c0.w * bfhi(ww[1]);
                    acc[4] += c1.x * bflo(ww[2]); acc[5] += c1.y * bfhi(ww[2]); acc[6] += c1.z * bflo(ww[3]); acc[7] += c1.w * bfhi(ww[3]);
                }
            }
            float ss = 0.f;
#pragma unroll
            for (int j = 0; j < 8; ++j) { acc[j] = silu_f(acc[j]); ss += acc[j] * acc[j]; }
            float* dstp;
            if (seg < 2) {
                ss += __shfl_xor(ss, 1); ss += __shfl_xor(ss, 2); ss += __shfl_xor(ss, 4); ss += __shfl_xor(ss, 8);
                float sc = 1.0f / sqrtf(ss + EPS); if (seg == 0) sc *= 0.08838834764831845f;
#pragma unroll
                for (int j = 0; j < 8; ++j) acc[j] *= sc;
                dstp = (seg == 0 ? QN : KN) + (size_t)m * 512 + 8 * X.lane;
            } else dstp = VN + (size_t)m * 512 + 8 * X.lane;
            *(f32x4*)dstp = (f32x4){acc[0], acc[1], acc[2], acc[3]}; *(f32x4*)(dstp + 4) = (f32x4){acc[4], acc[5], acc[6], acc[7]};
        }
    }
}

__device__ __forceinline__ void phase_scan_naive(const Args& a, const Ctx& X) {
    unsigned char* ws = a.ws;
    const float* QN = (const float*)(ws + WS_QN); const float* KN = (const float*)(ws + WS_KN); const float* VN = (const float*)(ws + WS_VN);
    const float* G = (const float*)(ws + WS_G); const float* BT = (const float*)(ws + WS_BETA); float* OR = (float*)(ws + WS_ORAW);
    constexpr int TT = 16;
    LAS float* kq = (LAS float*)X.lds;
    LAS float* gb = kq + 4 * TT * 256;
    const int hh = X.tid >> 7, e = X.tid & 127;
    for (int b = X.bid; b < NB; b += X.G) {
        float s[128];
#pragma unroll
        for (int d = 0; d < 128; ++d) s[d] = 0.f;
        for (int t0 = 0; t0 < SEQ; t0 += TT) {
            __syncthreads();
            for (int i = X.tid; i < 4 * TT * 256; i += 512) { const int h2 = i / (TT * 256), r = i % (TT * 256), tt = r >> 8, d = r & 255; const size_t m = (size_t)b * SEQ + t0 + tt;
                kq[i] = d < 128 ? KN[m * 512 + h2 * 128 + d] : QN[m * 512 + h2 * 128 + d - 128]; }
            if (X.tid < TT * 8) { const int tt = X.tid >> 3, j = X.tid & 7; const size_t m = (size_t)b * SEQ + t0 + tt; gb[X.tid] = j < 4 ? G[m * 4 + j] : BT[m * 4 + j - 4]; }
            __syncthreads();
            for (int tt = 0; tt < TT; ++tt) {
                const size_t m = (size_t)b * SEQ + t0 + tt;
                const float alpha = __expf(gb[tt * 8 + hh]), beta = gb[tt * 8 + 4 + hh];
                const float vv = VN[m * 512 + hh * 128 + e];
                const LAS f32x4* kp = (const LAS f32x4*)(kq + (hh * TT + tt) * 256);
                float dot = 0.f;
#pragma unroll
                for (int q = 0; q < 32; ++q) { const f32x4 kk = kp[q]; dot += kk.x * s[4 * q] + kk.y * s[4 * q + 1] + kk.z * s[4 * q + 2] + kk.w * s[4 * q + 3]; if ((q & 3) == 3) asm volatile("" ::: "memory"); }
                const float vn = beta * (vv - alpha * dot);
                float o = 0.f;
#pragma unroll
                for (int q = 0; q < 32; ++q) { const f32x4 kk = kp[q], qq = kp[32 + q];
                    s[4 * q] = alpha * s[4 * q] + kk.x * vn; s[4 * q + 1] = alpha * s[4 * q + 1] + kk.y * vn; s[4 * q + 2] = alpha * s[4 * q + 2] + kk.z * vn; s[4 * q + 3] = alpha * s[4 * q + 3] + kk.w * vn;
                    o += qq.x * s[4 * q] + qq.y * s[4 * q + 1] + qq.z * s[4 * q + 2] + qq.w * s[4 * q + 3]; if ((q & 3) == 3) asm volatile("" ::: "memory"); }
                OR[m * 512 + hh * 128 + e] = o;
            }
        }
    }
}

__device__ __forceinline__ int off256(int row, int col) { return row * 256 + ((((col >> 3) ^ row) & 15) << 4) + ((col & 7) << 1); }
__device__ __forceinline__ int off128(int row, int col) { return row * 128 + ((((col >> 3) ^ row) & 7) << 4) + ((col & 7) << 1); }
__device__ __forceinline__ bf16x8 frag256(const LAS unsigned char* img, int r0, int ks, int lane) { return *(const LAS bf16x8*)(img + off256(r0 + (lane & 15), 32 * ks + 8 * (lane >> 4))); }
__device__ __forceinline__ bf16x8 frag128(const LAS unsigned char* img, int r0, int ks, int lane) { return *(const LAS bf16x8*)(img + off128(r0 + (lane & 15), 32 * ks + 8 * (lane >> 4))); }
#define MFMA16(a, b, c) __builtin_amdgcn_mfma_f32_16x16x32_bf16((a), (b), (c), 0, 0, 0)

constexpr int SA_KR = 0, SA_QR = 16384, SA_VBT = 32768, SA_KBGT = 49152, SA_KDT = 65536, SA_AM = 81920, SA_TM = 98304, SA_GC = 106496, SA_BETA = 106752;

__device__ __forceinline__ void phase_stepa(const Args& a, const Ctx& X) {
    unsigned char* ws = a.ws; const bf16_t* P = (const bf16_t*)(ws + WS_PROJ);
    const float* G = (const float*)(ws + WS_G); const float* BT = (const float*)(ws + WS_BETA);
    bf16_t* WN = (bf16_t*)(ws + WS_WN); bf16_t* QG = (bf16_t*)(ws + WS_QG); bf16_t* KDT = (bf16_t*)(ws + WS_KDT); bf16_t* QK = (bf16_t*)(ws + WS_QK);
    float* UF = (float*)(ws + WS_UF); float* EG = (float*)(ws + WS_EG);
    LAS unsigned char* L = X.lds;
    LAS float* GC = (LAS float*)(L + SA_GC); LAS float* BE = (LAS float*)(L + SA_BETA); LAS float* AM = (LAS float*)(L + SA_AM);
    const int w = X.wave;
    for (int ci = X.bid; ci < 2048; ci += X.G) {
        int tid_o = X.tid; asm volatile("" : "+v"(tid_o));
        const int t = tid_o >> 3, cp = tid_o & 7, lane = tid_o & 63, fr = lane & 15, fq = lane >> 4;
        const int n = ci & 127, h = (ci >> 7) & 3, b = ci >> 9;
        const size_t m0 = (size_t)b * SEQ + (size_t)n * 64;
        __syncthreads();
        if (w == 0) {
            float gv = G[(m0 + lane) * 4 + h]; const float bv = BT[(m0 + lane) * 4 + h];
#pragma unroll
            for (int o = 1; o < 64; o <<= 1) { const float up = __shfl_up(gv, o); if (lane >= o) gv += up; }
            GC[lane] = gv; BE[lane] = bv;
        }
        float val[3][16];
#pragma unroll
        for (int seg = 0; seg < 3; ++seg) {
            const int ch = seg * 512 + h * 128 + 16 * cp;
#pragma unroll
            for (int c = 0; c < 16; ++c) val[seg][c] = 0.f;
#pragma unroll
            for (int j = 0; j < CONVK; ++j) {
                if (n * 64 + t - 3 + j >= 0) {
                    const u32x4* pp = (const u32x4*)(P + (m0 + t - 3 + j) * PROJ_N + 1024 + ch);
                    const u32x4 x0 = pp[0], x1 = pp[1]; const unsigned xx[8] = {x0.x, x0.y, x0.z, x0.w, x1.x, x1.y, x1.z, x1.w};
                    const f32x4* cw = (const f32x4*)(a.gdn_conv_w + (size_t)j * 1536 + ch);
#pragma unroll
                    for (int q4 = 0; q4 < 4; ++q4) { const f32x4 c4 = cw[q4];
                        val[seg][4 * q4] += c4.x * bflo(xx[2 * q4]); val[seg][4 * q4 + 1] += c4.y * bfhi(xx[2 * q4]); val[seg][4 * q4 + 2] += c4.z * bflo(xx[2 * q4 + 1]); val[seg][4 * q4 + 3] += c4.w * bfhi(xx[2 * q4 + 1]); }
                }
                asm volatile("" ::: "memory");
            }
            float ss = 0.f;
#pragma unroll
            for (int c = 0; c < 16; ++c) { val[seg][c] = silu_f(val[seg][c]); ss += val[seg][c] * val[seg][c]; }
            if (seg < 2) {
                ss += __shfl_xor(ss, 1); ss += __shfl_xor(ss, 2); ss += __shfl_xor(ss, 4);
                float sc = 1.0f / sqrtf(ss + EPS); if (seg == 0) sc *= 0.08838834764831845f;
#pragma unroll
                for (int c = 0; c < 16; ++c) val[seg][c] *= sc;
            }
        }
        __syncthreads();
        {
            const float gct = GC[t], bt = BE[t], gl = GC[63];
            const float eg = __expf(gct), ekd = __expf(gl - gct);
#pragma unroll
            for (int hf = 0; hf < 2; ++hf) {
                u32x4 kq, qq, qg;
                kq.x = pk2(val[1][8 * hf], val[1][8 * hf + 1]); kq.y = pk2(val[1][8 * hf + 2], val[1][8 * hf + 3]); kq.z = pk2(val[1][8 * hf + 4], val[1][8 * hf + 5]); kq.w = pk2(val[1][8 * hf + 6], val[1][8 * hf + 7]);
                qq.x = pk2(val[0][8 * hf], val[0][8 * hf + 1]); qq.y = pk2(val[0][8 * hf + 2], val[0][8 * hf + 3]); qq.z = pk2(val[0][8 * hf + 4], val[0][8 * hf + 5]); qq.w = pk2(val[0][8 * hf + 6], val[0][8 * hf + 7]);
                qg.x = pk2(val[0][8 * hf] * eg, val[0][8 * hf + 1] * eg); qg.y = pk2(val[0][8 * hf + 2] * eg, val[0][8 * hf + 3] * eg); qg.z = pk2(val[0][8 * hf + 4] * eg, val[0][8 * hf + 5] * eg); qg.w = pk2(val[0][8 * hf + 6] * eg, val[0][8 * hf + 7] * eg);
                *(LAS u32x4*)(L + SA_KR + off256(t, 16 * cp + 8 * hf)) = kq;
                *(LAS u32x4*)(L + SA_QR + off256(t, 16 * cp + 8 * hf)) = qq;
                *(u32x4*)(QG + (size_t)ci * 8192 + t * 128 + 16 * cp + 8 * hf) = qg;
            }
#pragma unroll
            for (int c = 0; c < 16; ++c) {
                *(LAS bf16_t*)(L + SA_VBT + off128(16 * cp + c, t)) = (bf16_t)f2bf(bt * val[2][c]);
                *(LAS bf16_t*)(L + SA_KBGT + off128(16 * cp + c, t)) = (bf16_t)f2bf(bt * eg * val[1][c]);
                *(LAS bf16_t*)(L + SA_KDT + (16 * cp + c) * 128 + t * 2) = (bf16_t)f2bf(val[1][c] * ekd);
            }
        }
        __syncthreads();
#pragma unroll
        for (int q2 = 0; q2 < 2; ++q2) {
            const int id = 2 * w + q2, it = id >> 2, jt = id & 3;
            if (jt > it) {
                *(u32x2*)(QK + (size_t)ci * 4096 + (16 * it + fr) * 64 + 16 * jt + 4 * fq) = (u32x2){0u, 0u};
            } else {
                f32x4 kk = {0.f, 0.f, 0.f, 0.f}, qk = {0.f, 0.f, 0.f, 0.f};
#pragma unroll
                for (int ks = 0; ks < 4; ++ks) {
                    const bf16x8 ki = frag256(L + SA_KR, 16 * it, ks, lane), kj = frag256(L + SA_KR, 16 * jt, ks, lane), qi = frag256(L + SA_QR, 16 * it, ks, lane);
                    kk = MFMA16(ki, kj, kk);
                    qk = MFMA16(kj, qi, qk);
                }
                {
                    const int j = 16 * jt + fr; const float gj = GC[j];
#pragma unroll
                    for (int r = 0; r < 4; ++r) { const int i = 16 * it + 4 * fq + r; AM[i * 64 + j] = (i > j) ? BE[i] * kk[r] * __expf(GC[i] - gj) : 0.f; }
                }
                {
                    const int i = 16 * it + fr; const float gi = GC[i]; float o[4];
#pragma unroll
                    for (int r = 0; r < 4; ++r) { const int j = 16 * jt + 4 * fq + r; o[r] = (i >= j) ? qk[r] * __expf(gi - GC[j]) : 0.f; }
                    *(u32x2*)(QK + (size_t)ci * 4096 + i * 64 + 16 * jt + 4 * fq) = (u32x2){pk2(o[0], o[1]), pk2(o[2], o[3])};
                }
            }
        }
        __syncthreads();
        if (w == 0) {
            float Tc[64];
#pragma unroll
            for (int i = 0; i < 64; ++i) {
                float acc = (i == lane) ? 1.f : 0.f;
#pragma unroll
                for (int j = 0; j < i; j += 4) {
                    const f32x4 av = *(const LAS f32x4*)(AM + i * 64 + j);
                    acc -= av.x * Tc[j];
                    if (j + 1 < i) acc -= av.y * Tc[j + 1];
                    if (j + 2 < i) acc -= av.z * Tc[j + 2];
                    if (j + 3 < i) acc -= av.w * Tc[j + 3];
                    if ((j & 15) == 12) asm volatile("" ::: "memory");
                }
                Tc[i] = acc;
                *(LAS bf16_t*)(L + SA_TM + off128(i, lane)) = (bf16_t)f2bf(acc);
                asm volatile("" ::: "memory");
            }
        }
        __syncthreads();
        {
            const int tt = w >> 1, dh = w & 1;
            const bf16x8 t0 = frag128(L + SA_TM, 16 * tt, 0, lane), t1 = frag128(L + SA_TM, 16 * tt, 1, lane);
#pragma unroll
            for (int j = 0; j < 4; ++j) {
                const int ct = 4 * dh + j;
                f32x4 u = {0.f, 0.f, 0.f, 0.f}, wv = {0.f, 0.f, 0.f, 0.f};
                u = MFMA16(t0, frag128(L + SA_VBT, 16 * ct, 0, lane), u); u = MFMA16(t1, frag128(L + SA_VBT, 16 * ct, 1, lane), u);
                wv = MFMA16(frag128(L + SA_KBGT, 16 * ct, 0, lane), t0, wv); wv = MFMA16(frag128(L + SA_KBGT, 16 * ct, 1, lane), t1, wv);
                *(f32x4*)(UF + (((size_t)ci * 32 + tt * 8 + ct) * 64 + lane) * 4) = u;
                *(u32x2*)(WN + (size_t)ci * 8192 + (16 * tt + fr) * 128 + 16 * ct + 4 * fq) = (u32x2){pk2(-wv[0], -wv[1]), pk2(-wv[2], -wv[3])};
            }
            const LAS u32x4* ks = (const LAS u32x4*)(L + SA_KDT) + tid_o * 2; u32x4* kd = (u32x4*)(KDT + (size_t)ci * 8192) + tid_o * 2;
            kd[0] = ks[0]; kd[1] = ks[1];
            if (tid_o == 0) EG[ci] = __expf(GC[63]);
        }
    }
}

constexpr int SC_ST = 0, SC_VT = 32768, SC_OSS = 49152;
struct ScanSet { bf16x8 wn[4], qg[4], qkf[2], kdt[2]; f32x4 uf[4]; u32x2 zz[4]; float eg; };
__device__ __forceinline__ void scan_load(ScanSet& s, const unsigned char* ws, int ci, size_t m0, int h, int w, int lane) {
    const int fr = lane & 15, fq = lane >> 4, tt = w >> 1, dh = w & 1;
    const bf16_t* WN = (const bf16_t*)(ws + WS_WN) + (size_t)ci * 8192 + (16 * tt + fr) * 128 + 8 * fq;
    const bf16_t* QG = (const bf16_t*)(ws + WS_QG) + (size_t)ci * 8192 + (16 * tt + fr) * 128 + 8 * fq;
    const bf16_t* QK = (const bf16_t*)(ws + WS_QK) + (size_t)ci * 4096 + (16 * tt + fr) * 64 + 8 * fq;
    const bf16_t* KD = (const bf16_t*)(ws + WS_KDT) + (size_t)ci * 8192 + (16 * w + fr) * 64 + 8 * fq;
    const float* UF = (const float*)(ws + WS_UF) + (((size_t)ci * 32 + tt * 8 + 4 * dh) * 64 + lane) * 4;
    const bf16_t* Z = (const bf16_t*)(ws + WS_PROJ) + (m0 + 16 * tt + fr) * PROJ_N + 2560 + h * 128 + 64 * dh + 4 * fq;
#pragma unroll
    for (int ks = 0; ks < 4; ++ks) { s.wn[ks] = *(const bf16x8*)(WN + 32 * ks); s.qg[ks] = *(const bf16x8*)(QG + 32 * ks); }
#pragma unroll
    for (int ks = 0; ks < 2; ++ks) { s.qkf[ks] = *(const bf16x8*)(QK + 32 * ks); s.kdt[ks] = *(const bf16x8*)(KD + 32 * ks); }
#pragma unroll
    for (int j = 0; j < 4; ++j) { s.uf[j] = *(const f32x4*)(UF + j * 256); s.zz[j] = *(const u32x2*)(Z + 16 * j); }
    s.eg = ((const float*)(ws + WS_EG))[ci];
}
__device__ __forceinline__ void phase_scan(const Args& a, const Ctx& X) {
    if (X.bid >= 16) return;
    unsigned char* ws = a.ws; bf16_t* MIX = (bf16_t*)(ws + WS_MIXIN);
    LAS unsigned char* L = X.lds; LAS float* OSS = (LAS float*)(L + SC_OSS);
    const int bh = X.bid, b = bh >> 2, h = bh & 3, w = X.wave, lane = X.lane, fr = lane & 15, fq = lane >> 4, tt = w >> 1, dh = w & 1;
    __syncthreads();
    for (int i = X.tid; i < 2048; i += 512) ((LAS u32x4*)(L + SC_ST))[i] = (u32x4){0u, 0u, 0u, 0u};
    f32x4 Sacc[8];
#pragma unroll
    for (int j = 0; j < 8; ++j) Sacc[j] = (f32x4){0.f, 0.f, 0.f, 0.f};
    f32x4 onw[4];
#pragma unroll
    for (int j = 0; j < 4; ++j) onw[j] = *(const f32x4*)(a.gdn_onorm_w + 64 * dh + 16 * j + 4 * fq);
    ScanSet cur, nxt;
    scan_load(cur, ws, bh * 128, (size_t)b * SEQ, h, w, lane);
    __syncthreads();
    for (int n = 0; n < 128; ++n) {
        const size_t m0 = (size_t)b * SEQ + (size_t)n * 64;
        { const int n1 = n + 1 < 128 ? n + 1 : n; scan_load(nxt, ws, bh * 128 + n1, (size_t)b * SEQ + (size_t)n1 * 64, h, w, lane); }
        f32x4 vacc[4], oacc[4];
#pragma unroll
        for (int j = 0; j < 4; ++j) { vacc[j] = cur.uf[j]; oacc[j] = (f32x4){0.f, 0.f, 0.f, 0.f}; }
#pragma unroll
        for (int j = 0; j < 4; ++j)
#pragma unroll
            for (int ks = 0; ks < 4; ++ks) { const bf16x8 sb = frag256(L + SC_ST, 16 * (4 * dh + j), ks, lane); vacc[j] = MFMA16(cur.wn[ks], sb, vacc[j]); oacc[j] = MFMA16(sb, cur.qg[ks], oacc[j]); }
#pragma unroll
        for (int j = 0; j < 4; ++j) *(LAS u32x2*)(L + SC_VT + off128(16 * (4 * dh + j) + fr, 16 * tt + 4 * fq)) = (u32x2){pk2(vacc[j][0], vacc[j][1]), pk2(vacc[j][2], vacc[j][3])};
        __syncthreads();
#pragma unroll
        for (int j = 0; j < 4; ++j)
#pragma unroll
            for (int ks = 0; ks < 2; ++ks) oacc[j] = MFMA16(frag128(L + SC_VT, 16 * (4 * dh + j), ks, lane), cur.qkf[ks], oacc[j]);
#pragma unroll
        for (int j = 0; j < 8; ++j) {
            Sacc[j] = Sacc[j] * cur.eg;
#pragma unroll
            for (int ks = 0; ks < 2; ++ks) Sacc[j] = MFMA16(cur.kdt[ks], frag128(L + SC_VT, 16 * j, ks, lane), Sacc[j]);
        }
#pragma unroll
        for (int j = 0; j < 8; ++j) *(LAS u32x2*)(L + SC_ST + off256(16 * j + fr, 16 * w + 4 * fq)) = (u32x2){pk2(Sacc[j][0], Sacc[j][1]), pk2(Sacc[j][2], Sacc[j][3])};
        float ss = 0.f;
#pragma unroll
        for (int j = 0; j < 4; ++j) ss += (oacc[j][0] * oacc[j][0] + oacc[j][1] * oacc[j][1]) + (oacc[j][2] * oacc[j][2] + oacc[j][3] * oacc[j][3]);
        ss += __shfl_xor(ss, 16); ss += __shfl_xor(ss, 32);
        if (fq == 0) OSS[((n & 1) * 64 + 16 * tt + fr) * 2 + dh] = ss;
        __syncthreads();
        {
            const float tot = OSS[((n & 1) * 64 + 16 * tt + fr) * 2] + OSS[((n & 1) * 64 + 16 * tt + fr) * 2 + 1];
            const float rstd = 1.0f / sqrtf(tot * (1.f / HD) + EPS);
            bf16_t* op = MIX + (m0 + 16 * tt + fr) * DM + 512 + h * 128 + 64 * dh + 4 * fq;
#pragma unroll
            for (int j = 0; j < 4; ++j) {
                const float z0 = bflo(cur.zz[j].x), z1 = bfhi(cur.zz[j].x), z2 = bflo(cur.zz[j].y), z3 = bfhi(cur.zz[j].y);
                const float y0 = oacc[j][0] * rstd * onw[j][0] * silu_f(z0), y1 = oacc[j][1] * rstd * onw[j][1] * silu_f(z1), y2 = oacc[j][2] * rstd * onw[j][2] * silu_f(z2), y3 = oacc[j][3] * rstd * onw[j][3] * silu_f(z3);
                *(u32x2*)(op + 16 * j) = (u32x2){pk2(y0, y1), pk2(y2, y3)};
            }
        }
        cur = nxt;
    }
}

__device__ __forceinline__ void phase_onorm(const Args& a, const Ctx& X) {
    unsigned char* ws = a.ws; const bf16_t* P = (const bf16_t*)(ws + WS_PROJ); bf16_t* MIX = (bf16_t*)(ws + WS_MIXIN); const float* OR = (const float*)(ws + WS_ORAW);
    const int gw = X.bid * 8 + X.wave, NGW = X.G * 8;
    for (int m = gw; m < NTOK; m += NGW) {
        const f32x4 o0 = *(const f32x4*)(OR + (size_t)m * 512 + 8 * X.lane), o1 = *(const f32x4*)(OR + (size_t)m * 512 + 8 * X.lane + 4);
        float o[8] = {o0.x, o0.y, o0.z, o0.w, o1.x, o1.y, o1.z, o1.w}; float ss = 0.f;
#pragma unroll
        for (int j = 0; j < 8; ++j) ss += o[j] * o[j];
        ss += __shfl_xor(ss, 1); ss += __shfl_xor(ss, 2); ss += __shfl_xor(ss, 4); ss += __shfl_xor(ss, 8);
        const float rstd = 1.0f / sqrtf(ss * (1.f / HD) + EPS);
        const u32x4 zw = *(const u32x4*)(P + (size_t)m * PROJ_N + 2560 + 8 * X.lane); const unsigned zz[4] = {zw.x, zw.y, zw.z, zw.w};
        const int d0 = (8 * X.lane) & 127;
        float r[8];
#pragma unroll
        for (int j = 0; j < 8; ++j) { const float z = (j & 1) ? bfhi(zz[j >> 1]) : bflo(zz[j >> 1]); r[j] = o[j] * rstd * a.gdn_onorm_w[d0 + j] * silu_f(z); }
        *(u32x4*)(MIX + (size_t)m * DM + 512 + 8 * X.lane) = (u32x4){pk2(r[0], r[1]), pk2(r[2], r[3]), pk2(r[4], r[5]), pk2(r[6], r[7])};
    }
}

__device__ __forceinline__ void phase_route(const Args& a, const Ctx& X) {
    unsigned char* ws = a.ws; const float* L = (const float*)(ws + WS_LOGITS); int* cnt = (int*)(ws + WS_CTL); int* list = (int*)(ws + WS_LIST); int* route = (int*)(ws + WS_ROUTE);
    for (int m = X.bid * 512 + X.tid; m < NTOK; m += X.G * 512) {
        float v[32];
#pragma unroll
        for (int q = 0; q < 8; ++q) { const f32x4 t = *(const f32x4*)(L + (size_t)m * NE + 4 * q); v[4 * q] = t.x; v[4 * q + 1] = t.y; v[4 * q + 2] = t.z; v[4 * q + 3] = t.w; }
        int ei[4]; float ev[4];
#pragma unroll
        for (int k = 0; k < 4; ++k) {
            float best = -INFINITY; int bi = 0;
#pragma unroll
            for (int j = 0; j < 32; ++j) { if (v[j] > best) { best = v[j]; bi = j; } }
            ei[k] = bi; ev[k] = best;
#pragma unroll
            for (int j = 0; j < 32; ++j) if (j == bi) v[j] = -INFINITY;
        }
        float w[4]; float sum = 0.f;
#pragma unroll
        for (int k = 0; k < 4; ++k) { w[k] = __expf(ev[k] - ev[0]); sum += w[k]; }
        const float inv = 1.0f / sum;
#pragma unroll
        for (int k = 0; k < 4; ++k) {
            const int rank = atomicAdd(cnt + ei[k], 1);
            list[(size_t)ei[k] * LIST_CAP + rank] = m;
            route[(size_t)m * 12 + k] = ei[k]; route[(size_t)m * 12 + 4 + k] = rank; ((float*)route)[(size_t)m * 12 + 8 + k] = w[k] * inv;
        }
    }
}

__device__ __forceinline__ int moe_tables(const Args& a, const Ctx& X, pg8::MoeTab& T) {
    LAS int* tp = (LAS int*)(X.lds + LDS_MISC); LAS int* cn = (LAS int*)(X.lds + LDS_MISC + 256);
    const int* cnt = (const int*)(a.ws + WS_CTL);
    __syncthreads();
    if (X.tid == 0) { int acc = 0; for (int e = 0; e < NE; ++e) { const int c = cnt[e]; cn[e] = c; tp[e] = acc; acc += (c + 255) >> 8; } tp[NE] = acc; }
    __syncthreads();
    T.tp = tp; T.cnt = cn;
    return tp[NE];
}

__device__ __forceinline__ void phase_combine(const Args& a, const Ctx& X) {
    unsigned char* ws = a.ws; pg8::MoeTab T; (void)moe_tables(a, X, T);
    const float* X1 = (const float*)(ws + WS_X1); const bf16_t* Y = (const bf16_t*)(ws + WS_Y); const int* route = (const int*)(ws + WS_ROUTE); const float* mod = (const float*)(ws + WS_MOD);
    const int gw = X.bid * 8 + X.wave, NGW = X.G * 8;
    for (int m = gw; m < NTOK; m += NGW) {
        const int b = m / SEQ;
        f32x4 acc[4] = {{0, 0, 0, 0}, {0, 0, 0, 0}, {0, 0, 0, 0}, {0, 0, 0, 0}};
#pragma unroll
        for (int k = 0; k < 4; ++k) {
            const int e = route[(size_t)m * 12 + k], rank = route[(size_t)m * 12 + 4 + k]; const float w = ((const float*)route)[(size_t)m * 12 + 8 + k];
            const size_t slot = (size_t)T.tp[e] * 256 + rank;
            const u32x2* yp = (const u32x2*)(Y + slot * DM) + X.lane;
#pragma unroll
            for (int j = 0; j < 4; ++j) { const u32x2 t = yp[64 * j]; acc[j].x += w * bflo(t.x); acc[j].y += w * bfhi(t.x); acc[j].z += w * bflo(t.y); acc[j].w += w * bfhi(t.y); }
        }
        const f32x4* xr = (const f32x4*)(X1 + (size_t)m * DM) + X.lane;
        const f32x4* g2 = (const f32x4*)(mod + (size_t)b * 6144 + 5 * DM) + X.lane;
        f32x4 v[4]; float ss = 0.f;
#pragma unroll
        for (int j = 0; j < 4; ++j) { v[j] = xr[64 * j] + g2[64 * j] * acc[j]; ss += (v[j].x * v[j].x + v[j].y * v[j].y) + (v[j].z * v[j].z + v[j].w * v[j].w); }
        const float rstd = 1.0f / sqrtf(wave_sum(ss) * (1.f / DM) + EPS);
        f32x4* orow = (f32x4*)(a.out + (size_t)m * DM) + X.lane; const f32x4* nf = (const f32x4*)a.norm_f_w + X.lane;
#pragma unroll
        for (int j = 0; j < 4; ++j) orow[64 * j] = v[j] * rstd * nf[64 * j];
    }
}


#define XB_TMO      128
#define XB_XCNT(j)  (256  + 64 * (j))
#define XB_XSUB(j)  (1280 + 64 * (j))
#define XB_XGEN(j)  (2304 + 64 * (j))
#define XB_TOP      3328
#define XB_TOPGEN   3392
#define XCD_BAR_WORDS 3456
#define XB_SPIN_CAP (1u << 18)
__device__ __forceinline__ unsigned xb_ld(unsigned* p)              { return __hip_atomic_load(p, __ATOMIC_RELAXED, __HIP_MEMORY_SCOPE_AGENT); }
__device__ __forceinline__ unsigned xb_add(unsigned* p, unsigned v) { return __hip_atomic_fetch_add(p, v, __ATOMIC_RELAXED, __HIP_MEMORY_SCOPE_AGENT); }
__device__ __forceinline__ unsigned xb_xcc_id() { return (unsigned)__builtin_amdgcn_s_getreg((3 << 11) | 20) & 0xFu; }
#define XB_SPIN(cond, bar) do { unsigned _sp = 0; while (cond) { __builtin_amdgcn_s_sleep(1); \
    if ((++_sp & 255u) == 0u) { if (xb_ld(&(bar)[XB_TMO])) break; if (_sp > XB_SPIN_CAP) { atomicAdd(&(bar)[XB_TMO], 1u); break; } } } } while (0)
struct XcdBarrier { unsigned* bar; unsigned x; volatile LAS unsigned* st; };
__device__ __forceinline__ XcdBarrier xcd_barrier_post(unsigned* bar, volatile LAS unsigned* st) {
    XcdBarrier b; b.bar = bar; b.x = xb_xcc_id(); b.st = st;
    if (threadIdx.x == 0) (void)xb_add(&bar[XB_XCNT(b.x)], 1u);
    return b;
}
__device__ __forceinline__ void xcd_barrier_complete(unsigned* bar, unsigned x, unsigned& nloc, unsigned& nx) {
    const unsigned G = gridDim.x * gridDim.y * gridDim.z;
    unsigned sum, cnt, mine, sp = 0u;
    for (;;) {
        sum = 0u; cnt = 0u; mine = 0u;
#pragma unroll
        for (unsigned j = 0; j < 16; ++j) { const unsigned c = xb_ld(&bar[XB_XCNT(j)]); sum += c; cnt += (c > 0u) ? 1u : 0u; mine = (j == x) ? c : mine; }
        if (sum == G) break;
        __builtin_amdgcn_s_sleep(1);
        if ((++sp & 255u) == 0u) { if (xb_ld(&bar[XB_TMO])) break; if (sp > XB_SPIN_CAP) { atomicAdd(&bar[XB_TMO], 1u); break; } }
    }
    nloc = mine > 0u ? mine : 1u; nx = cnt > 0u ? cnt : 1u;
}
__device__ __forceinline__ void xcd_barrier(const XcdBarrier& b) {
    asm volatile("s_waitcnt vmcnt(0)" ::: "memory");
    __syncthreads();
    if (threadIdx.x == 0) {
        unsigned* bar = b.bar;
        __builtin_amdgcn_s_waitcnt(0);
        unsigned nloc = b.st[0], nx = b.st[1];
        if (nloc == 0u) { xcd_barrier_complete(bar, b.x, nloc, nx); b.st[0] = nloc; b.st[1] = nx; }
        const unsigned old = xb_add(&bar[XB_XSUB(b.x)], 1u);
        const unsigned gen = old / nloc;
        if (old + 1u == (gen + 1u) * nloc) {
            __builtin_amdgcn_fence(__ATOMIC_RELEASE, "agent");
            asm volatile("s_waitcnt vmcnt(0)" ::: "memory");
            const unsigned og = xb_add(&bar[XB_TOP], 1u);
            const unsigned tg = og / nx;
            if (og + 1u == (tg + 1u) * nx) xb_add(&bar[XB_TOPGEN], 1u);
            else XB_SPIN(xb_ld(&bar[XB_TOPGEN]) == tg, bar);
            __builtin_amdgcn_fence(__ATOMIC_ACQUIRE, "agent");
            xb_add(&bar[XB_XGEN(b.x)], 1u);
            asm volatile("s_waitcnt vmcnt(0)" ::: "memory");
        } else {
            XB_SPIN(xb_ld(&bar[XB_XGEN(b.x)]) == gen, bar);
            __builtin_amdgcn_fence(__ATOMIC_ACQUIRE, "agent");
            asm volatile("s_waitcnt vmcnt(0)" ::: "memory");
        }
    }
    __syncthreads();
}

enum { PH_PREP0 = 0, PH_ROWS1, PH_PROJ, PH_GMLP, PH_CONV, PH_SCAN, PH_MIX, PH_ROWS2, PH_ROUTER, PH_ROUTE, PH_MOE1, PH_MOE2, PH_COMBINE, PH_COUNT };

__global__ void __launch_bounds__(512, 2) mega(Args a) {
    extern __shared__ __attribute__((aligned(16))) unsigned char lds_raw[];
    Ctx X; X.lds = (LAS unsigned char*)lds_raw; X.tid = threadIdx.x; X.lane = X.tid & 63; X.wave = __builtin_amdgcn_readfirstlane(X.tid >> 6); X.G = gridDim.x; X.bid = blockIdx.x;
    unsigned char* ws = a.ws;
#if SINGLE_LAUNCH
    cg::grid_group grid = cg::this_grid();
    if (X.tid < 2) ((volatile LAS unsigned*)(X.lds + LDS_BARST))[X.tid] = 0u;
    __syncthreads();
    const XcdBarrier xbar = xcd_barrier_post((unsigned*)(ws + WS_CTL + CTL_BAR), (volatile LAS unsigned*)(X.lds + LDS_BARST));
#define SEAM(k) do { if (a.ph_lo <= (k) && (k) + 1 < a.ph_hi) { if ((k) == 0) grid.sync(); else xcd_barrier(xbar); } } while (0)
#else
#define SEAM(k) do { } while (0)
#endif
#ifndef PHMASK
#define PHMASK 0xffffffffu
#endif
#define IN(k) (((PHMASK >> (k)) & 1u) && a.ph_lo <= (k) && (k) < a.ph_hi)
#ifndef REPMASK
#define REPMASK 0u
#endif
#define REP(k) for (int rep_ = 0; rep_ < ((((REPMASK) >> (k)) & 1u) ? 2 : 1); ++rep_)
    if (IN(PH_PREP0)) { REP(PH_PREP0) phase_prep0(a, X); SEAM(PH_PREP0); }
    if (IN(PH_ROWS1)) { REP(PH_ROWS1) phase_rows<true>(a, X, a.x, a.norm1_w, 0, 1, (bf16_t*)(ws + WS_H)); SEAM(PH_ROWS1); }
    if (IN(PH_PROJ)) {
        REP(PH_PROJ) { __syncthreads();
        pg8::DenseSched S; S.init(ws + WS_H, ws + WS_WINT, NTOK, PROJ_N, X.G, X.bid);
        pg8::EpiProj E{(bf16_t*)(ws + WS_PROJ)};
        pg8::gemm_phase(X.lds, S, E); }
        SEAM(PH_PROJ);
    }
    if (IN(PH_GMLP)) { REP(PH_GMLP) phase_gmlp(a, X); SEAM(PH_GMLP); }
    if (IN(PH_CONV)) { REP(PH_CONV) phase_stepa(a, X); SEAM(PH_CONV); }
    if (IN(PH_SCAN)) { REP(PH_SCAN) phase_scan(a, X); SEAM(PH_SCAN); }
    if (IN(PH_MIX)) {
        REP(PH_MIX) { __syncthreads();
        pg8::DenseSched S; S.init(ws + WS_MIXIN, ws + WS_WOUTT, NTOK, DM, X.G, X.bid);
        pg8::EpiMix E{a.x, (const float*)(ws + WS_MOD), (float*)(ws + WS_X1)};
        pg8::gemm_phase(X.lds, S, E); }
        SEAM(PH_MIX);
    }
    if (IN(PH_ROWS2)) { REP(PH_ROWS2) { __syncthreads(); phase_rows<false>(a, X, (const float*)(ws + WS_X1), a.norm2_w, 3, 4, (bf16_t*)(ws + WS_H)); } SEAM(PH_ROWS2); }
    if (IN(PH_ROUTER)) {
        REP(PH_ROUTER) { __syncthreads();
        pg8::DenseSched S; S.init(ws + WS_H, ws + WS_WRT, NTOK, 256, X.G, X.bid);
        pg8::EpiLogits E{a.b_router, (float*)(ws + WS_LOGITS)};
        pg8::gemm_phase(X.lds, S, E); }
        SEAM(PH_ROUTER);
    }
    if (IN(PH_ROUTE)) { phase_route(a, X); SEAM(PH_ROUTE); }
    if (IN(PH_MOE1)) {
        REP(PH_MOE1) {
        pg8::MoeTab T; const int nM = moe_tables(a, X, T);
        pg8::Moe1Sched S; S.init(ws + WS_H, ws + WS_WGUT, (const int*)(ws + WS_LIST), T, nM, X.G, X.bid);
        pg8::EpiAct E{a.b_gu, (bf16_t*)(ws + WS_ACT)};
        pg8::gemm_phase(X.lds, S, E); }
        SEAM(PH_MOE1);
    }
    if (IN(PH_MOE2)) {
        REP(PH_MOE2) {
        pg8::MoeTab T; const int nM = moe_tables(a, X, T);
        pg8::Moe2Sched S; S.init(ws + WS_ACT, ws + WS_WDT, T, nM, X.G, X.bid);
        pg8::EpiY E{a.b_down, (bf16_t*)(ws + WS_Y)};
        pg8::gemm_phase(X.lds, S, E); }
        SEAM(PH_MOE2);
    }
    if (IN(PH_COMBINE)) { REP(PH_COMBINE) phase_combine(a, X); }
#undef IN
#undef SEAM
#undef REP
}

extern "C" void kernel_launch(void* const* d_in, const int* in_sizes, int n_in, void* d_out, int out_size, void* d_ws, size_t ws_size, hipStream_t stream) {
    static int grid = 0;
    if (grid == 0) {
        if (n_in != 22 || out_size != NTOK * DM || ws_size < WS_END) { fprintf(stderr, "kernel_launch: unexpected shapes (n_in %d out %d ws %zu)\n", n_in, out_size, ws_size); grid = -1; return; }
        int dev = 0, cus = 0, per_cu = 0;
        (void)hipGetDevice(&dev); (void)hipDeviceGetAttribute(&cus, hipDeviceAttributeMultiprocessorCount, dev);
        (void)hipFuncSetAttribute((const void*)mega, hipFuncAttributeMaxDynamicSharedMemorySize, LDS_BYTES);
        (void)hipOccupancyMaxActiveBlocksPerMultiprocessor(&per_cu, (const void*)mega, 512, LDS_BYTES);
        if (per_cu < 1) { fprintf(stderr, "kernel_launch: occupancy query says %d blocks per CU\n", per_cu); }
        (void)hipGetLastError();
        grid = cus > 0 ? cus : 256;
    }
    if (grid < 0) return;
    (void)hipMemsetAsync((char*)d_ws + WS_CTL, 0, CTL_ZERO, stream);
    Args a{};
    const float** p = (const float**)&a;
    for (int i = 0; i < 22; ++i) p[i] = (const float*)d_in[i];
    a.out = (float*)d_out; a.ws = (unsigned char*)d_ws;
#if SINGLE_LAUNCH
    a.ph_lo = 0; a.ph_hi = PH_COUNT;
    void* args[] = {&a};
    hipError_t e = hipLaunchCooperativeKernel((const void*)mega, dim3(grid), dim3(512), args, LDS_BYTES, stream);
    if (e != hipSuccess) fprintf(stderr, "cooperative launch failed: %s (grid %d)\n", hipGetErrorString(e), grid);
#else
    for (int ph = 0; ph < PH_COUNT; ++ph) { a.ph_lo = ph; a.ph_hi = ph + 1; hipLaunchKernelGGL(mega, dim3(grid), dim3(512), LDS_BYTES, stream, a); }
#endif
}
```

```cpp
#include <hip/hip_runtime.h>
#include <cstdio>
#include <cstdint>
#include <type_traits>

#ifndef SINGLE_LAUNCH
#define SINGLE_LAUNCH 1
#endif
#if SINGLE_LAUNCH
#include <hip/hip_cooperative_groups.h>
namespace cg = cooperative_groups;
#endif

#define LAS __attribute__((address_space(3)))
typedef unsigned short bf16_t;
typedef short bf16x8 __attribute__((ext_vector_type(8)));
typedef float f32x4 __attribute__((ext_vector_type(4)));
typedef float f32x2 __attribute__((ext_vector_type(2)));
typedef unsigned u32x4 __attribute__((ext_vector_type(4)));
typedef unsigned u32x2 __attribute__((ext_vector_type(2)));

constexpr int DM = 1024, NB = 4, SEQ = 8192, NTOK = NB * SEQ;
constexpr int GM_G = 4, GM_D = 128, GM_W = 512, GM_C = 128;
constexpr int NH = 4, HD = 128, QKW = 512, VW = 512, CONVK = 4;
constexpr int IN_COLS = 3080, PROJ_N = 3072;
constexpr int NE = 32, TOPK = 4, DFF = 1024;
constexpr float EPS = 1e-6f;
constexpr int LIST_CAP = NTOK;
constexpr int MAX_SLOTS = NTOK * TOPK + NE * 256;

constexpr size_t MiB = 1u << 20;
constexpr size_t WS_CTL = 0;
constexpr size_t WS_MOD = 1 * MiB;
constexpr size_t WS_G = 2 * MiB;
constexpr size_t WS_BETA = 3 * MiB;
constexpr size_t WS_ROUTE = 4 * MiB;
constexpr size_t WS_LIST = 6 * MiB;
constexpr size_t WS_LOGITS = 10 * MiB;
constexpr size_t WS_WOUTT = 16 * MiB;
constexpr size_t WS_WINT = 18 * MiB;
constexpr size_t WS_WGUT = 24 * MiB;
constexpr size_t WS_WDT = 152 * MiB;
constexpr size_t WS_H8 = 184 * MiB;
constexpr size_t WS_X1 = 216 * MiB;
constexpr size_t WS_H = 344 * MiB;
constexpr size_t WS_PROJ = 408 * MiB;
constexpr size_t WS_MIXIN = 600 * MiB;
constexpr size_t WS_WN = 664 * MiB;
constexpr size_t WS_QG = 696 * MiB;
constexpr size_t WS_KDT = 728 * MiB;
constexpr size_t WS_QK = 760 * MiB;
constexpr size_t WS_UF = 776 * MiB;
constexpr size_t WS_EG = 840 * MiB;
constexpr size_t WS_SG = 856 * MiB;
constexpr size_t WS_VG = 920 * MiB;
constexpr size_t WS_ACT = 408 * MiB;
constexpr size_t WS_Y = 680 * MiB;
constexpr size_t WS_END = 952 * MiB;

constexpr int LDS_BYTES = 147456;
constexpr int LDS_MISC = 146432;
constexpr int LDS_BARST = 147200;
constexpr size_t CTL_BAR = 4096;
constexpr size_t CTL_CNT = 20480;
constexpr size_t CTL_CVT = 28672;
constexpr size_t CTL_ZERO = 32768;

typedef __bf16 bf16x2_hw __attribute__((ext_vector_type(2)));
__device__ __forceinline__ unsigned pk2(float lo, float hi) { const f32x2 v = {lo, hi}; return __builtin_bit_cast(unsigned, __builtin_convertvector(v, bf16x2_hw)); }
__device__ __forceinline__ unsigned f2bf(float f) { return pk2(f, 0.f) & 0xffffu; }
__device__ __forceinline__ float bflo(unsigned w) { return __builtin_bit_cast(float, w << 16); }
__device__ __forceinline__ float bfhi(unsigned w) { return __builtin_bit_cast(float, w & 0xffff0000u); }
__device__ __forceinline__ float wave_sum(float v) {
    v += __builtin_bit_cast(float, __builtin_amdgcn_mov_dpp(__builtin_bit_cast(int, v), 0xB1, 0xF, 0xF, true));
    v += __builtin_bit_cast(float, __builtin_amdgcn_mov_dpp(__builtin_bit_cast(int, v), 0x4E, 0xF, 0xF, true));
    v += __builtin_bit_cast(float, __builtin_amdgcn_mov_dpp(__builtin_bit_cast(int, v), 0x124, 0xF, 0xF, true));
    v += __builtin_bit_cast(float, __builtin_amdgcn_mov_dpp(__builtin_bit_cast(int, v), 0x128, 0xF, 0xF, true));
    const int iv = __builtin_bit_cast(int, v);
    const float r0 = __builtin_bit_cast(float, __builtin_amdgcn_readlane(iv, 0)), r1 = __builtin_bit_cast(float, __builtin_amdgcn_readlane(iv, 16));
    const float r2 = __builtin_bit_cast(float, __builtin_amdgcn_readlane(iv, 32)), r3 = __builtin_bit_cast(float, __builtin_amdgcn_readlane(iv, 48));
    return (r0 + r1) + (r2 + r3);
}
__device__ __forceinline__ float silu_f(float x) { return x * __builtin_amdgcn_rcpf(1.f + __expf(-x)); }
__device__ __forceinline__ float sigmoid_f(float x) { return __builtin_amdgcn_rcpf(1.f + __expf(-x)); }

namespace pg8 {
constexpr int BM = 256, BK = 64, HALF = 128, HTB = HALF * BK * 2, STAGE_BYTES = 8 * HTB, NXCD = 8, KD = 1024;
__host__ __device__ __forceinline__ void stage_map(int tid, int i, bool f8, int& R, int& C) {
    const int wid = tid >> 6, l = tid & 63; R = 64 * i + 8 * wid + (l >> 3);
    const int swz = f8 ? (((R >> 1) & 3) << 1) : (R & 7);
    C = ((l & 7) ^ swz) * 8;
}
__host__ __device__ __forceinline__ int perm32(int rho) { const int n = rho >> 4, i = rho & 15; return 8 * (i >> 2) + 4 * n + (i & 3); }

struct Unit { const char* A; const char* B0; const char* B1; unsigned vA0[2], vA1[2]; int pm, pn, e, rot; };

template <int NN = 0>
__device__ __forceinline__ bool tile_order(int i, int G, int c, int nM, int nN_, int& pm, int& pn, int WGM = 8) {
    const int nN = NN > 0 ? NN : nN_;
    const int nwg = nM * nN; const long L = (long)i * G + c; if (L >= nwg) return false;
    int wgid = (int)L; { const int q = nwg / NXCD, r = nwg % NXCD, xcd = wgid % NXCD, off = wgid / NXCD; wgid = (xcd < r ? xcd * (q + 1) : r * (q + 1) + (xcd - r) * q) + off; }
    const int nig = WGM * nN, gid = wgid / nig, fm = gid * WGM, gsz = (nM - fm) < WGM ? (nM - fm) : WGM, idx = wgid - gid * nig;
    if (gsz == 8) { pm = fm + (idx & 7); pn = idx >> 3; } else { pm = fm + (idx % gsz); pn = idx / gsz; }
    return true;
}

__device__ __forceinline__ unsigned cvt_pk_bf16(float lo, float hi) { unsigned r; asm volatile("v_cvt_pk_bf16_f32 %0, %1, %2" : "=v"(r) : "v"(lo), "v"(hi)); return r; }
__device__ __forceinline__ f32x2 gelu_pk(f32x2 v) {
    const f32x2 av = __builtin_elementwise_abs(v), d = av * 0.2316418882f + 1.0f;
    f32x2 t; t.x = __builtin_amdgcn_rcpf(d.x); t.y = __builtin_amdgcn_rcpf(d.y);
    f32x2 q = t * 0.5307027145f + (-0.7265760135f); q = q * t + 0.7107068705f; q = q * t + (-0.142248368f); q = q * t + 0.127414796f; q = q * t;
    const f32x2 s = (v * v) * (-0.72134752044f);
    f32x2 e; e.x = __builtin_amdgcn_exp2f(s.x); e.y = __builtin_amdgcn_exp2f(s.y);
    const f32x2 m = v * (q * e), r = v - m;
    f32x2 o; o.x = v.x < 0.f ? m.x : r.x; o.y = v.y < 0.f ? m.y : r.y; return o;
}

template <class Epi, class Sched, bool F8 = false, bool ALIGN = true>
__device__ __forceinline__ void gemm_phase(LAS unsigned char* lds, Sched& S, const Epi& E) {
    const int tid = threadIdx.x, wid = __builtin_amdgcn_readfirstlane(tid >> 6), lane = tid & 63, wr = wid >> 2, wc = wid & 3, fr = lane & 15, fq = lane >> 4;
    constexpr int PITCH = F8 ? KD : 2 * KD, nt = PITCH / 128;
    unsigned voffB[2];
#pragma unroll
    for (int i = 0; i < 2; ++i) { int R, C; stage_map(tid, i, F8, R, C); const int Rb = Epi::PERM ? ((R & ~31) + perm32(R & 31)) : R; voffB[i] = (unsigned)(Rb * PITCH + C * 2); }
    const size_t kstep = (size_t)(BK * 2);
    const unsigned ldsw = (unsigned)wid * 1024u;
    const int aoff = (wr * 64 + fr) * 128 + (F8 ? ((fq ^ ((fr >> 1) & 3)) << 5) : ((fq ^ (fr & 7)) << 4)), boff = (wc * 32 + fr) * 128 + (F8 ? ((fq ^ ((fr >> 1) & 3)) << 5) : ((fq ^ (fr & 7)) << 4));
    const int aoff1 = (wr * 64 + fr) * 128 + (((4 + fq) ^ (fr & 7)) << 4), boff1 = (wc * 32 + fr) * 128 + (((4 + fq) ^ (fr & 7)) << 4);
#define PG8_SA(b, h) (((b) * 2 + (h)) * HTB)
#define PG8_SB(b, h) ((4 + (b) * 2 + (h)) * HTB)
#define PG8_STAGE(bufoff, gbase, voff) do { _Pragma("unroll") for (int _i = 0; _i < 2; ++_i) \
        __builtin_amdgcn_global_load_lds((const unsigned*)((const char*)(gbase) + (voff)[_i]), (LAS unsigned*)(lds + (bufoff) + ldsw + _i * 8192), 16, 0, 0); } while (0)
    typedef int v8i_t __attribute__((ext_vector_type(8)));
    typedef int v4i_t __attribute__((ext_vector_type(4)));
#define PG8_LD32(dst_, off_) do { const v4i_t lo_ = *(const LAS v4i_t*)(lds + (off_)), hi_ = *(const LAS v4i_t*)(lds + (off_) + 16); dst_ = __builtin_shufflevector(lo_, hi_, 0, 1, 2, 3, 4, 5, 6, 7); } while (0)
#define PG8_LDA(X_, b, h) do { _Pragma("unroll") for (int m = 0; m < 4; ++m) { if constexpr (F8) PG8_LD32(X_##8[m], PG8_SA(b, h) + aoff + m * 2048); \
        else { X_[m][0] = *(const LAS bf16x8*)(lds + PG8_SA(b, h) + aoff + m * 2048); X_[m][1] = *(const LAS bf16x8*)(lds + PG8_SA(b, h) + aoff1 + m * 2048); } } } while (0)
#define PG8_LDB(X_, b, h) do { _Pragma("unroll") for (int n = 0; n < 2; ++n) { if constexpr (F8) PG8_LD32(X_##8[n], PG8_SB(b, h) + boff + n * 2048); \
        else { X_[n][0] = *(const LAS bf16x8*)(lds + PG8_SB(b, h) + boff + n * 2048); X_[n][1] = *(const LAS bf16x8*)(lds + PG8_SB(b, h) + boff1 + n * 2048); } } } while (0)
#define PG8_MMA(ai, bj, At_, Bt_) do { __builtin_amdgcn_s_setprio(1); _Pragma("unroll") for (int m = 0; m < 4; ++m) _Pragma("unroll") for (int n = 0; n < 2; ++n) { \
        if constexpr (F8) { asm volatile("v_mfma_scale_f32_16x16x128_f8f6f4 %0, %1, %2, %0, %3, %4 op_sel_hi:[0,0,0]" : "+v"(acc[ai][bj][m][n]) : "v"(Bt_##8[n]), "v"(At_##8[m]), "v"(scale_w), "v"(scale_a)); } \
        else { _Pragma("unroll") for (int k = 0; k < 2; ++k) acc[ai][bj][m][n] = __builtin_amdgcn_mfma_f32_16x16x32_bf16(Bt_[n][k], At_[m][k], acc[ai][bj][m][n], 0, 0, 0); } } \
        __builtin_amdgcn_s_setprio(0); } while (0)
#define PG8_WAIT_V(n) asm volatile("s_waitcnt vmcnt(" #n ")" ::: "memory")
#define PG8_WAIT_L(n) asm volatile("s_waitcnt lgkmcnt(" #n ")" ::: "memory")
#define PG8_BAR __builtin_amdgcn_s_barrier()
#define PG8_SCHED __builtin_amdgcn_sched_barrier(0)
    Unit cur, nxt; int ui = 0;
    if (!S.next(0, cur)) return;
    f32x4 acc[2][2][4][2];
#pragma unroll
    for (int a = 0; a < 2; ++a)
#pragma unroll
        for (int b = 0; b < 2; ++b)
#pragma unroll
            for (int m = 0; m < 4; ++m)
#pragma unroll
                for (int n = 0; n < 2; ++n) acc[a][b][m][n] = (f32x4){0.f, 0.f, 0.f, 0.f};
    bf16x8 At[4][2], B0[2][2], B1[2][2]; v8i_t At8[4], B08[2], B18[2];
    int scale_w = 0x7a7a7a7a, scale_a = 0x7f7f7f7f; asm volatile("" : "+v"(scale_w), "+v"(scale_a));
#define PG8_KO(u_, j_) ((size_t)(((j_) + (u_).rot) & (nt - 1)) * kstep)
    { const size_t k0 = PG8_KO(cur, 0), k1 = PG8_KO(cur, 1);
    PG8_STAGE(PG8_SB(0, 0), cur.B0 + k0, voffB); PG8_STAGE(PG8_SB(0, 1), cur.B1 + k0, voffB); PG8_STAGE(PG8_SA(0, 0), cur.A + k0, cur.vA0); PG8_STAGE(PG8_SA(0, 1), cur.A + k0, cur.vA1);
    if (wr == 1) PG8_BAR;
    PG8_WAIT_V(2); PG8_BAR;
    PG8_STAGE(PG8_SB(1, 0), cur.B0 + k1, voffB); PG8_STAGE(PG8_SA(1, 0), cur.A + k1, cur.vA0); PG8_STAGE(PG8_SB(1, 1), cur.B1 + k1, voffB);
    PG8_WAIT_V(6); PG8_BAR; }
    for (;;) {
        const bool has_next = S.next(ui + 1, nxt);
#pragma nounroll
        for (int t = 0; t < nt; t += 2) {
            const bool last = (t == nt - 2);
            const bool fromn = last && has_next;
            const int rot2 = fromn ? nxt.rot : cur.rot, j2 = last ? 0 : t + 2;
            const size_t ko2 = (size_t)((j2 + rot2) & (nt - 1)) * kstep, ko3 = (size_t)((j2 + 1 + rot2) & (nt - 1)) * kstep;
            const char* a2 = (fromn ? nxt.A : cur.A); const char* b20 = (fromn ? nxt.B0 : cur.B0); const char* b21 = (fromn ? nxt.B1 : cur.B1);
            unsigned w0[2], w1[2];
#pragma unroll
            for (int i = 0; i < 2; ++i) { w0[i] = fromn ? nxt.vA0[i] : cur.vA0[i]; w1[i] = fromn ? nxt.vA1[i] : cur.vA1[i]; }
            const char* a1 = cur.A + PG8_KO(cur, t + 1);
            PG8_LDB(B0, 0, 0); PG8_LDB(B1, 0, 1); PG8_SCHED; PG8_LDA(At, 0, 0); PG8_STAGE(PG8_SA(1, 1), a1, cur.vA1);
            PG8_WAIT_V(8); PG8_WAIT_L(0); PG8_BAR; PG8_MMA(0, 0, At, B0); PG8_MMA(0, 1, At, B1); PG8_BAR; PG8_SCHED;
            PG8_LDA(At, 0, 1); PG8_STAGE(PG8_SB(0, 0), b20 + ko2, voffB); PG8_STAGE(PG8_SB(0, 1), b21 + ko2, voffB); PG8_STAGE(PG8_SA(0, 0), a2 + ko2, w0);
            PG8_WAIT_V(8); PG8_WAIT_L(0); PG8_BAR; PG8_MMA(1, 0, At, B0); PG8_MMA(1, 1, At, B1); PG8_BAR; PG8_SCHED;
            PG8_LDB(B0, 1, 0); PG8_LDB(B1, 1, 1); PG8_SCHED; PG8_LDA(At, 1, 0); PG8_STAGE(PG8_SA(0, 1), a2 + ko2, w1);
            PG8_WAIT_V(8); PG8_WAIT_L(0); PG8_BAR; PG8_MMA(0, 0, At, B0); PG8_MMA(0, 1, At, B1); PG8_BAR; PG8_SCHED;
            PG8_LDA(At, 1, 1); PG8_STAGE(PG8_SB(1, 0), b20 + ko3, voffB); PG8_STAGE(PG8_SB(1, 1), b21 + ko3, voffB); PG8_STAGE(PG8_SA(1, 0), a2 + ko3, w0);
            PG8_WAIT_V(8); PG8_WAIT_L(0); PG8_BAR; PG8_MMA(1, 0, At, B0); PG8_MMA(1, 1, At, B1); PG8_BAR; PG8_SCHED;
        }
        if constexpr (ALIGN) { if (wr == 0) PG8_BAR; }
        if constexpr (F8) asm volatile("s_nop 15\n\ts_nop 15" ::: "memory");
        E(acc, cur, wr, wc, fr, fq);
        if (!has_next) break;
#pragma unroll
        for (int a = 0; a < 2; ++a)
#pragma unroll
            for (int b = 0; b < 2; ++b)
#pragma unroll
                for (int m = 0; m < 4; ++m)
#pragma unroll
                    for (int n = 0; n < 2; ++n) acc[a][b][m][n] = (f32x4){0.f, 0.f, 0.f, 0.f};
        cur = nxt; ++ui;
        if constexpr (ALIGN) { if (wr == 1) PG8_BAR; }
    }
    PG8_WAIT_V(0);
    if constexpr (!ALIGN) { if (wr == 0) PG8_BAR; }
    PG8_BAR;
#undef PG8_SA
#undef PG8_SB
#undef PG8_KO
#undef PG8_STAGE
#undef PG8_LDA
#undef PG8_LD32
#undef PG8_LDB
#undef PG8_MMA
#undef PG8_WAIT_V
#undef PG8_WAIT_L
#undef PG8_BAR
#undef PG8_SCHED
}

#ifndef WGM_DENSE
#define WGM_DENSE 8
#endif
#ifndef WGM_MOE1
#define WGM_MOE1 8
#endif
#ifndef WGM_MOE2
#define WGM_MOE2 8
#endif
#ifndef ROT_DENSE
#define ROT_DENSE 1
#endif
#ifndef ROT_MOE
#define ROT_MOE 1
#endif
#ifndef ALIGN_MOE1
#define ALIGN_MOE1 true
#endif
#ifndef ALIGN_MOE2
#define ALIGN_MOE2 true
#endif
template <int PITCH = 2 * KD> struct DenseSchedT {
    const char* A; const char* Bt; int nM, nN, G, c; int R[2], C[2]; bool same_tile = false;
    __device__ __forceinline__ void init(const void* A_, const void* Bt_, int M, int N, int G_, int c_) {
        A = (const char*)A_; Bt = (const char*)Bt_; nM = M / BM; nN = N / BM; G = G_; c = c_;
#pragma unroll
        for (int i = 0; i < 2; ++i) stage_map((int)threadIdx.x, i, PITCH == KD, R[i], C[i]);
    }
    __device__ __forceinline__ bool next(int i, Unit& u) const {
        int pm, pn; if (!tile_order(i, G, c, nM, nN, pm, pn, WGM_DENSE)) return false;
        if (same_tile) { pm = 0; pn = 0; }
        u.pm = pm; u.pn = pn; u.e = 0; u.rot = ROT_DENSE ? pm + pn : 0; u.A = A; u.B0 = Bt + (size_t)pn * 256 * PITCH; u.B1 = u.B0 + (size_t)128 * PITCH;
#pragma unroll
        for (int i2 = 0; i2 < 2; ++i2) { u.vA0[i2] = (unsigned)((pm * 256 + R[i2]) * PITCH + C[i2] * 2); u.vA1[i2] = u.vA0[i2] + 128u * PITCH; }
        return true;
    }
};
typedef DenseSchedT<2 * KD> DenseSched;
struct MoeTab { const LAS int* tp; const LAS int* cnt; const LAS int* te; };
__device__ __forceinline__ int moe_find(const MoeTab& T, int pm) { return __builtin_amdgcn_readfirstlane(T.te[pm]); }
template <int PITCH> struct Moe1Sched {
    const char* A; const char* Bt; const int* list; MoeTab T; int nM, nN, G, c, imax; int R[2], C[2];
    int ptok[4];
    __device__ __forceinline__ void fetch(int i) {
        int pm, pn; (void)tile_order<8>(i < imax ? i : imax, G, c, nM, nN, pm, pn, WGM_MOE1);
        const int e = moe_find(T, pm), ml = pm - __builtin_amdgcn_readfirstlane(T.tp[e]), ce = __builtin_amdgcn_readfirstlane(T.cnt[e]);
#pragma unroll
        for (int i2 = 0; i2 < 2; ++i2) { const int i0 = ml * 256 + R[i2], i1 = i0 + 128;
            ptok[2 * i2] = list[(size_t)e * LIST_CAP + (i0 < ce ? i0 : ce - 1)]; ptok[2 * i2 + 1] = list[(size_t)e * LIST_CAP + (i1 < ce ? i1 : ce - 1)]; }
    }
    __device__ __forceinline__ void init(const void* A_, const void* Bt_, const int* list_, MoeTab T_, int nM_, int G_, int c_) {
        A = (const char*)A_; Bt = (const char*)Bt_; list = list_; T = T_; nM = nM_; nN = 8; G = G_; c = c_;
        const int nwg = nM * nN; imax = nwg > c ? (nwg - 1 - c) / G : 0;
#pragma unroll
        for (int i = 0; i < 2; ++i) stage_map((int)threadIdx.x, i, true, R[i], C[i]);
        if (nwg > c) fetch(0);
    }
    __device__ __forceinline__ bool next(int i, Unit& u) {
        int pm, pn; if (!tile_order<8>(i, G, c, nM, nN, pm, pn, WGM_MOE1)) return false;
        const int e = moe_find(T, pm);
        u.pm = pm; u.pn = pn; u.e = e; u.rot = ROT_MOE ? pm + pn : 0; u.A = A;
        u.B0 = Bt + ((size_t)e * 2048 + 128 * pn) * PITCH; u.B1 = Bt + ((size_t)e * 2048 + 1024 + 128 * pn) * PITCH;
#pragma unroll
        for (int i2 = 0; i2 < 2; ++i2) { u.vA0[i2] = (unsigned)(ptok[2 * i2] * PITCH + C[i2] * 2); u.vA1[i2] = (unsigned)(ptok[2 * i2 + 1] * PITCH + C[i2] * 2); }
        fetch(i + 1);
        return true;
    }
};
template <int PITCH> struct Moe2Sched {
    const char* A; const char* Bt; MoeTab T; int nM, nN, G, c; int R[2], C[2];
    __device__ __forceinline__ void init(const void* A_, const void* Bt_, MoeTab T_, int nM_, int G_, int c_) {
        A = (const char*)A_; Bt = (const char*)Bt_; T = T_; nM = nM_; nN = 4; G = G_; c = c_;
#pragma unroll
        for (int i = 0; i < 2; ++i) stage_map((int)threadIdx.x, i, true, R[i], C[i]);
    }
    __device__ __forceinline__ bool next(int i, Unit& u) const {
        int pm, pn; if (!tile_order<4>(i, G, c, nM, nN, pm, pn, WGM_MOE2)) return false;
        const int e = moe_find(T, pm);
        u.pm = pm; u.pn = pn; u.e = e; u.rot = ROT_MOE ? pm + pn : 0; u.A = A;
        u.B0 = Bt + ((size_t)e * 1024 + 256 * pn) * PITCH; u.B1 = u.B0 + (size_t)128 * PITCH;
#pragma unroll
        for (int i2 = 0; i2 < 2; ++i2) { u.vA0[i2] = (unsigned)((pm * 256 + R[i2]) * PITCH + C[i2] * 2); u.vA1[i2] = u.vA0[i2] + 128u * PITCH; }
        return true;
    }
};

struct EpiProj {
    static constexpr bool PERM = true;
    bf16_t* O;
    __device__ __forceinline__ void operator()(const f32x4 (&acc)[2][2][4][2], const Unit& u, int wr, int wc, int fr, int fq) const {
        const int row0 = u.pm * BM + wr * 64 + fr, col0 = u.pn * BM + wc * 32 + 8 * fq; const bool act = u.pn < 4;
#pragma unroll
        for (int ai = 0; ai < 2; ++ai)
#pragma unroll
            for (int m = 0; m < 4; ++m) { bf16_t* rowp = O + (size_t)(row0 + ai * HALF + m * 16) * PROJ_N + col0;
#pragma unroll
                for (int bj = 0; bj < 2; ++bj) { f32x4 v0 = acc[ai][bj][m][0], v1 = acc[ai][bj][m][1];
                    if (act) { f32x2 a = gelu_pk((f32x2){v0[0], v0[1]}), b = gelu_pk((f32x2){v0[2], v0[3]}), c = gelu_pk((f32x2){v1[0], v1[1]}), d = gelu_pk((f32x2){v1[2], v1[3]});
                        v0 = (f32x4){a.x, a.y, b.x, b.y}; v1 = (f32x4){c.x, c.y, d.x, d.y}; }
                    u32x4 w; w.x = cvt_pk_bf16(v0[0], v0[1]); w.y = cvt_pk_bf16(v0[2], v0[3]); w.z = cvt_pk_bf16(v1[0], v1[1]); w.w = cvt_pk_bf16(v1[2], v1[3]);
                    *(u32x4*)(rowp + bj * HALF) = w; } }
    }
};
struct EpiMix {
    static constexpr bool PERM = true;
    const float* x; const float* mod; bf16_t* X1;
    __device__ __forceinline__ void operator()(const f32x4 (&acc)[2][2][4][2], const Unit& u, int wr, int wc, int fr, int fq) const {
        const int row0 = u.pm * BM + wr * 64 + fr, col0 = u.pn * BM + wc * 32 + 8 * fq;
        const int b = (u.pm * BM) / SEQ; const float* g1 = mod + (size_t)b * 6 * DM + 2 * DM;
        f32x4 gv[2][2];
#pragma unroll
        for (int bj = 0; bj < 2; ++bj)
#pragma unroll
            for (int n = 0; n < 2; ++n) gv[bj][n] = *(const f32x4*)(g1 + col0 + bj * HALF + 4 * n);
#pragma unroll
        for (int ai = 0; ai < 2; ++ai)
#pragma unroll
            for (int m = 0; m < 4; ++m) { const size_t off = (size_t)(row0 + ai * HALF + m * 16) * DM + col0;
#pragma unroll
                for (int bj = 0; bj < 2; ++bj) {
                    const f32x4 x0 = *(const f32x4*)(x + off + bj * HALF), x1 = *(const f32x4*)(x + off + bj * HALF + 4);
                    const f32x4 v0 = x0 + gv[bj][0] * acc[ai][bj][m][0], v1 = x1 + gv[bj][1] * acc[ai][bj][m][1];
                    u32x4 w; w.x = cvt_pk_bf16(v0[0], v0[1]); w.y = cvt_pk_bf16(v0[2], v0[3]); w.z = cvt_pk_bf16(v1[0], v1[1]); w.w = cvt_pk_bf16(v1[2], v1[3]);
                    *(u32x4*)(X1 + off + bj * HALF) = w; }
                asm volatile("" ::: "memory"); }
    }
};
struct EpiAct {
    static constexpr bool PERM = true;
    const float* bgu; unsigned char* O;
    __device__ __forceinline__ void operator()(const f32x4 (&acc)[2][2][4][2], const Unit& u, int wr, int wc, int fr, int fq) const {
        const int row0 = u.pm * BM + wr * 64 + fr, f0 = u.pn * 128 + wc * 32 + 8 * fq;
        const float* bg = bgu + (size_t)u.e * 2048 + f0; const float* bu = bg + 1024;
        const f32x4 bg0 = *(const f32x4*)bg, bg1 = *(const f32x4*)(bg + 4), bu0 = *(const f32x4*)bu, bu1 = *(const f32x4*)(bu + 4);
#pragma unroll
        for (int ai = 0; ai < 2; ++ai)
#pragma unroll
            for (int m = 0; m < 4; ++m) {
                float r[8];
#pragma unroll
                for (int n = 0; n < 2; ++n)
#pragma unroll
                    for (int j = 0; j < 4; ++j) {
                        float g = acc[ai][0][m][n][j] + (n ? bg1[j] : bg0[j]), up = acc[ai][1][m][n][j] + (n ? bu1[j] : bu0[j]);
                        g = fminf(g, 7.0f); up = fminf(fmaxf(up, -7.0f), 7.0f);
                        r[n * 4 + j] = g * sigmoid_f(1.702f * g) * (up + 1.0f);
                    }
                int w0 = 0, w1 = 0;
                w0 = __builtin_amdgcn_cvt_pk_fp8_f32(r[0], r[1], w0, false); w0 = __builtin_amdgcn_cvt_pk_fp8_f32(r[2], r[3], w0, true);
                w1 = __builtin_amdgcn_cvt_pk_fp8_f32(r[4], r[5], w1, false); w1 = __builtin_amdgcn_cvt_pk_fp8_f32(r[6], r[7], w1, true);
                *(u32x2*)(O + (size_t)(row0 + ai * HALF + m * 16) * DFF + f0) = (u32x2){(unsigned)w0, (unsigned)w1};
            }
    }
};
struct EpiY {
    static constexpr bool PERM = true;
    const float* bd; unsigned char* O;
    __device__ __forceinline__ void operator()(const f32x4 (&acc)[2][2][4][2], const Unit& u, int wr, int wc, int fr, int fq) const {
        const int row0 = u.pm * BM + wr * 64 + fr, col0 = u.pn * BM + wc * 32 + 8 * fq;
        const float* b = bd + (size_t)u.e * DM + col0;
        f32x4 bv[2][2];
#pragma unroll
        for (int bj = 0; bj < 2; ++bj)
#pragma unroll
            for (int n = 0; n < 2; ++n) bv[bj][n] = *(const f32x4*)(b + bj * HALF + 4 * n);
#pragma unroll
        for (int ai = 0; ai < 2; ++ai)
#pragma unroll
            for (int m = 0; m < 4; ++m) { unsigned char* rowp = O + (size_t)(row0 + ai * HALF + m * 16) * DM + col0;
#pragma unroll
                for (int bj = 0; bj < 2; ++bj) { const f32x4 v0 = acc[ai][bj][m][0] + bv[bj][0], v1 = acc[ai][bj][m][1] + bv[bj][1];
                    int w0 = 0, w1 = 0;
                    w0 = __builtin_amdgcn_cvt_pk_fp8_f32(v0[0], v0[1], w0, false); w0 = __builtin_amdgcn_cvt_pk_fp8_f32(v0[2], v0[3], w0, true);
                    w1 = __builtin_amdgcn_cvt_pk_fp8_f32(v1[0], v1[1], w1, false); w1 = __builtin_amdgcn_cvt_pk_fp8_f32(v1[2], v1[3], w1, true);
                    *(u32x2*)(rowp + bj * HALF) = (u32x2){(unsigned)w0, (unsigned)w1}; } }
    }
};
}

struct Args {
    const float *x, *c, *w_ada, *b_ada, *norm1_w, *w_in, *gm_vnorm_w, *gm_w_spatial, *gm_b_spatial, *gdn_conv_w, *gdn_a_log, *gdn_dt_bias, *gdn_onorm_w,
        *w_out, *norm2_w, *w_router, *b_router, *w_gu, *b_gu, *w_down, *b_down, *norm_f_w;
    float* out; unsigned char* ws; int ph_lo, ph_hi;
};

struct Ctx { LAS unsigned char* lds; int tid, lane, wave, G, bid; };

__device__ __forceinline__ void transpose_item(const float* W, int ld, bf16_t* WT, int Kp, int k0, int n0, int row_off, LAS float* scr, int lane) {
#pragma unroll 8
    for (int i = 0; i < 32; ++i) { const int kk = 2 * i + (lane >> 5); scr[kk * 33 + (lane & 31)] = W[(size_t)(k0 + kk) * ld + n0 + (lane & 31)]; }
    asm volatile("s_waitcnt lgkmcnt(0)" ::: "memory");
    const int c = lane & 7;
#pragma unroll
    for (int j = 0; j < 4; ++j) { const int n = (lane >> 3) + 8 * j; const LAS float* s = scr + (8 * c) * 33 + n;
        u32x4 o; o.x = pk2(s[0 * 33], s[1 * 33]); o.y = pk2(s[2 * 33], s[3 * 33]); o.z = pk2(s[4 * 33], s[5 * 33]); o.w = pk2(s[6 * 33], s[7 * 33]);
        *(u32x4*)(WT + (size_t)(row_off + n0 + n) * Kp + k0 + 8 * c) = o; }
    asm volatile("s_waitcnt lgkmcnt(0)" ::: "memory");
}

__device__ __forceinline__ void transpose_item_f8(const float* W, int ld, unsigned char* WT, int Kp, int k0, int n0, LAS float* scr, int lane) {
#pragma unroll 8
    for (int i = 0; i < 32; ++i) { const int kk = 2 * i + (lane >> 5); scr[kk * 33 + (lane & 31)] = W[(size_t)(k0 + kk) * ld + n0 + (lane & 31)]; }
    asm volatile("s_waitcnt lgkmcnt(0)" ::: "memory");
    const int c = lane & 3;
#pragma unroll
    for (int j = 0; j < 2; ++j) { const int n = (lane >> 2) + 16 * j; const LAS float* sp = scr + (16 * c) * 33 + n; int w[4];
#pragma unroll
        for (int q = 0; q < 4; ++q) { int t = 0; t = __builtin_amdgcn_cvt_pk_fp8_f32(sp[(4 * q) * 33] * 32.f, sp[(4 * q + 1) * 33] * 32.f, t, false); t = __builtin_amdgcn_cvt_pk_fp8_f32(sp[(4 * q + 2) * 33] * 32.f, sp[(4 * q + 3) * 33] * 32.f, t, true); w[q] = t; }
        *(u32x4*)(WT + (size_t)(n0 + n) * Kp + k0 + 16 * c) = (u32x4){(unsigned)w[0], (unsigned)w[1], (unsigned)w[2], (unsigned)w[3]}; }
    asm volatile("s_waitcnt lgkmcnt(0)" ::: "memory");
}
__device__ __forceinline__ void phase_prep0(const Args& a, const Ctx& X) {
    unsigned char* ws = a.ws;
    {
        LAS float* cact = (LAS float*)X.lds;
        LAS f32x4* part = (LAS f32x4*)(X.lds + 16384);
        for (int i = X.tid; i < NB * DM; i += 512) cact[i] = silu_f(a.c[i]);
        __syncthreads();
        float* mod = (float*)(ws + WS_MOD);
        for (int cgp = X.bid; cgp < 256; cgp += X.G) {
            const int j0 = 24 * cgp;
            if (X.tid < 384) {
                const int q = X.tid % 6, kc = X.tid / 6;
                f32x4 s[4] = {{0, 0, 0, 0}, {0, 0, 0, 0}, {0, 0, 0, 0}, {0, 0, 0, 0}};
#pragma unroll 4
                for (int kk = 0; kk < 16; ++kk) { const int k = kc * 16 + kk; const f32x4 w = *(const f32x4*)(a.w_ada + (size_t)k * 6144 + j0 + 4 * q);
#pragma unroll
                    for (int b = 0; b < 4; ++b) s[b] += w * cact[b * DM + k]; }
#pragma unroll
                for (int b = 0; b < 4; ++b) part[(kc * 4 + b) * 6 + q] = s[b];
            }
            __syncthreads();
            if (X.tid < 96) { const int b = X.tid / 24, col = X.tid % 24; float s = 0.f;
                for (int kc = 0; kc < 64; ++kc) s += part[(kc * 4 + b) * 6 + (col >> 2)][col & 3];
                mod[b * 6144 + j0 + col] = s + a.b_ada[j0 + col]; }
            __syncthreads();
        }
    }
    {
        LAS float* scr = (LAS float*)(X.lds + X.wave * 16384);
        const int gw = X.bid * 8 + X.wave, NGW = X.G * 8;
        bf16_t* WinT = (bf16_t*)(ws + WS_WINT); bf16_t* WoutT = (bf16_t*)(ws + WS_WOUTT);
        constexpr int I_IN = 16 * 96, I_OUT = 16 * 32;
        constexpr int NITEMS = I_IN + I_OUT;
        for (int it = gw; it < NITEMS; it += NGW) {
            int r = it;
            if (r < I_IN) { transpose_item(a.w_in, IN_COLS, WinT, DM, 64 * (r / 96), 32 * (r % 96), 0, scr, X.lane); continue; } r -= I_IN;
            transpose_item_f8(a.w_out, DM, (unsigned char*)WoutT, DM, 64 * (r / 32), 32 * (r % 32), scr, X.lane);
        }
    }
}

__device__ __forceinline__ void cv_item(const Args& a, unsigned char* ws, int it, const float*& src, int& ld, unsigned char*& dst) {
    constexpr int I_GU = 32 * 16 * 64;
    if (it < I_GU) { const int e = it / 1024, q = it % 1024, k0 = 64 * (q / 64), n0 = 32 * (q % 64); ld = 2048; src = a.w_gu + (size_t)e * DM * 2048 + (size_t)k0 * 2048 + n0; dst = ws + WS_WGUT + ((size_t)e * 2048 + n0) * DM + k0; }
    else { const int r = it - I_GU, e = r / 512, q = r % 512, k0 = 64 * (q / 32), n0 = 32 * (q % 32); ld = DM; src = a.w_down + (size_t)e * DFF * DM + (size_t)k0 * DM + n0; dst = ws + WS_WDT + ((size_t)e * DM + n0) * DFF + k0; }
}
__device__ __forceinline__ void cv_load(f32x4 (&r)[8], const float* src, int ld, int lane) {
#pragma unroll
    for (int i = 0; i < 8; ++i) r[i] = *(const f32x4*)(src + (size_t)(8 * i + (lane >> 3)) * ld + 4 * (lane & 7));
}
__device__ __forceinline__ void cv_store(const f32x4 (&r)[8], unsigned char* dst, LAS float* scr, int lane) {
#pragma unroll
    for (int i = 0; i < 8; ++i) { LAS float* p = scr + (8 * i + (lane >> 3)) * 33 + 4 * (lane & 7); p[0] = r[i].x; p[1] = r[i].y; p[2] = r[i].z; p[3] = r[i].w; }
    asm volatile("s_waitcnt lgkmcnt(0)" ::: "memory");
    const int c = lane & 3;
#pragma unroll
    for (int j = 0; j < 2; ++j) { const int n = (lane >> 2) + 16 * j; const LAS float* sp = scr + (16 * c) * 33 + n; int w[4];
#pragma unroll
        for (int q = 0; q < 4; ++q) { int t = 0; t = __builtin_amdgcn_cvt_pk_fp8_f32(sp[(4 * q) * 33] * 32.f, sp[(4 * q + 1) * 33] * 32.f, t, false); t = __builtin_amdgcn_cvt_pk_fp8_f32(sp[(4 * q + 2) * 33] * 32.f, sp[(4 * q + 3) * 33] * 32.f, t, true); w[q] = t; }
        *(u32x4*)(dst + (size_t)n * 1024 + 16 * c) = (u32x4){(unsigned)w[0], (unsigned)w[1], (unsigned)w[2], (unsigned)w[3]}; }
    asm volatile("s_waitcnt lgkmcnt(0)" ::: "memory");
}
__device__ __forceinline__ void convert_experts(const Args& a, const Ctx& X, int vb, int nvb, int it_lo, int it_hi) {
    unsigned char* ws = a.ws;
    LAS float* scr = (LAS float*)(X.lds + X.wave * 16384);
    const int step = nvb * 8; int it = it_lo + vb * 8 + X.wave;
    if (it >= it_hi) return;
    const float* src; int ld; unsigned char* dst; f32x4 cur[8], nxt[8];
    cv_item(a, ws, it, src, ld, dst); cv_load(cur, src, ld, X.lane);
    for (; it < it_hi; it += step) {
        const float* src2; int ld2; unsigned char* dst2;
        cv_item(a, ws, it + step < it_hi ? it + step : it, src2, ld2, dst2);
        cv_load(nxt, src2, ld2, X.lane);
        cv_store(cur, dst, scr, X.lane);
#pragma unroll
        for (int i = 0; i < 8; ++i) cur[i] = nxt[i];
        dst = dst2;
    }
}

__device__ __forceinline__ void phase_rows1(const Args& a, const Ctx& X) {
    unsigned char* ws = a.ws; const float* mod = (const float*)(ws + WS_MOD); const float* src = a.x; bf16_t* dst = (bf16_t*)(ws + WS_H);
    LAS float* scl = (LAS float*)X.lds;
    LAS float* shf = scl + 4 * DM;
    LAS float* w8 = shf + 4 * DM;
    for (int i = X.tid; i < NB * DM; i += 512) { const int b = i >> 10, k = i & 1023; scl[i] = a.norm1_w[k] * (1.f + mod[b * 6144 + 1 * DM + k]); shf[i] = mod[b * 6144 + 0 * DM + k]; }
    for (int i = X.tid; i < DM * 8; i += 512) { const int k = i >> 3, c = i & 7, j = k >> 8, l = (k & 255) >> 2, e = k & 3;
        w8[((((c >> 2) * 4 + j) * 4 + e) * 64 + l) * 4 + (c & 3)] = a.w_in[(size_t)k * IN_COLS + PROJ_N + c]; }
    __syncthreads();
    float* G = (float*)(ws + WS_G); float* BT = (float*)(ws + WS_BETA);
    const int gw = X.bid * 8 + X.wave, NGW = X.G * 8;
    const float dtb = a.gdn_dt_bias[X.lane & 3], aexp = __expf(a.gdn_a_log[X.lane & 3]);
    f32x4 nx[4], nx2[4];
    { const f32x4* xr = (const f32x4*)(src + (size_t)gw * DM) + X.lane; const f32x4* xr2 = (const f32x4*)(src + (size_t)(gw + NGW) * DM) + X.lane;
#pragma unroll
        for (int j = 0; j < 4; ++j) { nx[j] = xr[64 * j]; nx2[j] = xr2[64 * j]; } }
    for (int m = gw; m < NTOK; m += NGW) {
        const int b = m / SEQ;
        f32x4 v[4]; float ss = 0.f;
#pragma unroll
        for (int j = 0; j < 4; ++j) { v[j] = nx[j]; nx[j] = nx2[j]; }
        { const int mp = m + 2 * NGW < NTOK ? m + 2 * NGW : m;
          const f32x4* xr = (const f32x4*)(src + (size_t)mp * DM) + X.lane;
#pragma unroll
            for (int j = 0; j < 4; ++j) nx2[j] = xr[64 * j]; }
#pragma unroll
        for (int j = 0; j < 4; ++j) ss += (v[j].x * v[j].x + v[j].y * v[j].y) + (v[j].z * v[j].z + v[j].w * v[j].w);
        const float rstd = __builtin_amdgcn_rsqf(wave_sum(ss) * (1.f / DM) + EPS);
        float ab[8] = {0, 0, 0, 0, 0, 0, 0, 0};
        unsigned long long* o8 = (unsigned long long*)(dst + (size_t)m * DM) + X.lane;
#pragma unroll
        for (int j = 0; j < 4; ++j) {
            const int k0 = 4 * X.lane + 256 * j;
            const f32x4 sc = *(const LAS f32x4*)(scl + b * DM + k0), sf = *(const LAS f32x4*)(shf + b * DM + k0);
            const f32x4 h = v[j] * rstd * sc + sf;
            o8[64 * j] = (unsigned long long)pk2(h.x, h.y) | ((unsigned long long)pk2(h.z, h.w) << 32);
#pragma unroll
            for (int e = 0; e < 4; ++e) { const f32x4 wa = *(const LAS f32x4*)(w8 + (((0 * 4 + j) * 4 + e) * 64 + X.lane) * 4), wb = *(const LAS f32x4*)(w8 + (((1 * 4 + j) * 4 + e) * 64 + X.lane) * 4);
                ab[0] += h[e] * wa.x; ab[1] += h[e] * wa.y; ab[2] += h[e] * wa.z; ab[3] += h[e] * wa.w; ab[4] += h[e] * wb.x; ab[5] += h[e] * wb.y; ab[6] += h[e] * wb.z; ab[7] += h[e] * wb.w; }
        }
#pragma unroll
        for (int e = 0; e < 8; ++e) ab[e] = wave_sum(ab[e]);
        if (X.lane < 4) { const int hh = X.lane; const float av = (hh == 0 ? ab[0] : hh == 1 ? ab[1] : hh == 2 ? ab[2] : ab[3]) + dtb;
            const float sp = av > 20.f ? av : __logf(1.f + __expf(av)); G[(size_t)m * 4 + hh] = -aexp * sp; }
        else if (X.lane < 8) { const int hh = X.lane - 4; const float bv = (hh == 0 ? ab[4] : hh == 1 ? ab[5] : hh == 2 ? ab[6] : ab[7]); BT[(size_t)m * 4 + hh] = sigmoid_f(bv); }
    }
}

__device__ __forceinline__ int off256(int row, int col) { return row * 256 + ((((col >> 3) ^ row) & 15) << 4) + ((col & 7) << 1); }
__device__ __forceinline__ int off128(int row, int col) { return row * 128 + ((((col >> 3) ^ row ^ (row >> 4)) & 7) << 4) + ((col & 7) << 1); }
__device__ __forceinline__ bf16x8 frag256(const LAS unsigned char* img, int r0, int ks, int lane) { return *(const LAS bf16x8*)(img + off256(r0 + (lane & 15), 32 * ks + 8 * (lane >> 4))); }
__device__ __forceinline__ bf16x8 frag128(const LAS unsigned char* img, int r0, int ks, int lane) { return *(const LAS bf16x8*)(img + off128(r0 + (lane & 15), 32 * ks + 8 * (lane >> 4))); }
#define MFMA16(a, b, c) __builtin_amdgcn_mfma_f32_16x16x32_bf16((a), (b), (c), 0, 0, 0)
constexpr int GM_WS = 0, GM_VT = 32768;
__device__ __forceinline__ void phase_gmlp(const Args& a, const Ctx& X, int vb, int nvb) {
    unsigned char* ws = a.ws; const bf16_t* P = (const bf16_t*)(ws + WS_PROJ); bf16_t* MIX = (bf16_t*)(ws + WS_MIXIN);
    LAS unsigned char* L = X.lds;
    const int w = X.wave;
    int gcur = -1;
    u32x4 vpre[4];
    if (vb < NB * 64 * GM_G) { const int g0 = vb & 3, n0 = (vb >> 2) & 63, b0 = vb >> 8; const u32x4* vp = (const u32x4*)(P + ((size_t)b0 * SEQ + (size_t)n0 * GM_C + (X.tid >> 2)) * PROJ_N + GM_W + g0 * GM_D + (X.tid & 3) * 32);
#pragma unroll
        for (int q = 0; q < 4; ++q) vpre[q] = vp[q]; }
    for (int it = vb; it < NB * 64 * GM_G; it += nvb) {
        int tid_o = X.tid; asm volatile("" : "+v"(tid_o));
        const int lane = tid_o & 63, fr = lane & 15, fq = lane >> 4;
        const int g = it & 3, n = (it >> 2) & 63, b = it >> 8;
        const size_t row0 = (size_t)b * SEQ + (size_t)n * GM_C;
        __syncthreads();
        if (g != gcur) {
            gcur = g;
            const int t = tid_o >> 2, sp = tid_o & 3;
            const float* wr = a.gm_w_spatial + (size_t)g * 16384 + t * 128 + 32 * sp;
#pragma unroll
            for (int q = 0; q < 4; ++q) {
                const f32x4 x0 = *(const f32x4*)(wr + 8 * q), x1 = *(const f32x4*)(wr + 8 * q + 4); const int s0 = 32 * sp + 8 * q;
                const float f[8] = {x0.x, x0.y, x0.z, x0.w, x1.x, x1.y, x1.z, x1.w}; float m[8];
#pragma unroll
                for (int e = 0; e < 8; ++e) m[e] = (s0 + e <= t) ? f[e] : 0.f;
                *(LAS u32x4*)(L + GM_WS + off256(t, s0)) = (u32x4){pk2(m[0], m[1]), pk2(m[2], m[3]), pk2(m[4], m[5]), pk2(m[6], m[7])};
            }
        }
        {
            const int sr = tid_o >> 2, dp = tid_o & 3;
            float f[32]; float ss = 0.f;
#pragma unroll
            for (int q = 0; q < 4; ++q) { const u32x4 x = vpre[q]; const unsigned ww[4] = {x.x, x.y, x.z, x.w};
#pragma unroll
                for (int j = 0; j < 4; ++j) { f[q * 8 + 2 * j] = bflo(ww[j]); f[q * 8 + 2 * j + 1] = bfhi(ww[j]); } }
#pragma unroll
            for (int j = 0; j < 32; ++j) ss += f[j] * f[j];
            ss += __shfl_xor(ss, 1); ss += __shfl_xor(ss, 2);
            const float rstd = __builtin_amdgcn_rsqf(ss * (1.f / GM_D) + EPS);
            const float* vw = a.gm_vnorm_w + g * GM_D + dp * 32;
#pragma unroll
            for (int j = 0; j < 32; ++j) *(LAS bf16_t*)(L + GM_VT + off256(dp * 32 + j, sr)) = (bf16_t)f2bf(f[j] * rstd * vw[j]);
        }
        {
            const int itn = it + nvb < NB * 64 * GM_G ? it + nvb : it, g2 = itn & 3, n2 = (itn >> 2) & 63, b2 = itn >> 8;
            const u32x4* vp = (const u32x4*)(P + ((size_t)b2 * SEQ + (size_t)n2 * GM_C + (tid_o >> 2)) * PROJ_N + GM_W + g2 * GM_D + (tid_o & 3) * 32);
#pragma unroll
            for (int q = 0; q < 4; ++q) vpre[q] = vp[q];
        }
        u32x2 uu8[8]; float bs8[8];
#pragma unroll
        for (int tt = 0; tt < 8; ++tt) { uu8[tt] = *(const u32x2*)(P + (row0 + fr + 16 * tt) * PROJ_N + g * GM_D + 16 * w + 4 * fq); bs8[tt] = a.gm_b_spatial[g * GM_C + 16 * tt + fr]; }
        __syncthreads();
        bf16x8 va[4];
#pragma unroll
        for (int ks = 0; ks < 4; ++ks) va[ks] = frag256(L + GM_VT, 16 * w, ks, lane);
        unsigned char* op = (unsigned char*)MIX + (row0 + fr) * DM + g * GM_D + 16 * w + 4 * fq;
#pragma unroll
        for (int tt = 0; tt < 8; ++tt) {
            f32x4 acc = {0.f, 0.f, 0.f, 0.f};
#pragma unroll
            for (int ks = 0; ks <= tt / 2; ++ks) acc = MFMA16(va[ks], frag256(L + GM_WS, 16 * tt, ks, lane), acc);
            const float bs = bs8[tt]; const u32x2 uu = uu8[tt];
            { int w8_ = 0; w8_ = __builtin_amdgcn_cvt_pk_fp8_f32(bflo(uu.x) * (acc[0] + bs), bfhi(uu.x) * (acc[1] + bs), w8_, false); w8_ = __builtin_amdgcn_cvt_pk_fp8_f32(bflo(uu.y) * (acc[2] + bs), bfhi(uu.y) * (acc[3] + bs), w8_, true);
              *(unsigned*)(op + (size_t)(16 * tt) * DM) = (unsigned)w8_; }
        }
    }
}


constexpr int SA_KR = 0, SA_QR = 16384, SA_VBT = 32768, SA_KBGT = 49152, SA_KDT = 65536, SA_AM = 81920, SA_TM = 98304, SA_GC = 106496, SA_BETA = 106752, SA_TMT = 107008, SA_XT = 109568, SA_CW = 112128;

__device__ __forceinline__ void stepa_load(u32x4 (&raw)[3][4][2], const bf16_t* P, int ci, int t, int cp) {
    const int n = ci & 127, h = (ci >> 7) & 3, b = ci >> 9; const size_t m0 = (size_t)b * SEQ + (size_t)n * 64;
#pragma unroll
    for (int seg = 0; seg < 3; ++seg)
#pragma unroll
        for (int j = 0; j < CONVK; ++j) {
            const bool ok = n * 64 + t - 3 + j >= 0;
            const u32x4* pp = (const u32x4*)(P + (m0 + (ok ? t - 3 + j : 0)) * PROJ_N + 1024 + seg * 512 + h * 128 + 16 * cp);
            raw[seg][j][0] = pp[0]; raw[seg][j][1] = pp[1];
        }
}
__device__ __forceinline__ void phase_stepa(const Args& a, const Ctx& X) {
    unsigned char* ws = a.ws; const bf16_t* P = (const bf16_t*)(ws + WS_PROJ);
    const float* G = (const float*)(ws + WS_G); const float* BT = (const float*)(ws + WS_BETA);
    bf16_t* WN = (bf16_t*)(ws + WS_WN); bf16_t* QG = (bf16_t*)(ws + WS_QG); bf16_t* KDT = (bf16_t*)(ws + WS_KDT); bf16_t* QK = (bf16_t*)(ws + WS_QK);
    bf16_t* UF = (bf16_t*)(ws + WS_UF); float* EG = (float*)(ws + WS_EG);
    LAS unsigned char* L = X.lds;
    LAS float* GC = (LAS float*)(L + SA_GC); LAS float* BE = (LAS float*)(L + SA_BETA); LAS float* AM = (LAS float*)(L + SA_AM);
    const int w = X.wave;
    __syncthreads();
    for (int i = X.tid; i < CONVK * 1536 / 4; i += 512) ((LAS f32x4*)(L + SA_CW))[i] = ((const f32x4*)a.gdn_conv_w)[i];
    u32x4 raw[3][4][2];
    stepa_load(raw, P, X.bid, X.tid >> 3, X.tid & 7);
    float gnx = 0.f, bnx = 0.f;
    if (w == 0) { const int n0_ = X.bid & 127, h0_ = (X.bid >> 7) & 3, b0_ = X.bid >> 9; const size_t mm = (size_t)b0_ * SEQ + (size_t)n0_ * 64; gnx = G[(mm + X.lane) * 4 + h0_]; bnx = BT[(mm + X.lane) * 4 + h0_]; }
    for (int ci = X.bid; ci < 2048; ci += X.G) {
        int tid_o = X.tid; asm volatile("" : "+v"(tid_o));
        const int t = tid_o >> 3, cp = tid_o & 7, lane = tid_o & 63, fr = lane & 15, fq = lane >> 4;
        const int n = ci & 127, h = (ci >> 7) & 3, b = ci >> 9;
        const size_t m0 = (size_t)b * SEQ + (size_t)n * 64;
        __syncthreads();
        if (w == 0) {
            float gv = gnx; const float bv = bnx;
            { const int cn_ = ci + X.G < 2048 ? ci + X.G : ci, n2 = cn_ & 127, h2 = (cn_ >> 7) & 3, b2 = cn_ >> 9; const size_t m2 = (size_t)b2 * SEQ + (size_t)n2 * 64;
              gnx = G[(m2 + lane) * 4 + h2]; bnx = BT[(m2 + lane) * 4 + h2]; }
#pragma unroll
            for (int o = 1; o < 64; o <<= 1) { const float up = __shfl_up(gv, o); if (lane >= o) gv += up; }
            GC[lane] = gv; BE[lane] = bv;
        }
        float val[3][16];
#pragma unroll
        for (int seg = 0; seg < 3; ++seg) {
            const int ch = seg * 512 + h * 128 + 16 * cp;
#pragma unroll
            for (int c = 0; c < 16; ++c) val[seg][c] = 0.f;
#pragma unroll
            for (int j = 0; j < CONVK; ++j) {
                {
                    const unsigned mk = (n * 64 + t - 3 + j >= 0) ? 0xffffffffu : 0u;
                    const u32x4 x0 = raw[seg][j][0], x1 = raw[seg][j][1]; const unsigned xx[8] = {x0.x & mk, x0.y & mk, x0.z & mk, x0.w & mk, x1.x & mk, x1.y & mk, x1.z & mk, x1.w & mk};
                    const LAS f32x4* cw = (const LAS f32x4*)(L + SA_CW) + (j * 1536 + ch) / 4;
#pragma unroll
                    for (int q4 = 0; q4 < 4; ++q4) { const f32x4 c4 = cw[q4];
                        val[seg][4 * q4] += c4.x * bflo(xx[2 * q4]); val[seg][4 * q4 + 1] += c4.y * bfhi(xx[2 * q4]); val[seg][4 * q4 + 2] += c4.z * bflo(xx[2 * q4 + 1]); val[seg][4 * q4 + 3] += c4.w * bfhi(xx[2 * q4 + 1]); }
                }
            }
            float ss = 0.f;
#pragma unroll
            for (int c = 0; c < 16; ++c) { val[seg][c] = silu_f(val[seg][c]); ss += val[seg][c] * val[seg][c]; }
            if (seg < 2) {
                ss += __shfl_xor(ss, 1); ss += __shfl_xor(ss, 2); ss += __shfl_xor(ss, 4);
                float sc = __builtin_amdgcn_rsqf(ss + EPS); if (seg == 0) sc *= 0.08838834764831845f;
#pragma unroll
                for (int c = 0; c < 16; ++c) val[seg][c] *= sc;
            }
        }
        stepa_load(raw, P, ci + X.G < 2048 ? ci + X.G : ci, t, cp);
        __syncthreads();
        {
            const float gct = GC[t], bt = BE[t], gl = GC[63];
            const float eg = __expf(gct), ekd = __expf(gl - gct);
#pragma unroll
            for (int hf = 0; hf < 2; ++hf) {
                u32x4 kq, qq, qg;
                kq.x = pk2(val[1][8 * hf], val[1][8 * hf + 1]); kq.y = pk2(val[1][8 * hf + 2], val[1][8 * hf + 3]); kq.z = pk2(val[1][8 * hf + 4], val[1][8 * hf + 5]); kq.w = pk2(val[1][8 * hf + 6], val[1][8 * hf + 7]);
                qq.x = pk2(val[0][8 * hf], val[0][8 * hf + 1]); qq.y = pk2(val[0][8 * hf + 2], val[0][8 * hf + 3]); qq.z = pk2(val[0][8 * hf + 4], val[0][8 * hf + 5]); qq.w = pk2(val[0][8 * hf + 6], val[0][8 * hf + 7]);
                qg.x = pk2(val[0][8 * hf] * eg, val[0][8 * hf + 1] * eg); qg.y = pk2(val[0][8 * hf + 2] * eg, val[0][8 * hf + 3] * eg); qg.z = pk2(val[0][8 * hf + 4] * eg, val[0][8 * hf + 5] * eg); qg.w = pk2(val[0][8 * hf + 6] * eg, val[0][8 * hf + 7] * eg);
                *(LAS u32x4*)(L + SA_KR + off256(t, 16 * cp + 8 * hf)) = kq;
                *(LAS u32x4*)(L + SA_QR + off256(t, 16 * cp + 8 * hf)) = qq;
                *(u32x4*)(QG + (size_t)ci * 8192 + t * 128 + 16 * cp + 8 * hf) = qg;
            }
#pragma unroll
            for (int c = 0; c < 16; ++c) {
                *(LAS bf16_t*)(L + SA_VBT + off128(16 * cp + c, t)) = (bf16_t)f2bf(bt * val[2][c]);
                *(LAS bf16_t*)(L + SA_KBGT + off128(16 * cp + c, t)) = (bf16_t)f2bf(bt * eg * val[1][c]);
                *(LAS bf16_t*)(L + SA_KDT + off128(16 * cp + c, t)) = (bf16_t)f2bf(val[1][c] * ekd);
            }
        }
        __syncthreads();
#pragma unroll
        for (int q2 = 0; q2 < 2; ++q2) {
            const int id = 2 * w + q2, it = id >> 2, jt = id & 3;
            if (jt > it) {
                *(u32x2*)(QK + (size_t)ci * 4096 + (16 * it + fr) * 64 + 16 * jt + 4 * fq) = (u32x2){0u, 0u};
            } else {
                f32x4 kk = {0.f, 0.f, 0.f, 0.f}, qk = {0.f, 0.f, 0.f, 0.f};
#pragma unroll
                for (int ks = 0; ks < 4; ++ks) {
                    const bf16x8 ki = frag256(L + SA_KR, 16 * it, ks, lane), kj = frag256(L + SA_KR, 16 * jt, ks, lane), qi = frag256(L + SA_QR, 16 * it, ks, lane);
                    kk = MFMA16(ki, kj, kk);
                    qk = MFMA16(kj, qi, qk);
                }
                {
                    const int j = 16 * jt + fr; const float gj = GC[j];
#pragma unroll
                    for (int r = 0; r < 4; ++r) { const int i = 16 * it + 4 * fq + r; AM[i * 64 + j] = (i > j) ? BE[i] * kk[r] * __expf(GC[i] - gj) : 0.f; }
                }
                {
                    const int i = 16 * it + fr; const float gi = GC[i]; float o[4];
#pragma unroll
                    for (int r = 0; r < 4; ++r) { const int j = 16 * jt + 4 * fq + r; o[r] = (i >= j) ? qk[r] * __expf(gi - GC[j]) : 0.f; }
                    *(u32x2*)(QK + (size_t)ci * 4096 + i * 64 + 16 * jt + 4 * fq) = (u32x2){pk2(o[0], o[1]), pk2(o[2], o[3])};
                }
            }
        }
        __syncthreads();
        if (w == 0) {
            const int hb = 32 * (lane >> 5), c = lane & 31;
            float Tc[32];
            f32x4 An[8];
#pragma unroll
            for (int q = 0; q < 8; ++q) An[q] = (f32x4){0.f, 0.f, 0.f, 0.f};
#pragma unroll
            for (int i = 0; i < 32; ++i) {
                f32x4 Ac[8];
#pragma unroll
                for (int q = 0; q < 8; ++q) Ac[q] = An[q];
                if (i + 1 < 32) {
#pragma unroll
                    for (int q = 0; q < 8; ++q) if (4 * q < i + 1) An[q] = *(const LAS f32x4*)(AM + (hb + i + 1) * 64 + hb + 4 * q);
                }
                float acc0 = (i == c) ? 1.f : 0.f, acc1 = 0.f;
#pragma unroll
                for (int q = 0; q < 8; ++q) {
                    const int j = 4 * q;
                    if (j < i) acc0 -= Ac[q].x * Tc[j];
                    if (j + 1 < i) acc1 -= Ac[q].y * Tc[j + 1];
                    if (j + 2 < i) acc0 -= Ac[q].z * Tc[j + 2];
                    if (j + 3 < i) acc1 -= Ac[q].w * Tc[j + 3];
                }
                Tc[i] = acc0 + acc1;
                asm volatile("" : "+v"(Tc[i]) :: "memory");
            }
#pragma unroll
            for (int i = 0; i < 32; ++i) {
                *(LAS bf16_t*)(L + SA_TM + off128(hb + i, hb + c)) = (bf16_t)f2bf(Tc[i]);
                if (hb) *(LAS bf16_t*)(L + SA_TM + off128(i, 32 + c)) = (bf16_t)0;
            }
            if (!hb) {
#pragma unroll
                for (int q4 = 0; q4 < 4; ++q4)
                    *(LAS u32x4*)(L + SA_TMT + c * 80 + q4 * 16) = (u32x4){pk2(Tc[8 * q4], Tc[8 * q4 + 1]), pk2(Tc[8 * q4 + 2], Tc[8 * q4 + 3]), pk2(Tc[8 * q4 + 4], Tc[8 * q4 + 5]), pk2(Tc[8 * q4 + 6], Tc[8 * q4 + 7])};
            }
        }
        __syncthreads();
        if (w < 4) {
            const int it2 = w >> 1, ct2 = w & 1;
            const LAS float* ar = AM + (32 + 16 * it2 + fr) * 64 + 8 * fq;
            const f32x4 a0 = *(const LAS f32x4*)ar, a1 = *(const LAS f32x4*)(ar + 4);
            const u32x4 ap = {pk2(a0.x, a0.y), pk2(a0.z, a0.w), pk2(a1.x, a1.y), pk2(a1.z, a1.w)};
            const bf16x8 bq = *(const LAS bf16x8*)(L + SA_TMT + (16 * ct2 + fr) * 80 + fq * 16);
            f32x4 xa = {0.f, 0.f, 0.f, 0.f};
            xa = MFMA16(__builtin_bit_cast(bf16x8, ap), bq, xa);
            *(LAS u32x2*)(L + SA_XT + (16 * ct2 + fr) * 80 + (16 * it2 + 4 * fq) * 2) = (u32x2){pk2(xa[0], xa[1]), pk2(xa[2], xa[3])};
        }
        __syncthreads();
        if (w < 4) {
            const int it2 = w >> 1, ct2 = w & 1;
            const bf16x8 ta = *(const LAS bf16x8*)(L + SA_TM + off128(32 + 16 * it2 + fr, 32 + 8 * fq));
            const bf16x8 xb = *(const LAS bf16x8*)(L + SA_XT + (16 * ct2 + fr) * 80 + fq * 16);
            f32x4 ta2 = {0.f, 0.f, 0.f, 0.f};
            ta2 = MFMA16(ta, xb, ta2);
#pragma unroll
            for (int r = 0; r < 4; ++r) *(LAS bf16_t*)(L + SA_TM + off128(32 + 16 * it2 + 4 * fq + r, 16 * ct2 + fr)) = (bf16_t)f2bf(-ta2[r]);
        }
        __syncthreads();
        {
            const int tt = w >> 1, dh = w & 1;
            const bf16x8 t0 = frag128(L + SA_TM, 16 * tt, 0, lane), t1 = frag128(L + SA_TM, 16 * tt, 1, lane);
#pragma unroll
            for (int j = 0; j < 4; ++j) {
                const int ct = 4 * dh + j;
                f32x4 u = {0.f, 0.f, 0.f, 0.f}, wv = {0.f, 0.f, 0.f, 0.f};
                u = MFMA16(t0, frag128(L + SA_VBT, 16 * ct, 0, lane), u); u = MFMA16(t1, frag128(L + SA_VBT, 16 * ct, 1, lane), u);
                wv = MFMA16(frag128(L + SA_KBGT, 16 * ct, 0, lane), t0, wv); wv = MFMA16(frag128(L + SA_KBGT, 16 * ct, 1, lane), t1, wv);
                *(u32x2*)(UF + (((size_t)ci * 32 + tt * 8 + ct) * 64 + lane) * 4) = (u32x2){pk2(u[0], u[1]), pk2(u[2], u[3])};
                *(u32x2*)(WN + (size_t)ci * 8192 + (16 * tt + fr) * 128 + 16 * ct + 4 * fq) = (u32x2){pk2(-wv[0], -wv[1]), pk2(-wv[2], -wv[3])};
            }
            { const int rw = tid_o >> 2, c0 = (tid_o & 3) * 16; u32x4* kd = (u32x4*)(KDT + (size_t)ci * 8192 + rw * 64 + c0);
              kd[0] = *(const LAS u32x4*)(L + SA_KDT + off128(rw, c0)); kd[1] = *(const LAS u32x4*)(L + SA_KDT + off128(rw, c0 + 8)); }
            if (tid_o == 0) EG[ci] = __expf(GC[63]);
        }
    }
}

constexpr int SL_ST = 0, SL_VT = 4096, SL_BUF = 8192, SL_BUFSZ = 34816;
struct ScanPre { u32x4 w[2], k[2], u; float eg; };
__device__ __forceinline__ void scan_fetch(ScanPre& p, const unsigned char* ws, size_t chunk, int sl, int tid) {
    const u32x4* wn = (const u32x4*)(ws + WS_WN + chunk * 16384); const u32x4* kd = (const u32x4*)(ws + WS_KDT + chunk * 16384);
    p.w[0] = wn[tid]; p.w[1] = wn[tid + 512]; p.k[0] = kd[tid]; p.k[1] = kd[tid + 512];
    const int t4 = tid & 127;
    p.u = *(const u32x4*)(ws + WS_UF + chunk * 16384 + (size_t)(((t4 >> 5) * 8 + sl) * 512 + (t4 & 31) * 16));
    p.eg = ((const float*)(ws + WS_EG))[chunk];
}
__device__ __forceinline__ void scan_stage(const ScanPre& p, LAS unsigned char* B, int tid) {
#pragma unroll
    for (int i = 0; i < 2; ++i) { const int c = tid + 512 * i, row = c >> 4, cc = c & 15; *(LAS u32x4*)(B + row * 256 + (((cc ^ row) & 15) << 4)) = p.w[i]; }
#pragma unroll
    for (int i = 0; i < 2; ++i) { const int c = tid + 512 * i, row = c >> 3, cc = c & 7; *(LAS u32x4*)(B + 16384 + row * 128 + (((cc ^ row ^ (row >> 4)) & 7) << 4)) = p.k[i]; }
    if (tid < 128) *(LAS u32x4*)(B + 32768 + tid * 16) = p.u;
}
__device__ __forceinline__ void phase_scan(const Args& a, const Ctx& X, unsigned long long& sub_t) {
#ifndef CV_SPLIT
#define CV_SPLIT 45056
#endif
    if (X.bid >= 128) {
#ifdef SUBPROBE
        const unsigned long long t0_ = __builtin_amdgcn_s_memrealtime();
#endif
        phase_gmlp(a, X, X.bid - 128, X.G - 128); __syncthreads();
#ifdef SUBPROBE
        const unsigned long long t1_ = __builtin_amdgcn_s_memrealtime();
#endif
        convert_experts(a, X, X.bid - 128, X.G - 128, 0, CV_SPLIT);
#ifdef SUBPROBE
        __syncthreads(); const unsigned long long t2_ = __builtin_amdgcn_s_memrealtime(); sub_t += (SUBPROBE == 1) ? (t1_ - t0_) : (t2_ - t1_);
#endif
        return; }
    unsigned char* ws = a.ws;
    LAS unsigned char* L = X.lds;
    const int xl = X.bid & 7, kq = X.bid >> 3, sl = kq & 7, bh = (kq >> 3) * 8 + xl;
    const int w = X.wave, lane = X.lane, fr = lane & 15, fq = lane >> 4, tt = w & 3;
    const size_t c0 = (size_t)bh * 128;
    bf16_t* SGp = (bf16_t*)(ws + WS_SG) + c0 * 16384 + (16 * sl + fr) * 128 + 16 * w + 4 * fq;
    bf16_t* VGp = (bf16_t*)(ws + WS_VG) + c0 * 8192 + (16 * sl + fr) * 64 + 16 * tt + 4 * fq;
    __syncthreads();
    if (X.tid < 256) ((LAS u32x4*)(L + SL_ST))[X.tid] = (u32x4){0u, 0u, 0u, 0u};
    f32x4 Sacc = {0.f, 0.f, 0.f, 0.f};
    *(u32x2*)SGp = (u32x2){0u, 0u};
    ScanPre pre;
    scan_fetch(pre, ws, c0, sl, X.tid);
    scan_stage(pre, L + SL_BUF, X.tid);
    float eg_cur = pre.eg;
    scan_fetch(pre, ws, c0 + 1, sl, X.tid);
    __syncthreads();
    for (int n = 0; n < 128; ++n) {
        LAS unsigned char* Bc = L + SL_BUF + (n & 1) * SL_BUFSZ;
        scan_stage(pre, L + SL_BUF + ((n + 1) & 1) * SL_BUFSZ, X.tid);
        const float eg_next = pre.eg;
        scan_fetch(pre, ws, c0 + (n + 2 < 128 ? n + 2 : 127), sl, X.tid);
        if (w < 4) {
            const u32x2 uu = *(const LAS u32x2*)(Bc + 32768 + tt * 512 + lane * 8);
            f32x4 vacc = {bflo(uu.x), bfhi(uu.x), bflo(uu.y), bfhi(uu.y)};
#pragma unroll
            for (int ks = 0; ks < 4; ++ks) vacc = MFMA16(frag256(Bc, 16 * tt, ks, lane), frag256(L + SL_ST, 0, ks, lane), vacc);
            const u32x2 pv = {pk2(vacc[0], vacc[1]), pk2(vacc[2], vacc[3])};
            *(LAS u32x2*)(L + SL_VT + off128(fr, 16 * tt + 4 * fq)) = pv;
            *(u32x2*)(VGp + (size_t)n * 8192) = pv;
        }
        __syncthreads();
        Sacc = Sacc * eg_cur;
#pragma unroll
        for (int ks = 0; ks < 2; ++ks) Sacc = MFMA16(frag128(Bc + 16384, 16 * w, ks, lane), frag128(L + SL_VT, 0, ks, lane), Sacc);
        {
            const u32x2 ps = {pk2(Sacc[0], Sacc[1]), pk2(Sacc[2], Sacc[3])};
            *(LAS u32x2*)(L + SL_ST + off256(fr, 16 * w + 4 * fq)) = ps;
            if (n + 1 < 128) *(u32x2*)(SGp + (size_t)(n + 1) * 16384) = ps;
        }
        __syncthreads();
        eg_cur = eg_next;
    }
    convert_experts(a, X, X.bid, 128, CV_SPLIT, 49152);
}

constexpr int OP_SG = 0, OP_VG = 32768, OP_QG = 49152, OP_QK = 65536, OP_OSS = 73728;
__device__ __forceinline__ void opass_load(u32x4 (&pre)[9], const unsigned char* ws, int ci, int tid) {
    const u32x4* sg = (const u32x4*)(ws + WS_SG + (size_t)ci * 32768); const u32x4* vg = (const u32x4*)(ws + WS_VG + (size_t)ci * 16384);
    const u32x4* qg = (const u32x4*)(ws + WS_QG + (size_t)ci * 16384); const u32x4* qk = (const u32x4*)(ws + WS_QK + (size_t)ci * 8192);
#pragma unroll
    for (int i = 0; i < 4; ++i) pre[i] = sg[tid + 512 * i];
    pre[4] = vg[tid]; pre[5] = vg[tid + 512]; pre[6] = qg[tid]; pre[7] = qg[tid + 512]; pre[8] = qk[tid];
}
__device__ __forceinline__ void opass_store(const u32x4 (&pre)[9], LAS unsigned char* L, int tid) {
#pragma unroll
    for (int i = 0; i < 4; ++i) { const int c = tid + 512 * i, row = c >> 4, cc = c & 15; *(LAS u32x4*)(L + OP_SG + row * 256 + (((cc ^ row) & 15) << 4)) = pre[i]; }
#pragma unroll
    for (int i = 0; i < 2; ++i) { const int c = tid + 512 * i, row = c >> 3, cc = c & 7; *(LAS u32x4*)(L + OP_VG + row * 128 + (((cc ^ row ^ (row >> 4)) & 7) << 4)) = pre[4 + i]; }
#pragma unroll
    for (int i = 0; i < 2; ++i) { const int c = tid + 512 * i, row = c >> 4, cc = c & 15; *(LAS u32x4*)(L + OP_QG + row * 256 + (((cc ^ row) & 15) << 4)) = pre[6 + i]; }
    { const int c = tid, row = c >> 3, cc = c & 7; *(LAS u32x4*)(L + OP_QK + row * 128 + (((cc ^ row ^ (row >> 4)) & 7) << 4)) = pre[8]; }
}
__device__ __forceinline__ void phase_opass(const Args& a, const Ctx& X) {
    unsigned char* ws = a.ws; bf16_t* MIX = (bf16_t*)(ws + WS_MIXIN); const bf16_t* P = (const bf16_t*)(ws + WS_PROJ);
    LAS unsigned char* L = X.lds; LAS float* OSS = (LAS float*)(L + OP_OSS);
    const int w = X.wave;
    u32x4 pre[9];
    opass_load(pre, ws, X.bid, X.tid);
    for (int ci = X.bid; ci < 2048; ci += X.G) {
        int tid_o = X.tid; asm volatile("" : "+v"(tid_o));
        const int lane = tid_o & 63, fr = lane & 15, fq = lane >> 4, tt = w >> 1, dh = w & 1;
        const int n = ci & 127, bh = ci >> 7, h = bh & 3, b = bh >> 2;
        const size_t m0 = (size_t)b * SEQ + (size_t)n * 64;
        __syncthreads();
        opass_store(pre, L, tid_o);
        __syncthreads();
        opass_load(pre, ws, ci + X.G < 2048 ? ci + X.G : ci, tid_o);
        u32x2 zz[4];
#pragma unroll
        for (int j = 0; j < 4; ++j) zz[j] = *(const u32x2*)(P + (m0 + 16 * tt + fr) * PROJ_N + 2560 + h * 128 + 64 * dh + 16 * j + 4 * fq);
        bf16x8 qg[4], qkf[2];
#pragma unroll
        for (int ks = 0; ks < 4; ++ks) qg[ks] = frag256(L + OP_QG, 16 * tt, ks, lane);
#pragma unroll
        for (int ks = 0; ks < 2; ++ks) qkf[ks] = frag128(L + OP_QK, 16 * tt, ks, lane);
        f32x4 oacc[4];
#pragma unroll
        for (int j = 0; j < 4; ++j) {
            const int dvr = 16 * (4 * dh + j);
            oacc[j] = (f32x4){0.f, 0.f, 0.f, 0.f};
#pragma unroll
            for (int ks = 0; ks < 4; ++ks) oacc[j] = MFMA16(frag256(L + OP_SG, dvr, ks, lane), qg[ks], oacc[j]);
#pragma unroll
            for (int ks = 0; ks < 2; ++ks) oacc[j] = MFMA16(frag128(L + OP_VG, dvr, ks, lane), qkf[ks], oacc[j]);
        }
        float ss = 0.f;
#pragma unroll
        for (int j = 0; j < 4; ++j) ss += (oacc[j][0] * oacc[j][0] + oacc[j][1] * oacc[j][1]) + (oacc[j][2] * oacc[j][2] + oacc[j][3] * oacc[j][3]);
        ss += __shfl_xor(ss, 16); ss += __shfl_xor(ss, 32);
        if (fq == 0) OSS[(16 * tt + fr) * 2 + dh] = ss;
        __syncthreads();
        const float tot = OSS[(16 * tt + fr) * 2] + OSS[(16 * tt + fr) * 2 + 1];
        const float rstd = __builtin_amdgcn_rsqf(tot * (1.f / HD) + EPS);
        unsigned char* op = (unsigned char*)MIX + (m0 + 16 * tt + fr) * DM + 512 + h * 128 + 64 * dh + 4 * fq;
#pragma unroll
        for (int j = 0; j < 4; ++j) {
            const f32x4 onw = *(const f32x4*)(a.gdn_onorm_w + 64 * dh + 16 * j + 4 * fq);
            const float z0 = bflo(zz[j].x), z1 = bfhi(zz[j].x), z2 = bflo(zz[j].y), z3 = bfhi(zz[j].y);
            const float y0 = oacc[j][0] * rstd * onw[0] * silu_f(z0), y1 = oacc[j][1] * rstd * onw[1] * silu_f(z1), y2 = oacc[j][2] * rstd * onw[2] * silu_f(z2), y3 = oacc[j][3] * rstd * onw[3] * silu_f(z3);
            { int w8_ = 0; w8_ = __builtin_amdgcn_cvt_pk_fp8_f32(y0, y1, w8_, false); w8_ = __builtin_amdgcn_cvt_pk_fp8_f32(y2, y3, w8_, true); *(unsigned*)(op + 16 * j) = (unsigned)w8_; }
        }
    }
}

constexpr int R2_WR = 0, R2_HT = 65536, R2_LGW = 131072, R2_TOP = 135168, R2_CNT = 139264;
__device__ __forceinline__ void phase_router2(const Args& a, const Ctx& X) {
    unsigned char* ws = a.ws; const float* mod = (const float*)(ws + WS_MOD); const bf16_t* X1 = (const bf16_t*)(ws + WS_X1); unsigned char* H8 = ws + WS_H8;
    int* cnt = (int*)(ws + WS_CTL + CTL_CNT); int* list = (int*)(ws + WS_LIST); int* route = (int*)(ws + WS_ROUTE);
    LAS unsigned char* L = X.lds; LAS int* lcnt = (LAS int*)(L + R2_CNT); LAS int* gbase = lcnt + 32; float* LG = (float*)(ws + WS_LOGITS);
    const int w = X.wave;
    __syncthreads();
    for (int idx = X.tid; idx < DM * NE; idx += 512) {
        const int k = idx >> 5, e = idx & 31, chunk = k >> 3, phys = (chunk & ~15) | ((chunk ^ e) & 15);
        *(LAS bf16_t*)(L + R2_WR + e * 2048 + phys * 16 + (k & 7) * 2) = (bf16_t)f2bf(a.w_router[idx]);
    }
    for (int blk = X.bid; blk < NTOK / 128; blk += X.G) {
        int tid_o = X.tid; asm volatile("" : "+v"(tid_o));
        const int lane = tid_o & 63, fr = lane & 15, fq = lane >> 4;
        const int b = (blk * 128) / SEQ;
        f32x4 sc[4], sf[4];
#pragma unroll
        for (int j = 0; j < 4; ++j) { const int k0 = 4 * lane + 256 * j; const f32x4 nw = *(const f32x4*)(a.norm2_w + k0), s1 = *(const f32x4*)(mod + (size_t)b * 6144 + 4 * DM + k0);
            sc[j] = nw * (s1 + 1.0f); sf[j] = *(const f32x4*)(mod + (size_t)b * 6144 + 3 * DM + k0); }
        __syncthreads();
        if (tid_o < 32) lcnt[tid_o] = 0;
        LAS unsigned char* HTw = L + R2_HT + w * 8192;
        for (int rg = 0; rg < 4; ++rg) {
            const int mrow = blk * 128 + w * 16 + rg * 4;
            u32x2 xr[4][4];
#pragma unroll
            for (int r = 0; r < 4; ++r)
#pragma unroll
                for (int j = 0; j < 4; ++j) xr[r][j] = ((const u32x2*)(X1 + (size_t)(mrow + r) * DM))[lane + 64 * j];
#pragma unroll
            for (int r = 0; r < 4; ++r) {
                f32x4 v[4]; float ss = 0.f;
#pragma unroll
                for (int j = 0; j < 4; ++j) { v[j] = (f32x4){bflo(xr[r][j].x), bfhi(xr[r][j].x), bflo(xr[r][j].y), bfhi(xr[r][j].y)}; ss += (v[j].x * v[j].x + v[j].y * v[j].y) + (v[j].z * v[j].z + v[j].w * v[j].w); }
                const float rstd = __builtin_amdgcn_rsqf(wave_sum(ss) * (1.f / DM) + EPS);
#pragma unroll
                for (int j = 0; j < 4; ++j) {
                    const f32x4 h = v[j] * rstd * sc[j] + sf[j];
                    int w8_ = 0; w8_ = __builtin_amdgcn_cvt_pk_fp8_f32(h.x, h.y, w8_, false); w8_ = __builtin_amdgcn_cvt_pk_fp8_f32(h.z, h.w, w8_, true);
                    ((unsigned*)(H8 + (size_t)(mrow + r) * DM))[lane + 64 * j] = (unsigned)w8_;
                    const int k0 = 4 * lane + 256 * j, chunk = k0 >> 3;
                    *(LAS u32x2*)(HTw + r * 2048 + ((chunk ^ r) << 4) + (k0 & 7) * 2) = (u32x2){pk2(h.x, h.y), pk2(h.z, h.w)};
                }
            }
            f32x4 acc0 = {0.f, 0.f, 0.f, 0.f}, acc1 = {0.f, 0.f, 0.f, 0.f};
#pragma unroll 4
            for (int ks = 0; ks < 32; ++ks) {
                const int chunk = 4 * ks + fq;
                bf16x8 af = {0, 0, 0, 0, 0, 0, 0, 0};
                if (fr < 4) af = *(const LAS bf16x8*)(HTw + fr * 2048 + ((chunk ^ fr) << 4));
                const bf16x8 b0 = *(const LAS bf16x8*)(L + R2_WR + fr * 2048 + (((chunk & ~15) | ((chunk ^ fr) & 15)) << 4));
                const bf16x8 b1 = *(const LAS bf16x8*)(L + R2_WR + (16 + fr) * 2048 + (((chunk & ~15) | ((chunk ^ (16 + fr)) & 15)) << 4));
                acc0 = MFMA16(af, b0, acc0); acc1 = MFMA16(af, b1, acc1);
            }
            if (fq == 0) {
                const float br0 = a.b_router[fr], br1 = a.b_router[16 + fr];
#pragma unroll
                for (int r = 0; r < 4; ++r) { LG[(size_t)(mrow + r) * NE + fr] = acc0[r] + br0; LG[(size_t)(mrow + r) * NE + 16 + fr] = acc1[r] + br1; }
            }
        }
        asm volatile("s_waitcnt vmcnt(0)" ::: "memory");
        if (lane < 16) {
            const int mr = blk * 128 + w * 16 + lane;
            float v[32];
#pragma unroll
            for (int q = 0; q < 8; ++q) { const f32x4 t = *(const f32x4*)(LG + (size_t)mr * NE + 4 * q); v[4 * q] = t.x; v[4 * q + 1] = t.y; v[4 * q + 2] = t.z; v[4 * q + 3] = t.w; }
            int ei[4]; float ev[4];
#pragma unroll
            for (int k = 0; k < 4; ++k) {
                float best = -INFINITY; int bi = 0;
#pragma unroll
                for (int j = 0; j < 32; ++j) { if (v[j] > best) { best = v[j]; bi = j; } }
                ei[k] = bi; ev[k] = best;
#pragma unroll
                for (int j = 0; j < 32; ++j) if (j == bi) v[j] = -INFINITY;
            }
            float wv[4]; float sum = 0.f;
#pragma unroll
            for (int k = 0; k < 4; ++k) { wv[k] = __expf(ev[k] - ev[0]); sum += wv[k]; }
            const float inv = 1.0f / sum;
            LAS int* tp = (LAS int*)(L + R2_TOP) + (w * 16 + lane) * 8;
#pragma unroll
            for (int k = 0; k < 4; ++k) { tp[k] = ei[k]; ((LAS float*)tp)[4 + k] = wv[k] * inv; }
        }
        __syncthreads();
        {
            const int tok = tid_o >> 2, kk = tid_o & 3, m = blk * 128 + tok;
            const LAS int* tp = (const LAS int*)(L + R2_TOP) + tok * 8;
            const int e = tp[kk]; const float wk = ((const LAS float*)tp)[4 + kk];
            const int lrank = atomicAdd((int*)(lcnt + e), 1);
            __syncthreads();
            if (tid_o < 32) gbase[tid_o] = atomicAdd(cnt + 64 * tid_o, lcnt[tid_o]);
            __syncthreads();
            const int rank = gbase[e] + lrank;
            list[(size_t)e * LIST_CAP + rank] = m;
            route[(size_t)m * 12 + kk] = e; route[(size_t)m * 12 + 4 + kk] = rank; ((float*)route)[(size_t)m * 12 + 8 + kk] = wk;
        }
    }
}

__device__ __forceinline__ int moe_tables(const Args& a, const Ctx& X, pg8::MoeTab& T) {
    LAS int* tp = (LAS int*)(X.lds + LDS_MISC); LAS int* cn = (LAS int*)(X.lds + LDS_MISC + 256);
    const int* cnt = (const int*)(a.ws + WS_CTL + CTL_CNT);
    __syncthreads();
    LAS int* te = (LAS int*)(X.lds + 131072);
    if (X.tid == 0) { int acc = 0; for (int e = 0; e < NE; ++e) { const int c = cnt[64 * e]; cn[e] = c; tp[e] = acc; acc += (c + 255) >> 8; } tp[NE] = acc; }
    __syncthreads();
    for (int pm = X.tid; pm < tp[NE]; pm += 512) { int e = 0; while (e < NE - 1 && tp[e + 1] <= pm) ++e; te[pm] = e; }
    __syncthreads();
    T.tp = tp; T.cnt = cn; T.te = te;
    return tp[NE];
}

__device__ __forceinline__ void phase_combine(const Args& a, const Ctx& X) {
    unsigned char* ws = a.ws; pg8::MoeTab T; (void)moe_tables(a, X, T);
    const bf16_t* X1 = (const bf16_t*)(ws + WS_X1); const unsigned char* Y = ws + WS_Y; const int* route = (const int*)(ws + WS_ROUTE); const float* mod = (const float*)(ws + WS_MOD);
    const int gw = X.bid * 8 + X.wave, NGW = X.G * 8;
    for (int m = gw; m < NTOK; m += NGW) {
        const int b = m / SEQ;
        f32x4 acc[4] = {{0, 0, 0, 0}, {0, 0, 0, 0}, {0, 0, 0, 0}, {0, 0, 0, 0}};
#pragma unroll
        for (int k = 0; k < 4; ++k) {
            const int e = route[(size_t)m * 12 + k], rank = route[(size_t)m * 12 + 4 + k]; const float w = ((const float*)route)[(size_t)m * 12 + 8 + k];
            const size_t slot = (size_t)T.tp[e] * 256 + rank;
            const unsigned* yp = (const unsigned*)(Y + slot * DM) + X.lane;
#pragma unroll
            for (int j = 0; j < 4; ++j) { const int t = (int)yp[64 * j]; const f32x2 lo = __builtin_amdgcn_cvt_pk_f32_fp8(t, false), hi = __builtin_amdgcn_cvt_pk_f32_fp8(t, true);
                acc[j].x += w * lo.x; acc[j].y += w * lo.y; acc[j].z += w * hi.x; acc[j].w += w * hi.y; }
        }
        const u32x2* xr = (const u32x2*)(X1 + (size_t)m * DM) + X.lane;
        const f32x4* g2 = (const f32x4*)(mod + (size_t)b * 6144 + 5 * DM) + X.lane;
        f32x4 v[4]; float ss = 0.f;
#pragma unroll
        for (int j = 0; j < 4; ++j) { const u32x2 t = xr[64 * j]; v[j] = (f32x4){bflo(t.x), bfhi(t.x), bflo(t.y), bfhi(t.y)} + g2[64 * j] * acc[j]; ss += (v[j].x * v[j].x + v[j].y * v[j].y) + (v[j].z * v[j].z + v[j].w * v[j].w); }
        const float rstd = __builtin_amdgcn_rsqf(wave_sum(ss) * (1.f / DM) + EPS);
        f32x4* orow = (f32x4*)(a.out + (size_t)m * DM) + X.lane; const f32x4* nf = (const f32x4*)a.norm_f_w + X.lane;
#pragma unroll
        for (int j = 0; j < 4; ++j) orow[64 * j] = v[j] * rstd * nf[64 * j];
    }
}


#define XB_TMO      128
#define XB_XCNT(j)  (256  + 64 * (j))
#define XB_XSUB(j)  (1280 + 64 * (j))
#define XB_XGEN(j)  (2304 + 64 * (j))
#define XB_TOP      3328
#define XB_TOPGEN   3392
#define XCD_BAR_WORDS 3456
#define XB_SPIN_CAP (1u << 18)
__device__ __forceinline__ unsigned xb_ld(unsigned* p)              { return __hip_atomic_load(p, __ATOMIC_RELAXED, __HIP_MEMORY_SCOPE_AGENT); }
__device__ __forceinline__ unsigned xb_add(unsigned* p, unsigned v) { return __hip_atomic_fetch_add(p, v, __ATOMIC_RELAXED, __HIP_MEMORY_SCOPE_AGENT); }
__device__ __forceinline__ unsigned xb_xcc_id() { return (unsigned)__builtin_amdgcn_s_getreg((3 << 11) | 20) & 0xFu; }
#define XB_SPIN(cond, bar) do { unsigned _sp = 0; while (cond) { __builtin_amdgcn_s_sleep(1); \
    if ((++_sp & 255u) == 0u) { if (xb_ld(&(bar)[XB_TMO])) break; if (_sp > XB_SPIN_CAP) { atomicAdd(&(bar)[XB_TMO], 1u); break; } } } } while (0)
struct XcdBarrier { unsigned* bar; unsigned x; volatile LAS unsigned* st; };
__device__ __forceinline__ XcdBarrier xcd_barrier_post(unsigned* bar, volatile LAS unsigned* st) {
    XcdBarrier b; b.bar = bar; b.x = xb_xcc_id(); b.st = st;
    if (threadIdx.x == 0) (void)xb_add(&bar[XB_XCNT(b.x)], 1u);
    return b;
}
__device__ __forceinline__ void xcd_barrier_complete(unsigned* bar, unsigned x, unsigned& nloc, unsigned& nx) {
    const unsigned G = gridDim.x * gridDim.y * gridDim.z;
    unsigned sum, cnt, mine, sp = 0u;
    for (;;) {
        sum = 0u; cnt = 0u; mine = 0u;
#pragma unroll
        for (unsigned j = 0; j < 16; ++j) { const unsigned c = xb_ld(&bar[XB_XCNT(j)]); sum += c; cnt += (c > 0u) ? 1u : 0u; mine = (j == x) ? c : mine; }
        if (sum == G) break;
        __builtin_amdgcn_s_sleep(1);
        if ((++sp & 255u) == 0u) { if (xb_ld(&bar[XB_TMO])) break; if (sp > XB_SPIN_CAP) { atomicAdd(&bar[XB_TMO], 1u); break; } }
    }
    nloc = mine > 0u ? mine : 1u; nx = cnt > 0u ? cnt : 1u;
}
__device__ __forceinline__ void xcd_barrier(const XcdBarrier& b) {
    asm volatile("s_waitcnt vmcnt(0)" ::: "memory");
    __syncthreads();
    if (threadIdx.x == 0) {
        unsigned* bar = b.bar;
        __builtin_amdgcn_s_waitcnt(0);
        unsigned nloc = b.st[0], nx = b.st[1];
        if (nloc == 0u) { xcd_barrier_complete(bar, b.x, nloc, nx); b.st[0] = nloc; b.st[1] = nx; }
        const unsigned old = xb_add(&bar[XB_XSUB(b.x)], 1u);
        const unsigned gen = old / nloc;
        if (old + 1u == (gen + 1u) * nloc) {
            __builtin_amdgcn_fence(__ATOMIC_RELEASE, "agent");
            asm volatile("s_waitcnt vmcnt(0)" ::: "memory");
            const unsigned og = xb_add(&bar[XB_TOP], 1u);
            const unsigned tg = og / nx;
            if (og + 1u == (tg + 1u) * nx) xb_add(&bar[XB_TOPGEN], 1u);
            else XB_SPIN(xb_ld(&bar[XB_TOPGEN]) == tg, bar);
            __builtin_amdgcn_fence(__ATOMIC_ACQUIRE, "agent");
            xb_add(&bar[XB_XGEN(b.x)], 1u);
            asm volatile("s_waitcnt vmcnt(0)" ::: "memory");
        } else {
            XB_SPIN(xb_ld(&bar[XB_XGEN(b.x)]) == gen, bar);
            __builtin_amdgcn_fence(__ATOMIC_ACQUIRE, "agent");
            asm volatile("s_waitcnt vmcnt(0)" ::: "memory");
        }
    }
    __syncthreads();
}

enum { PH_PREP0 = 0, PH_ROWS1, PH_PROJ, PH_GMLP, PH_CONV, PH_SCAN, PH_OPASS, PH_MIX, PH_ROWS2, PH_ROUTER, PH_ROUTE, PH_MOE1, PH_MOE2, PH_COMBINE, PH_COUNT };

__global__ void __launch_bounds__(512, 2) mega(Args a) {
    extern __shared__ __attribute__((aligned(16))) unsigned char lds_raw[];
    Ctx X; X.lds = (LAS unsigned char*)lds_raw; X.tid = threadIdx.x; X.lane = X.tid & 63; X.wave = __builtin_amdgcn_readfirstlane(X.tid >> 6); X.G = gridDim.x; X.bid = blockIdx.x;
    unsigned char* ws = a.ws;
#if SINGLE_LAUNCH
    if (X.tid < 2) ((volatile LAS unsigned*)(X.lds + LDS_BARST))[X.tid] = 0u;
    __syncthreads();
    const XcdBarrier xbar = xcd_barrier_post((unsigned*)(ws + WS_CTL + CTL_BAR), (volatile LAS unsigned*)(X.lds + LDS_BARST));
#define SEAM(k) do { if (a.ph_lo <= (k) && (k) + 1 < a.ph_hi) { xcd_barrier(xbar); } } while (0)
#else
#define SEAM(k) do { } while (0)
#endif
#ifndef PHMASK
#define PHMASK 0xffffffffu
#endif
#ifndef TIMEPH
#define TIMEPH -1
#endif
#ifdef SUBPROBE
#define SUBADD(v) do { tp_acc += (v); } while (0)
#else
#define SUBADD(v) do { (void)(v); } while (0)
#endif
    unsigned long long tp_acc = 0, tp_t0 = 0;
#define TSTART(k) do { if ((k) == TIMEPH) tp_t0 = __builtin_amdgcn_s_memrealtime(); } while (0)
#ifdef TIMEPRE
#define TSTOP(k) do { } while (0)
#define TSTOP_PRE(k) do { if ((k) == TIMEPH) tp_acc += __builtin_amdgcn_s_memrealtime() - tp_t0; } while (0)
#else
#define TSTOP(k) do { if ((k) == TIMEPH) tp_acc += __builtin_amdgcn_s_memrealtime() - tp_t0; } while (0)
#define TSTOP_PRE(k) do { } while (0)
#endif
#define IN(k) (((PHMASK >> (k)) & 1u) && a.ph_lo <= (k) && (k) < a.ph_hi)
#ifndef REPMASK
#define REPMASK 0u
#endif
#define REP2(k, body) body if (((REPMASK) >> (k)) & 1u) { Ctx X0 = X; asm volatile("" : "+v"(X0.tid), "+v"(X0.lane), "+s"(X0.wave), "+s"(X0.bid)); const Ctx& X = X0; body }
#define BODY_PROJ { __syncthreads(); pg8::DenseSched S; S.init(ws + WS_H, ws + WS_WINT, NTOK, PROJ_N, X.G, X.bid); pg8::EpiProj E{(bf16_t*)(ws + WS_PROJ)}; pg8::gemm_phase(X.lds, S, E); }
#define BODY_MIX { __syncthreads(); pg8::DenseSchedT<1024> S; S.init(ws + WS_MIXIN, ws + WS_WOUTT, NTOK, DM, X.G, X.bid); pg8::EpiMix E{a.x, (const float*)(ws + WS_MOD), (bf16_t*)(ws + WS_X1)}; pg8::gemm_phase<pg8::EpiMix, pg8::DenseSchedT<1024>, true>(X.lds, S, E); }
#define BODY_MOE1 { pg8::MoeTab T; const int nM = moe_tables(a, X, T); pg8::Moe1Sched<1024> S; S.init(ws + WS_H8, ws + WS_WGUT, (const int*)(ws + WS_LIST), T, nM, X.G, X.bid); pg8::EpiAct E{a.b_gu, (unsigned char*)(ws + WS_ACT)}; pg8::gemm_phase<pg8::EpiAct, pg8::Moe1Sched<1024>, true, ALIGN_MOE1>(X.lds, S, E); }
#define BODY_MOE2 { pg8::MoeTab T; const int nM = moe_tables(a, X, T); pg8::Moe2Sched<1024> S; S.init(ws + WS_ACT, ws + WS_WDT, T, nM, X.G, X.bid); pg8::EpiY E{a.b_down, ws + WS_Y}; pg8::gemm_phase<pg8::EpiY, pg8::Moe2Sched<1024>, true, ALIGN_MOE2>(X.lds, S, E); }
    if (IN(PH_PREP0)) { TSTART(PH_PREP0); REP2(PH_PREP0, { __syncthreads(); phase_prep0(a, X); }) TSTOP_PRE(PH_PREP0); SEAM(PH_PREP0); TSTOP(PH_PREP0); }
    if (IN(PH_ROWS1)) { TSTART(PH_ROWS1); REP2(PH_ROWS1, { __syncthreads(); phase_rows1(a, X); }) TSTOP_PRE(PH_ROWS1); SEAM(PH_ROWS1); TSTOP(PH_ROWS1); }
    if (IN(PH_PROJ)) { TSTART(PH_PROJ); REP2(PH_PROJ, BODY_PROJ) TSTOP_PRE(PH_PROJ); SEAM(PH_PROJ); TSTOP(PH_PROJ); }
    if (IN(PH_CONV)) { TSTART(PH_CONV); REP2(PH_CONV, { phase_stepa(a, X); }) TSTOP_PRE(PH_CONV); SEAM(PH_CONV); TSTOP(PH_CONV); }
    if (IN(PH_SCAN)) { TSTART(PH_SCAN); REP2(PH_SCAN, { unsigned long long sub_ = 0; phase_scan(a, X, sub_); SUBADD(sub_); }) TSTOP_PRE(PH_SCAN); SEAM(PH_SCAN); TSTOP(PH_SCAN); }
    if (IN(PH_OPASS)) { TSTART(PH_OPASS); REP2(PH_OPASS, { phase_opass(a, X); }) TSTOP_PRE(PH_OPASS); SEAM(PH_OPASS); TSTOP(PH_OPASS); }
    if (IN(PH_MIX)) { TSTART(PH_MIX); REP2(PH_MIX, BODY_MIX) TSTOP_PRE(PH_MIX); SEAM(PH_MIX); TSTOP(PH_MIX); }
    if (IN(PH_ROWS2)) { TSTART(PH_ROWS2); REP2(PH_ROWS2, { phase_router2(a, X); }) TSTOP_PRE(PH_ROWS2); SEAM(PH_ROWS2); TSTOP(PH_ROWS2); }
    if (IN(PH_MOE1)) { TSTART(PH_MOE1); REP2(PH_MOE1, BODY_MOE1) TSTOP_PRE(PH_MOE1); SEAM(PH_MOE1); TSTOP(PH_MOE1); }
    if (IN(PH_MOE2)) { TSTART(PH_MOE2); REP2(PH_MOE2, BODY_MOE2) TSTOP_PRE(PH_MOE2); SEAM(PH_MOE2); TSTOP(PH_MOE2); }
    if (IN(PH_COMBINE)) { TSTART(PH_COMBINE); REP2(PH_COMBINE, { phase_combine(a, X); }) TSTOP(PH_COMBINE); }
#ifdef ROWS_PROBE
    { xcd_barrier(xbar); tp_t0 = __builtin_amdgcn_s_memrealtime(); __syncthreads(); phase_rows1(a, X); xcd_barrier(xbar); tp_acc += __builtin_amdgcn_s_memrealtime() - tp_t0; }
#endif
#ifdef GEMM_PROBE
    { xcd_barrier(xbar); tp_t0 = __builtin_amdgcn_s_memrealtime();
      pg8::DenseSched S; S.init(ws + WS_H, ws + WS_WINT, NTOK, PROJ_N, X.G, X.bid); S.same_tile = (GEMM_PROBE == 2); pg8::EpiProj E{(bf16_t*)(ws + WS_PROJ)}; pg8::gemm_phase(X.lds, S, E);
      xcd_barrier(xbar); tp_acc += __builtin_amdgcn_s_memrealtime() - tp_t0; }
#endif
#ifndef TIMEBLK
#define TIMEBLK 0
#endif
#if defined(GEMM_PROBE) || defined(ROWS_PROBE) || defined(SUBPROBE)
    if (X.bid == TIMEBLK) {
#else
    if (TIMEPH >= 0 && X.bid == TIMEBLK) {
#endif
        const unsigned long long t1 = __builtin_amdgcn_s_memrealtime(); while (__builtin_amdgcn_s_memrealtime() - t1 < 8ull * tp_acc) __builtin_amdgcn_s_sleep(8); }
#undef IN
#undef SEAM
#undef REP2
}

extern "C" void kernel_launch(void* const* d_in, const int* in_sizes, int n_in, void* d_out, int out_size, void* d_ws, size_t ws_size, hipStream_t stream) {
    static int grid = 0;
    if (grid == 0) {
        if (n_in != 22 || out_size != NTOK * DM || ws_size < WS_END) { fprintf(stderr, "kernel_launch: unexpected shapes (n_in %d out %d ws %zu)\n", n_in, out_size, ws_size); grid = -1; return; }
        int dev = 0, cus = 0, per_cu = 0;
        (void)hipGetDevice(&dev); (void)hipDeviceGetAttribute(&cus, hipDeviceAttributeMultiprocessorCount, dev);
        (void)hipFuncSetAttribute((const void*)mega, hipFuncAttributeMaxDynamicSharedMemorySize, LDS_BYTES);
        (void)hipOccupancyMaxActiveBlocksPerMultiprocessor(&per_cu, (const void*)mega, 512, LDS_BYTES);
        if (per_cu < 1) { fprintf(stderr, "kernel_launch: occupancy query says %d blocks per CU\n", per_cu); }
        (void)hipGetLastError();
        grid = cus > 0 ? cus : 256;
    }
    if (grid < 0) return;
    (void)hipMemsetAsync((char*)d_ws + WS_CTL, 0, CTL_ZERO, stream);
    Args a{};
    const float** p = (const float**)&a;
    for (int i = 0; i < 22; ++i) p[i] = (const float*)d_in[i];
    a.out = (float*)d_out; a.ws = (unsigned char*)d_ws;
#if SINGLE_LAUNCH
    a.ph_lo = 0; a.ph_hi = PH_COUNT;
    void* args[] = {&a};
    hipError_t e = hipLaunchCooperativeKernel((const void*)mega, dim3(grid), dim3(512), args, LDS_BYTES, stream);
    if (e != hipSuccess) fprintf(stderr, "cooperative launch failed: %s (grid %d)\n", hipGetErrorString(e), grid);
#else
    for (int ph = 0; ph < PH_COUNT; ++ph) { a.ph_lo = ph; a.ph_hi = ph + 1; hipLaunchKernelGGL(mega, dim3(grid), dim3(512), LDS_BYTES, stream, a); }
#endif
}
```

```cpp
#include <hip/hip_runtime.h>
#include <cstdio>
#include <cstdint>
#include <type_traits>

#ifndef SINGLE_LAUNCH
#define SINGLE_LAUNCH 1
#endif
#if SINGLE_LAUNCH
#include <hip/hip_cooperative_groups.h>
namespace cg = cooperative_groups;
#endif

#define LAS __attribute__((address_space(3)))
typedef unsigned short bf16_t;
typedef short bf16x8 __attribute__((ext_vector_type(8)));
typedef float f32x4 __attribute__((ext_vector_type(4)));
typedef float f32x2 __attribute__((ext_vector_type(2)));
typedef unsigned u32x4 __attribute__((ext_vector_type(4)));
typedef unsigned u32x2 __attribute__((ext_vector_type(2)));

constexpr int DM = 1024, NB = 4, SEQ = 8192, NTOK = NB * SEQ;
constexpr int GM_G = 4, GM_D = 128, GM_W = 512, GM_C = 128;
constexpr int NH = 4, HD = 128, QKW = 512, VW = 512, CONVK = 4;
constexpr int IN_COLS = 3080, PROJ_N = 3072;
constexpr int NE = 32, TOPK = 4, DFF = 1024;
constexpr float EPS = 1e-6f;
constexpr int LIST_CAP = NTOK;
constexpr int MAX_SLOTS = NTOK * TOPK + NE * 256;

constexpr size_t MiB = 1u << 20;
constexpr size_t WS_CTL = 0;
constexpr size_t WS_MOD = 1 * MiB;
constexpr size_t WS_G = 2 * MiB;
constexpr size_t WS_BETA = 3 * MiB;
constexpr size_t WS_ROUTE = 4 * MiB;
constexpr size_t WS_LIST = 6 * MiB;
constexpr size_t WS_LOGITS = 10 * MiB;
constexpr size_t WS_WOUTT = 16 * MiB;
constexpr size_t WS_WINT = 18 * MiB;
constexpr size_t WS_WGUT = 24 * MiB;
constexpr size_t WS_WDT = 152 * MiB;
constexpr size_t WS_H8 = 184 * MiB;
constexpr size_t WS_X1 = 216 * MiB;
constexpr size_t WS_H = 344 * MiB;
constexpr size_t WS_PROJ = 408 * MiB;
constexpr size_t WS_MIXIN = 600 * MiB;
constexpr size_t WS_WN = 664 * MiB;
constexpr size_t WS_QG = 696 * MiB;
constexpr size_t WS_KDT = 728 * MiB;
constexpr size_t WS_QK = 760 * MiB;
constexpr size_t WS_UF = 776 * MiB;
constexpr size_t WS_EG = 840 * MiB;
constexpr size_t WS_SG = 856 * MiB;
constexpr size_t WS_VG = 920 * MiB;
constexpr size_t WS_ACT = 408 * MiB;
constexpr size_t WS_Y = 680 * MiB;
constexpr size_t WS_END = 952 * MiB;

constexpr int LDS_BYTES = 147456;
constexpr int LDS_MISC = 146432;
constexpr int LDS_BARST = 147200;
constexpr size_t CTL_BAR = 4096;
constexpr size_t CTL_CNT = 20480;
constexpr size_t CTL_CVT = 28672;
constexpr size_t CTL_ZERO = 32768;

typedef __bf16 bf16x2_hw __attribute__((ext_vector_type(2)));
__device__ __forceinline__ unsigned pk2(float lo, float hi) { const f32x2 v = {lo, hi}; return __builtin_bit_cast(unsigned, __builtin_convertvector(v, bf16x2_hw)); }
__device__ __forceinline__ unsigned f2bf(float f) { return pk2(f, 0.f) & 0xffffu; }
__device__ __forceinline__ float bflo(unsigned w) { return __builtin_bit_cast(float, w << 16); }
__device__ __forceinline__ float bfhi(unsigned w) { return __builtin_bit_cast(float, w & 0xffff0000u); }
__device__ __forceinline__ float wave_sum(float v) {
    v += __builtin_bit_cast(float, __builtin_amdgcn_mov_dpp(__builtin_bit_cast(int, v), 0xB1, 0xF, 0xF, true));
    v += __builtin_bit_cast(float, __builtin_amdgcn_mov_dpp(__builtin_bit_cast(int, v), 0x4E, 0xF, 0xF, true));
    v += __builtin_bit_cast(float, __builtin_amdgcn_mov_dpp(__builtin_bit_cast(int, v), 0x124, 0xF, 0xF, true));
    v += __builtin_bit_cast(float, __builtin_amdgcn_mov_dpp(__builtin_bit_cast(int, v), 0x128, 0xF, 0xF, true));
    const int iv = __builtin_bit_cast(int, v);
    const float r0 = __builtin_bit_cast(float, __builtin_amdgcn_readlane(iv, 0)), r1 = __builtin_bit_cast(float, __builtin_amdgcn_readlane(iv, 16));
    const float r2 = __builtin_bit_cast(float, __builtin_amdgcn_readlane(iv, 32)), r3 = __builtin_bit_cast(float, __builtin_amdgcn_readlane(iv, 48));
    return (r0 + r1) + (r2 + r3);
}
__device__ __forceinline__ float silu_f(float x) { return x * __builtin_amdgcn_rcpf(1.f + __expf(-x)); }
__device__ __forceinline__ float sigmoid_f(float x) { return __builtin_amdgcn_rcpf(1.f + __expf(-x)); }

namespace pg8 {
constexpr int BM = 256, BK = 64, HALF = 128, HTB = HALF * BK * 2, STAGE_BYTES = 8 * HTB, NXCD = 8, KD = 1024;
__host__ __device__ __forceinline__ void stage_map(int tid, int i, bool f8, int& R, int& C) {
    const int wid = tid >> 6, l = tid & 63; R = 64 * i + 8 * wid + (l >> 3);
    const int swz = f8 ? (((R >> 1) & 3) << 1) : (R & 7);
    C = ((l & 7) ^ swz) * 8;
}
__host__ __device__ __forceinline__ int perm32(int rho) { const int n = rho >> 4, i = rho & 15; return 8 * (i >> 2) + 4 * n + (i & 3); }
template <int MODE> __host__ __device__ __forceinline__ int perm_rows(int R) {
    if constexpr (MODE == 1) return (R & ~31) + perm32(R & 31);
    else if constexpr (MODE == 2) return 64 * (R >> 5) + 16 * ((R >> 2) & 3) + 4 * ((R >> 4) & 1) + (R & 3);
    else if constexpr (MODE == 3) { const int fq = (R >> 2) & 3; return (R & ~31) + 16 * (fq & 1) + 8 * (fq >> 1) + 4 * ((R >> 4) & 1) + (R & 3); }
    else return R;
}

struct BiasRegs { f32x4 v[2][2]; };
struct Unit { const char* A; const char* B0; const char* B1; unsigned vA0[2], vA1[2]; int pm, pn, e, rot; };

template <int NN = 0>
__device__ __forceinline__ bool tile_order(int i, int G, int c, int nM, int nN_, int& pm, int& pn, int WGM = 8) {
    const int nN = NN > 0 ? NN : nN_;
    const int nwg = nM * nN; const long L = (long)i * G + c; if (L >= nwg) return false;
    int wgid = (int)L; { const int q = nwg / NXCD, r = nwg % NXCD, xcd = wgid % NXCD, off = wgid / NXCD; wgid = (xcd < r ? xcd * (q + 1) : r * (q + 1) + (xcd - r) * q) + off; }
    const int nig = WGM * nN, gid = wgid / nig, fm = gid * WGM, gsz = (nM - fm) < WGM ? (nM - fm) : WGM, idx = wgid - gid * nig;
    if (gsz == 8) { pm = fm + (idx & 7); pn = idx >> 3; } else { pm = fm + (idx % gsz); pn = idx / gsz; }
    return true;
}

__device__ __forceinline__ unsigned cvt_pk_bf16(float lo, float hi) { unsigned r; asm volatile("v_cvt_pk_bf16_f32 %0, %1, %2" : "=v"(r) : "v"(lo), "v"(hi)); return r; }
__device__ __forceinline__ f32x2 gelu_pk(f32x2 v) {
    const f32x2 av = __builtin_elementwise_abs(v), d = av * 0.2316418882f + 1.0f;
    f32x2 t; t.x = __builtin_amdgcn_rcpf(d.x); t.y = __builtin_amdgcn_rcpf(d.y);
    f32x2 q = t * 0.5307027145f + (-0.7265760135f); q = q * t + 0.7107068705f; q = q * t + (-0.142248368f); q = q * t + 0.127414796f; q = q * t;
    const f32x2 s = (v * v) * (-0.72134752044f);
    f32x2 e; e.x = __builtin_amdgcn_exp2f(s.x); e.y = __builtin_amdgcn_exp2f(s.y);
    const f32x2 m = v * (q * e), r = v - m;
    f32x2 o; o.x = v.x < 0.f ? m.x : r.x; o.y = v.y < 0.f ? m.y : r.y; return o;
}

template <class Epi, class Sched, bool F8 = false, bool ALIGN = true>
__device__ __forceinline__ void gemm_phase(LAS unsigned char* lds, Sched& S, const Epi& E) {
    const int tid = threadIdx.x, wid = __builtin_amdgcn_readfirstlane(tid >> 6), lane = tid & 63, wr = wid >> 2, wc = wid & 3, fr = lane & 15, fq = lane >> 4;
    constexpr int PITCH = F8 ? KD : 2 * KD, nt = PITCH / 128;
    unsigned voffB[2];
#pragma unroll
    for (int i = 0; i < 2; ++i) { int R, C; stage_map(tid, i, F8, R, C); const int Rb = perm_rows<Epi::PERM>(R); voffB[i] = (unsigned)(Rb * PITCH + C * 2); }
    const size_t kstep = (size_t)(BK * 2);
    const unsigned ldsw = (unsigned)wid * 1024u;
    const int aoff = (wr * 64 + fr) * 128 + (F8 ? (((fq ^ ((fr >> 1) & 3)) << 5) + ((fq & 1) << 4)) : ((fq ^ (fr & 7)) << 4)), boff = (wc * 32 + fr) * 128 + (F8 ? (((fq ^ ((fr >> 1) & 3)) << 5) + ((fq & 1) << 4)) : ((fq ^ (fr & 7)) << 4));
    const int aoffx = aoff ^ 16, boffx = boff ^ 16;
    const int aoff1 = (wr * 64 + fr) * 128 + (((4 + fq) ^ (fr & 7)) << 4), boff1 = (wc * 32 + fr) * 128 + (((4 + fq) ^ (fr & 7)) << 4);
#define PG8_SA(b, h) (((b) * 2 + (h)) * HTB)
#define PG8_SB(b, h) ((4 + (b) * 2 + (h)) * HTB)
#define PG8_STAGE(bufoff, gbase, voff) do { _Pragma("unroll") for (int _i = 0; _i < 2; ++_i) \
        __builtin_amdgcn_global_load_lds((const unsigned*)((const char*)(gbase) + (voff)[_i]), (LAS unsigned*)(lds + (bufoff) + ldsw + _i * 8192), 16, 0, 0); } while (0)
    typedef int v8i_t __attribute__((ext_vector_type(8)));
    typedef int v4i_t __attribute__((ext_vector_type(4)));
#define PG8_LD32(dst_, off_, offx_) do { const v4i_t lo_ = *(const LAS v4i_t*)(lds + (off_)), hi_ = *(const LAS v4i_t*)(lds + (offx_)); dst_ = __builtin_shufflevector(lo_, hi_, 0, 1, 2, 3, 4, 5, 6, 7); } while (0)
#define PG8_LDA(X_, b, h) do { _Pragma("unroll") for (int m = 0; m < 4; ++m) { if constexpr (F8) PG8_LD32(X_##8[m], PG8_SA(b, h) + aoff + m * 2048, PG8_SA(b, h) + aoffx + m * 2048); \
        else { X_[m][0] = *(const LAS bf16x8*)(lds + PG8_SA(b, h) + aoff + m * 2048); X_[m][1] = *(const LAS bf16x8*)(lds + PG8_SA(b, h) + aoff1 + m * 2048); } } } while (0)
#define PG8_LDB(X_, b, h) do { _Pragma("unroll") for (int n = 0; n < 2; ++n) { if constexpr (F8) PG8_LD32(X_##8[n], PG8_SB(b, h) + boff + n * 2048, PG8_SB(b, h) + boffx + n * 2048); \
        else { X_[n][0] = *(const LAS bf16x8*)(lds + PG8_SB(b, h) + boff + n * 2048); X_[n][1] = *(const LAS bf16x8*)(lds + PG8_SB(b, h) + boff1 + n * 2048); } } } while (0)
#define PG8_MMA(ai, bj, At_, Bt_) do { __builtin_amdgcn_s_setprio(1); _Pragma("unroll") for (int m = 0; m < 4; ++m) _Pragma("unroll") for (int n = 0; n < 2; ++n) { \
        if constexpr (F8) { asm volatile("v_mfma_scale_f32_16x16x128_f8f6f4 %0, %1, %2, %0, %3, %4 op_sel_hi:[0,0,0]" : "+v"(acc[ai][bj][m][n]) : "v"(Bt_##8[n]), "v"(At_##8[m]), "v"(scale_w), "v"(scale_a)); } \
        else { _Pragma("unroll") for (int k = 0; k < 2; ++k) acc[ai][bj][m][n] = __builtin_amdgcn_mfma_f32_16x16x32_bf16(Bt_[n][k], At_[m][k], acc[ai][bj][m][n], 0, 0, 0); } } \
        __builtin_amdgcn_s_setprio(0); } while (0)
#define PG8_WAIT_V(n) asm volatile("s_waitcnt vmcnt(" #n ")" ::: "memory")
#define PG8_WAIT_L(n) asm volatile("s_waitcnt lgkmcnt(" #n ")" ::: "memory")
#define PG8_BAR __builtin_amdgcn_s_barrier()
#define PG8_SCHED __builtin_amdgcn_sched_barrier(0)
    Unit cur, nxt; int ui = 0;
    if (!S.next(0, cur)) return;
    f32x4 acc[2][2][4][2];
    BiasRegs bias;
    if constexpr (Epi::HAS_BIAS) E.load_bias(bias, cur.e, cur.pn, wc, fq);
#pragma unroll
    for (int a = 0; a < 2; ++a)
#pragma unroll
        for (int b = 0; b < 2; ++b)
#pragma unroll
            for (int m = 0; m < 4; ++m)
#pragma unroll
                for (int n = 0; n < 2; ++n) { if constexpr (Epi::HAS_BIAS) acc[a][b][m][n] = bias.v[b][n]; else acc[a][b][m][n] = (f32x4){0.f, 0.f, 0.f, 0.f}; }
    bf16x8 At[4][2], B0[2][2], B1[2][2]; v8i_t At8[4], B08[2], B18[2];
    int scale_w = 0x7a7a7a7a, scale_a = 0x7f7f7f7f; asm volatile("" : "+v"(scale_w), "+v"(scale_a));
#define PG8_KO(u_, j_) ((size_t)(((j_) + (u_).rot) & (nt - 1)) * kstep)
    { const size_t k0 = PG8_KO(cur, 0), k1 = PG8_KO(cur, 1);
    PG8_STAGE(PG8_SB(0, 0), cur.B0 + k0, voffB); PG8_STAGE(PG8_SB(0, 1), cur.B1 + k0, voffB); PG8_STAGE(PG8_SA(0, 0), cur.A + k0, cur.vA0); PG8_STAGE(PG8_SA(0, 1), cur.A + k0, cur.vA1);
    if (wr == 1) PG8_BAR;
    PG8_WAIT_V(2); PG8_BAR;
    PG8_STAGE(PG8_SB(1, 0), cur.B0 + k1, voffB); PG8_STAGE(PG8_SA(1, 0), cur.A + k1, cur.vA0); PG8_STAGE(PG8_SB(1, 1), cur.B1 + k1, voffB);
    PG8_WAIT_V(6); PG8_BAR; }
    for (;;) {
        const bool has_next = S.next(ui + 1, nxt);
#pragma nounroll
        for (int t = 0; t < nt; t += 2) {
            const bool last = (t == nt - 2);
            const bool fromn = last && has_next;
            const int rot2 = fromn ? nxt.rot : cur.rot, j2 = last ? 0 : t + 2;
            const size_t ko2 = (size_t)((j2 + rot2) & (nt - 1)) * kstep, ko3 = (size_t)((j2 + 1 + rot2) & (nt - 1)) * kstep;
            const char* a2 = (fromn ? nxt.A : cur.A); const char* b20 = (fromn ? nxt.B0 : cur.B0); const char* b21 = (fromn ? nxt.B1 : cur.B1);
            unsigned w0[2], w1[2];
#pragma unroll
            for (int i = 0; i < 2; ++i) { w0[i] = fromn ? nxt.vA0[i] : cur.vA0[i]; w1[i] = fromn ? nxt.vA1[i] : cur.vA1[i]; }
            const char* a1 = cur.A + PG8_KO(cur, t + 1);
            PG8_LDB(B0, 0, 0); PG8_LDB(B1, 0, 1); PG8_SCHED; PG8_LDA(At, 0, 0); PG8_STAGE(PG8_SA(1, 1), a1, cur.vA1);
            PG8_WAIT_V(8); PG8_WAIT_L(0); PG8_BAR; PG8_MMA(0, 0, At, B0); PG8_MMA(0, 1, At, B1); PG8_BAR; PG8_SCHED;
            PG8_LDA(At, 0, 1); PG8_STAGE(PG8_SB(0, 0), b20 + ko2, voffB); PG8_STAGE(PG8_SB(0, 1), b21 + ko2, voffB); PG8_STAGE(PG8_SA(0, 0), a2 + ko2, w0);
            PG8_WAIT_V(8); PG8_WAIT_L(0); PG8_BAR; PG8_MMA(1, 0, At, B0); PG8_MMA(1, 1, At, B1); PG8_BAR; PG8_SCHED;
            PG8_LDB(B0, 1, 0); PG8_LDB(B1, 1, 1); PG8_SCHED; PG8_LDA(At, 1, 0); PG8_STAGE(PG8_SA(0, 1), a2 + ko2, w1);
            PG8_WAIT_V(8); PG8_WAIT_L(0); PG8_BAR; PG8_MMA(0, 0, At, B0); PG8_MMA(0, 1, At, B1); PG8_BAR; PG8_SCHED;
            PG8_LDA(At, 1, 1); PG8_STAGE(PG8_SB(1, 0), b20 + ko3, voffB); PG8_STAGE(PG8_SB(1, 1), b21 + ko3, voffB); PG8_STAGE(PG8_SA(1, 0), a2 + ko3, w0);
            PG8_WAIT_V(8); PG8_WAIT_L(0); PG8_BAR; PG8_MMA(1, 0, At, B0); PG8_MMA(1, 1, At, B1); PG8_BAR; PG8_SCHED;
        }
        if constexpr (ALIGN) { if (wr == 0) PG8_BAR; }
        if constexpr (F8) asm volatile("s_nop 15\n\ts_nop 15" ::: "memory");
        if constexpr (Epi::HAS_BIAS) E.load_bias(bias, has_next ? nxt.e : cur.e, has_next ? nxt.pn : cur.pn, wc, fq);
        E(acc, cur, wr, wc, fr, fq);
        if (!has_next) break;
#pragma unroll
        for (int a = 0; a < 2; ++a)
#pragma unroll
            for (int b = 0; b < 2; ++b)
#pragma unroll
                for (int m = 0; m < 4; ++m)
#pragma unroll
                    for (int n = 0; n < 2; ++n) { if constexpr (Epi::HAS_BIAS) acc[a][b][m][n] = bias.v[b][n]; else acc[a][b][m][n] = (f32x4){0.f, 0.f, 0.f, 0.f}; }
        cur = nxt; ++ui;
        if constexpr (ALIGN) { if (wr == 1) PG8_BAR; }
    }
    PG8_WAIT_V(0);
    if constexpr (!ALIGN) { if (wr == 0) PG8_BAR; }
    PG8_BAR;
#undef PG8_SA
#undef PG8_SB
#undef PG8_KO
#undef PG8_STAGE
#undef PG8_LDA
#undef PG8_LD32
#undef PG8_LDB
#undef PG8_MMA
#undef PG8_WAIT_V
#undef PG8_WAIT_L
#undef PG8_BAR
#undef PG8_SCHED
}

#ifndef WGM_DENSE
#define WGM_DENSE 8
#endif
#ifndef WGM_MOE1
#define WGM_MOE1 8
#endif
#ifndef WGM_MOE2
#define WGM_MOE2 8
#endif
#ifndef ROT_DENSE
#define ROT_DENSE 1
#endif
#ifndef ROT_MOE
#define ROT_MOE 1
#endif
#ifndef ALIGN_MOE1
#define ALIGN_MOE1 true
#endif
#ifndef ALIGN_MOE2
#define ALIGN_MOE2 true
#endif
template <int PITCH = 2 * KD> struct DenseSchedT {
    const char* A; const char* Bt; int nM, nN, G, c; int R[2], C[2]; bool same_tile = false;
    __device__ __forceinline__ void init(const void* A_, const void* Bt_, int M, int N, int G_, int c_) {
        A = (const char*)A_; Bt = (const char*)Bt_; nM = M / BM; nN = N / BM; G = G_; c = c_;
#pragma unroll
        for (int i = 0; i < 2; ++i) stage_map((int)threadIdx.x, i, PITCH == KD, R[i], C[i]);
    }
    __device__ __forceinline__ bool next(int i, Unit& u) const {
        int pm, pn; if (!tile_order(i, G, c, nM, nN, pm, pn, WGM_DENSE)) return false;
        if (same_tile) { pm = 0; pn = 0; }
        u.pm = pm; u.pn = pn; u.e = 0; u.rot = ROT_DENSE ? pm + pn : 0; u.A = A; u.B0 = Bt + (size_t)pn * 256 * PITCH; u.B1 = u.B0 + (size_t)128 * PITCH;
#pragma unroll
        for (int i2 = 0; i2 < 2; ++i2) { u.vA0[i2] = (unsigned)((pm * 256 + R[i2]) * PITCH + C[i2] * 2); u.vA1[i2] = u.vA0[i2] + 128u * PITCH; }
        return true;
    }
};
typedef DenseSchedT<2 * KD> DenseSched;
struct MoeTab { const LAS int* tp; const LAS int* cnt; const LAS int* te; };
__device__ __forceinline__ int moe_find(const MoeTab& T, int pm) { return __builtin_amdgcn_readfirstlane(T.te[pm]); }
template <int PITCH> struct Moe1Sched {
    const char* A; const char* Bt; const int* list; MoeTab T; int nM, nN, G, c, imax; int R[2], C[2];
    int ptok[4];
    __device__ __forceinline__ void fetch(int i) {
        int pm, pn; (void)tile_order<8>(i < imax ? i : imax, G, c, nM, nN, pm, pn, WGM_MOE1);
        const int e = moe_find(T, pm), ml = pm - __builtin_amdgcn_readfirstlane(T.tp[e]), ce = __builtin_amdgcn_readfirstlane(T.cnt[e]);
#pragma unroll
        for (int i2 = 0; i2 < 2; ++i2) { const int i0 = ml * 256 + R[i2], i1 = i0 + 128;
            ptok[2 * i2] = list[(size_t)e * LIST_CAP + (i0 < ce ? i0 : ce - 1)]; ptok[2 * i2 + 1] = list[(size_t)e * LIST_CAP + (i1 < ce ? i1 : ce - 1)]; }
    }
    __device__ __forceinline__ void init(const void* A_, const void* Bt_, const int* list_, MoeTab T_, int nM_, int G_, int c_) {
        A = (const char*)A_; Bt = (const char*)Bt_; list = list_; T = T_; nM = nM_; nN = 8; G = G_; c = c_;
        const int nwg = nM * nN; imax = nwg > c ? (nwg - 1 - c) / G : 0;
#pragma unroll
        for (int i = 0; i < 2; ++i) stage_map((int)threadIdx.x, i, true, R[i], C[i]);
        if (nwg > c) fetch(0);
    }
    __device__ __forceinline__ bool next(int i, Unit& u) {
        int pm, pn; if (!tile_order<8>(i, G, c, nM, nN, pm, pn, WGM_MOE1)) return false;
        const int e = moe_find(T, pm);
        u.pm = pm; u.pn = pn; u.e = e; u.rot = ROT_MOE ? pm + pn : 0; u.A = A;
        u.B0 = Bt + ((size_t)e * 2048 + 128 * pn) * PITCH; u.B1 = Bt + ((size_t)e * 2048 + 1024 + 128 * pn) * PITCH;
#pragma unroll
        for (int i2 = 0; i2 < 2; ++i2) { u.vA0[i2] = (unsigned)(ptok[2 * i2] * PITCH + C[i2] * 2); u.vA1[i2] = (unsigned)(ptok[2 * i2 + 1] * PITCH + C[i2] * 2); }
        fetch(i + 1);
        return true;
    }
};
template <int PITCH> struct Moe2Sched {
    const char* A; const char* Bt; MoeTab T; int nM, nN, G, c; int R[2], C[2];
    __device__ __forceinline__ void init(const void* A_, const void* Bt_, MoeTab T_, int nM_, int G_, int c_) {
        A = (const char*)A_; Bt = (const char*)Bt_; T = T_; nM = nM_; nN = 4; G = G_; c = c_;
#pragma unroll
        for (int i = 0; i < 2; ++i) stage_map((int)threadIdx.x, i, true, R[i], C[i]);
    }
    __device__ __forceinline__ bool next(int i, Unit& u) const {
        int pm, pn; if (!tile_order<4>(i, G, c, nM, nN, pm, pn, WGM_MOE2)) return false;
        const int e = moe_find(T, pm);
        u.pm = pm; u.pn = pn; u.e = e; u.rot = ROT_MOE ? pm + pn : 0; u.A = A;
        u.B0 = Bt + ((size_t)e * 1024 + 256 * pn) * PITCH; u.B1 = u.B0 + (size_t)8 * PITCH;
#pragma unroll
        for (int i2 = 0; i2 < 2; ++i2) { u.vA0[i2] = (unsigned)((pm * 256 + R[i2]) * PITCH + C[i2] * 2); u.vA1[i2] = u.vA0[i2] + 128u * PITCH; }
        return true;
    }
};

struct EpiProj {
    static constexpr int PERM = 1; static constexpr bool HAS_BIAS = false;
    bf16_t* O;
    __device__ __forceinline__ void operator()(const f32x4 (&acc)[2][2][4][2], const Unit& u, int wr, int wc, int fr, int fq) const {
        const int row0 = u.pm * BM + wr * 64 + fr, col0 = u.pn * BM + wc * 32 + 8 * fq; const bool act = u.pn < 4;
#pragma unroll
        for (int ai = 0; ai < 2; ++ai)
#pragma unroll
            for (int m = 0; m < 4; ++m) { bf16_t* rowp = O + (size_t)(row0 + ai * HALF + m * 16) * PROJ_N + col0;
#pragma unroll
                for (int bj = 0; bj < 2; ++bj) { f32x4 v0 = acc[ai][bj][m][0], v1 = acc[ai][bj][m][1];
                    if (act) { f32x2 a = gelu_pk((f32x2){v0[0], v0[1]}), b = gelu_pk((f32x2){v0[2], v0[3]}), c = gelu_pk((f32x2){v1[0], v1[1]}), d = gelu_pk((f32x2){v1[2], v1[3]});
                        v0 = (f32x4){a.x, a.y, b.x, b.y}; v1 = (f32x4){c.x, c.y, d.x, d.y}; }
                    u32x4 w; w.x = cvt_pk_bf16(v0[0], v0[1]); w.y = cvt_pk_bf16(v0[2], v0[3]); w.z = cvt_pk_bf16(v1[0], v1[1]); w.w = cvt_pk_bf16(v1[2], v1[3]);
                    *(u32x4*)(rowp + bj * HALF) = w; } }
    }
};
struct EpiMix {
    static constexpr int PERM = 1; static constexpr bool HAS_BIAS = false;
    const float* x; const float* mod; bf16_t* X1;
    __device__ __forceinline__ void operator()(const f32x4 (&acc)[2][2][4][2], const Unit& u, int wr, int wc, int fr, int fq) const {
        const int row0 = u.pm * BM + wr * 64 + fr, col0 = u.pn * BM + wc * 32 + 8 * fq;
        const int b = (u.pm * BM) / SEQ; const float* g1 = mod + (size_t)b * 6 * DM + 2 * DM;
        f32x4 gv[2][2];
#pragma unroll
        for (int bj = 0; bj < 2; ++bj)
#pragma unroll
            for (int n = 0; n < 2; ++n) gv[bj][n] = *(const f32x4*)(g1 + col0 + bj * HALF + 4 * n);
#pragma unroll
        for (int ai = 0; ai < 2; ++ai)
#pragma unroll
            for (int mp = 0; mp < 2; ++mp) {
                f32x4 xv[2][2][2];
#pragma unroll
                for (int h = 0; h < 2; ++h)
#pragma unroll
                    for (int bj = 0; bj < 2; ++bj) { const float* xp = x + (size_t)(row0 + ai * HALF + (2 * mp + h) * 16) * DM + col0 + bj * HALF; xv[h][bj][0] = *(const f32x4*)xp; xv[h][bj][1] = *(const f32x4*)(xp + 4); }
#pragma unroll
                for (int h = 0; h < 2; ++h) { const int m = 2 * mp + h; const size_t off = (size_t)(row0 + ai * HALF + m * 16) * DM + col0;
#pragma unroll
                    for (int bj = 0; bj < 2; ++bj) {
                        const f32x4 v0 = xv[h][bj][0] + gv[bj][0] * acc[ai][bj][m][0], v1 = xv[h][bj][1] + gv[bj][1] * acc[ai][bj][m][1];
                        u32x4 w; w.x = cvt_pk_bf16(v0[0], v0[1]); w.y = cvt_pk_bf16(v0[2], v0[3]); w.z = cvt_pk_bf16(v1[0], v1[1]); w.w = cvt_pk_bf16(v1[2], v1[3]);
                        *(u32x4*)(X1 + off + bj * HALF) = w; } }
                asm volatile("" ::: "memory"); }
    }
};
struct EpiAct {
    static constexpr int PERM = 3; static constexpr bool HAS_BIAS = true;
    const float* bgu; unsigned char* O;
    __device__ __forceinline__ void load_bias(BiasRegs& b, int e, int pn, int wc, int fq) const {
        const float* bg = bgu + (size_t)e * 2048 + pn * 128 + wc * 32 + 16 * (fq & 1) + 8 * (fq >> 1);
        b.v[0][0] = *(const f32x4*)bg; b.v[0][1] = *(const f32x4*)(bg + 4); b.v[1][0] = *(const f32x4*)(bg + 1024); b.v[1][1] = *(const f32x4*)(bg + 1028);
    }
    __device__ __forceinline__ void operator()(const f32x4 (&acc)[2][2][4][2], const Unit& u, int wr, int wc, int fr, int fq) const {
        const int row0 = u.pm * BM + wr * 64 + fr, f0 = u.pn * 128 + wc * 32 + 16 * (fq & 1) + 8 * (fq >> 1);
        (void)f0;
        unsigned char* obase = O + (size_t)(row0 + (fq >> 1) * 16) * DFF + u.pn * 128 + wc * 32 + 16 * (fq & 1);
#pragma unroll
        for (int ai = 0; ai < 2; ++ai)
#pragma unroll
            for (int mp = 0; mp < 2; ++mp) {
                unsigned wv[2][2];
#pragma unroll
                for (int h = 0; h < 2; ++h) { const int m = 2 * mp + h;
                    float r[8];
#pragma unroll
                    for (int n = 0; n < 2; ++n)
#pragma unroll
                        for (int j = 0; j < 4; j += 2) {
                            f32x2 g = {acc[ai][0][m][n][j], acc[ai][0][m][n][j + 1]}, up = {acc[ai][1][m][n][j], acc[ai][1][m][n][j + 1]};
                            g.x = __builtin_amdgcn_fmed3f(g.x, -3.0e38f, 7.0f); g.y = __builtin_amdgcn_fmed3f(g.y, -3.0e38f, 7.0f);
                            up.x = __builtin_amdgcn_fmed3f(up.x, -7.0f, 7.0f); up.y = __builtin_amdgcn_fmed3f(up.y, -7.0f, 7.0f);
                            const f32x2 t = g * (-1.702f * 1.4426950408889634f);
                            f32x2 d; d.x = __builtin_amdgcn_exp2f(t.x); d.y = __builtin_amdgcn_exp2f(t.y);
                            d = d + 1.0f;
                            f32x2 sg; sg.x = __builtin_amdgcn_rcpf(d.x); sg.y = __builtin_amdgcn_rcpf(d.y);
                            const f32x2 res = (g * sg) * (up + 1.0f);
                            r[n * 4 + j] = res.x; r[n * 4 + j + 1] = res.y;
                        }
                    int w0 = 0, w1 = 0;
                    w0 = __builtin_amdgcn_cvt_pk_fp8_f32(r[0], r[1], w0, false); w0 = __builtin_amdgcn_cvt_pk_fp8_f32(r[2], r[3], w0, true);
                    w1 = __builtin_amdgcn_cvt_pk_fp8_f32(r[4], r[5], w1, false); w1 = __builtin_amdgcn_cvt_pk_fp8_f32(r[6], r[7], w1, true);
                    wv[h][0] = (unsigned)w0; wv[h][1] = (unsigned)w1; }
#pragma unroll
                for (int q = 0; q < 2; ++q) { const auto sw = __builtin_amdgcn_permlane32_swap(wv[0][q], wv[1][q], false, false); wv[0][q] = sw[0]; wv[1][q] = sw[1]; }
                *(u32x4*)(obase + (size_t)(ai * HALF + mp * 32) * DFF) = (u32x4){wv[0][0], wv[0][1], wv[1][0], wv[1][1]};
            }
    }
};
struct EpiY {
    static constexpr int PERM = 2; static constexpr bool HAS_BIAS = true;
    const float* bd; unsigned char* O;
    __device__ __forceinline__ void load_bias(BiasRegs& b, int e, int pn, int wc, int fq) const {
        const float* p = bd + (size_t)e * DM + pn * BM + wc * 64 + 16 * fq;
#pragma unroll
        for (int bj = 0; bj < 2; ++bj)
#pragma unroll
            for (int n = 0; n < 2; ++n) b.v[bj][n] = *(const f32x4*)(p + 8 * bj + 4 * n);
    }
    __device__ __forceinline__ void operator()(const f32x4 (&acc)[2][2][4][2], const Unit& u, int wr, int wc, int fr, int fq) const {
        const int row0 = u.pm * BM + wr * 64 + fr, col0 = u.pn * BM + wc * 64 + 16 * fq;
#pragma unroll
        for (int ai = 0; ai < 2; ++ai)
#pragma unroll
            for (int m = 0; m < 4; ++m) { unsigned w[4];
#pragma unroll
                for (int bj = 0; bj < 2; ++bj) { const f32x4 v0 = acc[ai][bj][m][0], v1 = acc[ai][bj][m][1];
                    int w0 = 0, w1 = 0;
                    w0 = __builtin_amdgcn_cvt_pk_fp8_f32(v0[0], v0[1], w0, false); w0 = __builtin_amdgcn_cvt_pk_fp8_f32(v0[2], v0[3], w0, true);
                    w1 = __builtin_amdgcn_cvt_pk_fp8_f32(v1[0], v1[1], w1, false); w1 = __builtin_amdgcn_cvt_pk_fp8_f32(v1[2], v1[3], w1, true);
                    w[2 * bj] = (unsigned)w0; w[2 * bj + 1] = (unsigned)w1; }
                *(u32x4*)(O + (size_t)(row0 + ai * HALF + m * 16) * DM + col0) = (u32x4){w[0], w[1], w[2], w[3]}; }
    }
};
}

struct Args {
    const float *x, *c, *w_ada, *b_ada, *norm1_w, *w_in, *gm_vnorm_w, *gm_w_spatial, *gm_b_spatial, *gdn_conv_w, *gdn_a_log, *gdn_dt_bias, *gdn_onorm_w,
        *w_out, *norm2_w, *w_router, *b_router, *w_gu, *b_gu, *w_down, *b_down, *norm_f_w;
    float* out; unsigned char* ws; int ph_lo, ph_hi;
};

struct Ctx { LAS unsigned char* lds; int tid, lane, wave, G, bid; };

__device__ __forceinline__ void transpose_item(const float* W, int ld, bf16_t* WT, int Kp, int k0, int n0, int row_off, LAS float* scr, int lane) {
#pragma unroll 8
    for (int i = 0; i < 32; ++i) { const int kk = 2 * i + (lane >> 5); scr[kk * 33 + (lane & 31)] = W[(size_t)(k0 + kk) * ld + n0 + (lane & 31)]; }
    asm volatile("s_waitcnt lgkmcnt(0)" ::: "memory");
    const int c = lane & 7;
#pragma unroll
    for (int j = 0; j < 4; ++j) { const int n = (lane >> 3) + 8 * j; const LAS float* s = scr + (8 * c) * 33 + n;
        u32x4 o; o.x = pk2(s[0 * 33], s[1 * 33]); o.y = pk2(s[2 * 33], s[3 * 33]); o.z = pk2(s[4 * 33], s[5 * 33]); o.w = pk2(s[6 * 33], s[7 * 33]);
        *(u32x4*)(WT + (size_t)(row_off + n0 + n) * Kp + k0 + 8 * c) = o; }
    asm volatile("s_waitcnt lgkmcnt(0)" ::: "memory");
}

__device__ __forceinline__ void transpose_item_f8(const float* W, int ld, unsigned char* WT, int Kp, int k0, int n0, LAS float* scr, int lane) {
#pragma unroll 8
    for (int i = 0; i < 32; ++i) { const int kk = 2 * i + (lane >> 5); scr[kk * 33 + (lane & 31)] = W[(size_t)(k0 + kk) * ld + n0 + (lane & 31)]; }
    asm volatile("s_waitcnt lgkmcnt(0)" ::: "memory");
    const int c = lane & 3;
#pragma unroll
    for (int j = 0; j < 2; ++j) { const int n = (lane >> 2) + 16 * j; const LAS float* sp = scr + (16 * c) * 33 + n; int w[4];
#pragma unroll
        for (int q = 0; q < 4; ++q) { int t = 0; t = __builtin_amdgcn_cvt_pk_fp8_f32(sp[(4 * q) * 33] * 32.f, sp[(4 * q + 1) * 33] * 32.f, t, false); t = __builtin_amdgcn_cvt_pk_fp8_f32(sp[(4 * q + 2) * 33] * 32.f, sp[(4 * q + 3) * 33] * 32.f, t, true); w[q] = t; }
        *(u32x4*)(WT + (size_t)(n0 + n) * Kp + k0 + 16 * c) = (u32x4){(unsigned)w[0], (unsigned)w[1], (unsigned)w[2], (unsigned)w[3]}; }
    asm volatile("s_waitcnt lgkmcnt(0)" ::: "memory");
}
__device__ __forceinline__ void phase_prep0(const Args& a, const Ctx& X) {
    unsigned char* ws = a.ws;
    if (X.bid == 0 && X.tid < NE) ((int*)(ws + WS_CTL + CTL_CNT))[64 * X.tid] = 0;
    {
        LAS float* cact = (LAS float*)X.lds;
        LAS f32x4* part = (LAS f32x4*)(X.lds + 16384);
        for (int i = X.tid; i < NB * DM; i += 512) cact[i] = silu_f(a.c[i]);
        __syncthreads();
        float* mod = (float*)(ws + WS_MOD);
        for (int cgp = X.bid; cgp < 256; cgp += X.G) {
            const int j0 = 24 * cgp;
            if (X.tid < 384) {
                const int q = X.tid % 6, kc = X.tid / 6;
                f32x4 s[4] = {{0, 0, 0, 0}, {0, 0, 0, 0}, {0, 0, 0, 0}, {0, 0, 0, 0}};
#pragma unroll 4
                for (int kk = 0; kk < 16; ++kk) { const int k = kc * 16 + kk; const f32x4 w = *(const f32x4*)(a.w_ada + (size_t)k * 6144 + j0 + 4 * q);
#pragma unroll
                    for (int b = 0; b < 4; ++b) s[b] += w * cact[b * DM + k]; }
#pragma unroll
                for (int b = 0; b < 4; ++b) part[(kc * 4 + b) * 6 + q] = s[b];
            }
            __syncthreads();
            if (X.tid < 96) { const int b = X.tid / 24, col = X.tid % 24; float s = 0.f;
                for (int kc = 0; kc < 64; ++kc) s += part[(kc * 4 + b) * 6 + (col >> 2)][col & 3];
                mod[b * 6144 + j0 + col] = s + a.b_ada[j0 + col]; }
            __syncthreads();
        }
    }
    {
        LAS float* scr = (LAS float*)(X.lds + X.wave * 16384);
        const int gw = X.bid * 8 + X.wave, NGW = X.G * 8;
        bf16_t* WinT = (bf16_t*)(ws + WS_WINT); bf16_t* WoutT = (bf16_t*)(ws + WS_WOUTT);
        constexpr int I_IN = 16 * 96, I_OUT = 16 * 32;
        constexpr int NITEMS = I_IN;
        for (int it = gw; it < NITEMS; it += NGW) {
            int r = it;
            if (r < I_IN) { transpose_item_f8(a.w_in, IN_COLS, (unsigned char*)WinT, DM, 64 * (r / 96), 32 * (r % 96), scr, X.lane); continue; } r -= I_IN;
            transpose_item_f8(a.w_out, DM, (unsigned char*)WoutT, DM, 64 * (r / 32), 32 * (r % 32), scr, X.lane);
        }
    }
}

__device__ __forceinline__ void cv_item(const Args& a, unsigned char* ws, int it, const float*& src, int& ld, unsigned char*& dst) {
    constexpr int I_GU = 32 * 16 * 64;
    if (it < I_GU) { const int e = it / 1024, q = it % 1024, k0 = 64 * (q / 64), n0 = 32 * (q % 64); ld = 2048; src = a.w_gu + (size_t)e * DM * 2048 + (size_t)k0 * 2048 + n0; dst = ws + WS_WGUT + ((size_t)e * 2048 + n0) * DM + k0; }
    else if (it < 49152) { const int r = it - I_GU, e = r / 512, q = r % 512, k0 = 64 * (q / 32), n0 = 32 * (q % 32); ld = DM; src = a.w_down + (size_t)e * DFF * DM + (size_t)k0 * DM + n0; dst = ws + WS_WDT + ((size_t)e * DM + n0) * DFF + k0; }
    else { const int q = it - 49152, k0 = 64 * (q / 32), n0 = 32 * (q % 32); ld = DM; src = a.w_out + (size_t)k0 * DM + n0; dst = ws + WS_WOUTT + (size_t)n0 * DM + k0; }
}
__device__ __forceinline__ void cv_load(f32x4 (&r)[8], const float* src, int ld, int lane) {
#pragma unroll
    for (int i = 0; i < 8; ++i) r[i] = *(const f32x4*)(src + (size_t)(8 * i + (lane >> 3)) * ld + 4 * (lane & 7));
}
__device__ __forceinline__ void cv_store(const f32x4 (&r)[8], unsigned char* dst, LAS float* scr, int lane) {
#pragma unroll
    for (int i = 0; i < 8; ++i) { LAS float* p = scr + (8 * i + (lane >> 3)) * 33 + 4 * (lane & 7); p[0] = r[i].x; p[1] = r[i].y; p[2] = r[i].z; p[3] = r[i].w; }
    asm volatile("s_waitcnt lgkmcnt(0)" ::: "memory");
    const int c = lane & 3;
#pragma unroll
    for (int j = 0; j < 2; ++j) { const int n = (lane >> 2) + 16 * j; const LAS float* sp = scr + (16 * c) * 33 + n; int w[4];
#pragma unroll
        for (int q = 0; q < 4; ++q) { int t = 0; t = __builtin_amdgcn_cvt_pk_fp8_f32(sp[(4 * q) * 33] * 32.f, sp[(4 * q + 1) * 33] * 32.f, t, false); t = __builtin_amdgcn_cvt_pk_fp8_f32(sp[(4 * q + 2) * 33] * 32.f, sp[(4 * q + 3) * 33] * 32.f, t, true); w[q] = t; }
        *(u32x4*)(dst + (size_t)n * 1024 + 16 * c) = (u32x4){(unsigned)w[0], (unsigned)w[1], (unsigned)w[2], (unsigned)w[3]}; }
    asm volatile("s_waitcnt lgkmcnt(0)" ::: "memory");
}
__device__ __forceinline__ void convert_experts(const Args& a, const Ctx& X, int vb, int nvb, int it_lo, int it_hi) {
    unsigned char* ws = a.ws;
    LAS float* scr = (LAS float*)(X.lds + X.wave * 16384);
    const int step = nvb * 8; int it = it_lo + vb * 8 + X.wave;
    if (it >= it_hi) return;
    f32x4 b0[8], b1[8], b2[8]; unsigned char *d0, *d1, *d2;
    { const float* s_; int l_; cv_item(a, ws, it, s_, l_, d0); cv_load(b0, s_, l_, X.lane); cv_item(a, ws, it + step < it_hi ? it + step : it, s_, l_, d1); cv_load(b1, s_, l_, X.lane); }
#define CV_STEP(A, dA, C, dC) { const float* s_; int l_; cv_item(a, ws, it + 2 * step < it_hi ? it + 2 * step : it, s_, l_, dC); cv_load(C, s_, l_, X.lane); cv_store(A, dA, scr, X.lane); it += step; if (it >= it_hi) break; }
    for (;;) {
        CV_STEP(b0, d0, b2, d2)
        CV_STEP(b1, d1, b0, d0)
        CV_STEP(b2, d2, b1, d1)
    }
#undef CV_STEP
}

__device__ __forceinline__ void rows1_pre(const Args& a, const Ctx& X, f32x4 (&nx)[4], f32x4 (&nx2)[4]) {
    { const int gw = X.bid * 8 + X.wave, NGW = X.G * 8;
      const f32x4* xr = (const f32x4*)(a.x + (size_t)gw * DM) + X.lane; const f32x4* xr2 = (const f32x4*)(a.x + (size_t)(gw + NGW) * DM) + X.lane;
#pragma unroll
      for (int j = 0; j < 4; ++j) { nx[j] = xr[64 * j]; nx2[j] = xr2[64 * j]; } }
    LAS float* w8 = (LAS float*)X.lds + 8 * DM;
    for (int i = X.tid; i < DM * 8; i += 512) { const int k = i >> 3, c = i & 7, j = k >> 8, l = (k & 255) >> 2, e = k & 3;
        w8[((((c >> 2) * 4 + j) * 4 + e) * 64 + l) * 4 + (c & 3)] = a.w_in[(size_t)k * IN_COLS + PROJ_N + c]; }
}
__device__ __forceinline__ void phase_rows1(const Args& a, const Ctx& X, f32x4 (&nx)[4], f32x4 (&nx2)[4]) {
    unsigned char* ws = a.ws; const float* mod = (const float*)(ws + WS_MOD); const float* src = a.x; unsigned char* dst = ws + WS_H;
    LAS float* scl = (LAS float*)X.lds;
    LAS float* shf = scl + 4 * DM;
    LAS float* w8 = shf + 4 * DM;
    for (int i = X.tid; i < NB * DM; i += 512) { const int b = i >> 10, k = i & 1023; scl[i] = a.norm1_w[k] * (1.f + mod[b * 6144 + 1 * DM + k]); shf[i] = mod[b * 6144 + 0 * DM + k]; }
    __syncthreads();
    float* G = (float*)(ws + WS_G); float* BT = (float*)(ws + WS_BETA);
    const int gw = X.bid * 8 + X.wave, NGW = X.G * 8;
    const float dtb = a.gdn_dt_bias[X.lane & 3], aexp = __expf(a.gdn_a_log[X.lane & 3]);
    f32x4 nx3[4];
    auto row = [&](const f32x4 (&v)[4], f32x4 (&nn)[4], int m) {
        const int b = m / SEQ;
        { const int mp = m + 2 * NGW < NTOK ? m + 2 * NGW : m;
          const f32x4* xr = (const f32x4*)(src + (size_t)mp * DM) + X.lane;
#pragma unroll
            for (int j = 0; j < 4; ++j) nn[j] = xr[64 * j]; }
        float ss = 0.f;
#pragma unroll
        for (int j = 0; j < 4; ++j) ss += (v[j].x * v[j].x + v[j].y * v[j].y) + (v[j].z * v[j].z + v[j].w * v[j].w);
        const float rstd = __builtin_amdgcn_rsqf(wave_sum(ss) * (1.f / DM) + EPS);
        f32x2 ab2[4] = {{0, 0}, {0, 0}, {0, 0}, {0, 0}};
        unsigned* o8 = (unsigned*)(dst + (size_t)m * DM) + X.lane;
#pragma unroll
        for (int j = 0; j < 4; ++j) {
            const int k0 = 4 * X.lane + 256 * j;
            const f32x4 sc = *(const LAS f32x4*)(scl + b * DM + k0), sf = *(const LAS f32x4*)(shf + b * DM + k0);
            const f32x4 h = v[j] * rstd * sc + sf;
            { int w8_ = 0; w8_ = __builtin_amdgcn_cvt_pk_fp8_f32(h.x, h.y, w8_, false); w8_ = __builtin_amdgcn_cvt_pk_fp8_f32(h.z, h.w, w8_, true); o8[64 * j] = (unsigned)w8_; }
#pragma unroll
            for (int e = 0; e < 4; ++e) { const f32x4 wa = *(const LAS f32x4*)(w8 + (((0 * 4 + j) * 4 + e) * 64 + X.lane) * 4), wb = *(const LAS f32x4*)(w8 + (((1 * 4 + j) * 4 + e) * 64 + X.lane) * 4);
                const f32x2 hh = {h[e], h[e]};
                ab2[0] = __builtin_elementwise_fma(hh, (f32x2){wa.x, wa.y}, ab2[0]); ab2[1] = __builtin_elementwise_fma(hh, (f32x2){wa.z, wa.w}, ab2[1]);
                ab2[2] = __builtin_elementwise_fma(hh, (f32x2){wb.x, wb.y}, ab2[2]); ab2[3] = __builtin_elementwise_fma(hh, (f32x2){wb.z, wb.w}, ab2[3]); }
        }
        float ab[8] = {ab2[0].x, ab2[0].y, ab2[1].x, ab2[1].y, ab2[2].x, ab2[2].y, ab2[3].x, ab2[3].y};
#pragma unroll
        for (int e = 0; e < 8; ++e) ab[e] = wave_sum(ab[e]);
        if (X.lane < 4) { const int hh = X.lane; const float av = (hh == 0 ? ab[0] : hh == 1 ? ab[1] : hh == 2 ? ab[2] : ab[3]) + dtb;
            const float sp = av > 20.f ? av : __logf(1.f + __expf(av)); G[(size_t)m * 4 + hh] = -aexp * sp; }
        else if (X.lane < 8) { const int hh = X.lane - 4; const float bv = (hh == 0 ? ab[4] : hh == 1 ? ab[5] : hh == 2 ? ab[6] : ab[7]); BT[(size_t)m * 4 + hh] = sigmoid_f(bv); }
    };
    for (int m = gw; ; ) {
        row(nx, nx3, m); m += NGW; if (m >= NTOK) break;
        row(nx2, nx, m); m += NGW; if (m >= NTOK) break;
        row(nx3, nx2, m); m += NGW; if (m >= NTOK) break;
    }
}

__device__ __forceinline__ int off256(int row, int col) { return row * 256 + ((((col >> 3) ^ row) & 15) << 4) + ((col & 7) << 1); }
__device__ __forceinline__ int off128(int row, int col) { return row * 128 + ((((col >> 3) ^ row ^ (row >> 4)) & 7) << 4) + ((col & 7) << 1); }
__device__ __forceinline__ bf16x8 frag256(const LAS unsigned char* img, int r0, int ks, int lane) { return *(const LAS bf16x8*)(img + off256(r0 + (lane & 15), 32 * ks + 8 * (lane >> 4))); }
__device__ __forceinline__ bf16x8 frag128(const LAS unsigned char* img, int r0, int ks, int lane) { return *(const LAS bf16x8*)(img + off128(r0 + (lane & 15), 32 * ks + 8 * (lane >> 4))); }
#define MFMA16(a, b, c) __builtin_amdgcn_mfma_f32_16x16x32_bf16((a), (b), (c), 0, 0, 0)
constexpr int GM_WS = 0, GM_VT = 32768;
__device__ __forceinline__ void phase_gmlp(const Args& a, const Ctx& X, int vb, int nvb) {
    unsigned char* ws = a.ws; const bf16_t* P = (const bf16_t*)(ws + WS_PROJ); bf16_t* MIX = (bf16_t*)(ws + WS_MIXIN);
    LAS unsigned char* L = X.lds;
    const int w = X.wave;
    int gcur = -1;
    u32x4 vpre[4];
    if (vb < NB * 64 * GM_G) { const int g0 = vb & 3, n0 = (vb >> 2) & 63, b0 = vb >> 8; const u32x4* vp = (const u32x4*)(P + ((size_t)b0 * SEQ + (size_t)n0 * GM_C + (X.tid >> 2)) * PROJ_N + GM_W + g0 * GM_D + (X.tid & 3) * 32);
#pragma unroll
        for (int q = 0; q < 4; ++q) vpre[q] = vp[q]; }
    for (int it = vb; it < NB * 64 * GM_G; it += nvb) {
        int tid_o = X.tid; asm volatile("" : "+v"(tid_o));
        const int lane = tid_o & 63, fr = lane & 15, fq = lane >> 4;
        const int g = it & 3, n = (it >> 2) & 63, b = it >> 8;
        const size_t row0 = (size_t)b * SEQ + (size_t)n * GM_C;
        __syncthreads();
        if (g != gcur) {
            gcur = g;
            const int t = tid_o >> 2, sp = tid_o & 3;
            const float* wr = a.gm_w_spatial + (size_t)g * 16384 + t * 128 + 32 * sp;
#pragma unroll
            for (int q = 0; q < 4; ++q) {
                const f32x4 x0 = *(const f32x4*)(wr + 8 * q), x1 = *(const f32x4*)(wr + 8 * q + 4); const int s0 = 32 * sp + 8 * q;
                const float f[8] = {x0.x, x0.y, x0.z, x0.w, x1.x, x1.y, x1.z, x1.w}; float m[8];
#pragma unroll
                for (int e = 0; e < 8; ++e) m[e] = (s0 + e <= t) ? f[e] : 0.f;
                *(LAS u32x4*)(L + GM_WS + off256(t, s0)) = (u32x4){pk2(m[0], m[1]), pk2(m[2], m[3]), pk2(m[4], m[5]), pk2(m[6], m[7])};
            }
        }
        {
            const int sr = tid_o >> 2, dp = tid_o & 3;
            float f[32]; float ss = 0.f;
#pragma unroll
            for (int q = 0; q < 4; ++q) { const u32x4 x = vpre[q]; const unsigned ww[4] = {x.x, x.y, x.z, x.w};
#pragma unroll
                for (int j = 0; j < 4; ++j) { f[q * 8 + 2 * j] = bflo(ww[j]); f[q * 8 + 2 * j + 1] = bfhi(ww[j]); } }
#pragma unroll
            for (int j = 0; j < 32; ++j) ss += f[j] * f[j];
            ss += __shfl_xor(ss, 1); ss += __shfl_xor(ss, 2);
            const float rstd = __builtin_amdgcn_rsqf(ss * (1.f / GM_D) + EPS);
            const float* vw = a.gm_vnorm_w + g * GM_D + dp * 32;
#pragma unroll
            for (int j = 0; j < 32; ++j) *(LAS bf16_t*)(L + GM_VT + off256(64 * (dp >> 1) + 16 * ((j >> 2) & 3) + 4 * (2 * (dp & 1) + (j >> 4)) + (j & 3), sr)) = (bf16_t)f2bf(f[j] * rstd * vw[j]);
        }
        {
            const int itn = it + nvb < NB * 64 * GM_G ? it + nvb : it, g2 = itn & 3, n2 = (itn >> 2) & 63, b2 = itn >> 8;
            const u32x4* vp = (const u32x4*)(P + ((size_t)b2 * SEQ + (size_t)n2 * GM_C + (tid_o >> 2)) * PROJ_N + GM_W + g2 * GM_D + (tid_o & 3) * 32);
#pragma unroll
            for (int q = 0; q < 4; ++q) vpre[q] = vp[q];
        }
        const int dh = w & 1, tq = w >> 1;
        u32x4 uu[2][2]; float bs2[2];
#pragma unroll
        for (int ti = 0; ti < 2; ++ti) { const int tt = ti ? 7 - tq : tq; const u32x4* up = (const u32x4*)(P + (row0 + fr + 16 * tt) * PROJ_N + g * GM_D + 64 * dh + 16 * fq);
            uu[ti][0] = up[0]; uu[ti][1] = up[1]; bs2[ti] = a.gm_b_spatial[g * GM_C + 16 * tt + fr]; }
        __syncthreads();
        f32x4 acc[2][4];
#pragma unroll
        for (int ti = 0; ti < 2; ++ti)
#pragma unroll
            for (int df = 0; df < 4; ++df) acc[ti][df] = (f32x4){0.f, 0.f, 0.f, 0.f};
#pragma unroll
        for (int ks = 0; ks < 4; ++ks) {
            if (ks <= (7 - tq) / 2) {
                bf16x8 va[4];
#pragma unroll
                for (int df = 0; df < 4; ++df) va[df] = frag256(L + GM_VT, 64 * dh + 16 * df, ks, lane);
                { const bf16x8 wb = frag256(L + GM_WS, 16 * (7 - tq), ks, lane);
#pragma unroll
                  for (int df = 0; df < 4; ++df) acc[1][df] = MFMA16(va[df], wb, acc[1][df]); }
                if (ks <= tq / 2) { const bf16x8 wb = frag256(L + GM_WS, 16 * tq, ks, lane);
#pragma unroll
                  for (int df = 0; df < 4; ++df) acc[0][df] = MFMA16(va[df], wb, acc[0][df]); }
            }
        }
#pragma unroll
        for (int ti = 0; ti < 2; ++ti) { const int tt = ti ? 7 - tq : tq; const float bs = bs2[ti]; unsigned ow[4];
#pragma unroll
            for (int df = 0; df < 4; ++df) { const unsigned ua = (df & 1) ? uu[ti][df >> 1].z : uu[ti][df >> 1].x, ub = (df & 1) ? uu[ti][df >> 1].w : uu[ti][df >> 1].y;
                int w8_ = 0; w8_ = __builtin_amdgcn_cvt_pk_fp8_f32(bflo(ua) * (acc[ti][df][0] + bs), bfhi(ua) * (acc[ti][df][1] + bs), w8_, false); w8_ = __builtin_amdgcn_cvt_pk_fp8_f32(bflo(ub) * (acc[ti][df][2] + bs), bfhi(ub) * (acc[ti][df][3] + bs), w8_, true); ow[df] = (unsigned)w8_; }
            *(u32x4*)((unsigned char*)MIX + (row0 + fr + 16 * tt) * DM + g * GM_D + 64 * dh + 16 * fq) = (u32x4){ow[0], ow[1], ow[2], ow[3]}; }
    }
}


constexpr int SA_KR = 0, SA_QR = 16384, SA_VBT = 32768, SA_KBGT = 49152, SA_KDT = 65536, SA_AM = 81920, SA_TM = 98304, SA_GC = 106496, SA_BETA = 106752, SA_TMT = 107008, SA_XT = 109568, SA_CW = 112128;

__device__ __forceinline__ void stepa_load(u32x4 (&raw)[3][4][2], const bf16_t* P, int ci, int t, int cp) {
    const int n = ci & 127, h = (ci >> 7) & 3, b = ci >> 9; const size_t m0 = (size_t)b * SEQ + (size_t)n * 64;
#pragma unroll
    for (int seg = 0; seg < 3; ++seg)
#pragma unroll
        for (int j = 0; j < CONVK; ++j) {
            const bool ok = n * 64 + t - 3 + j >= 0;
            const u32x4* pp = (const u32x4*)(P + (m0 + (ok ? t - 3 + j : 0)) * PROJ_N + 1024 + seg * 512 + h * 128 + 16 * cp);
            raw[seg][j][0] = pp[0]; raw[seg][j][1] = pp[1];
        }
}
__device__ __forceinline__ void stepa_pre(const Args& a, const Ctx& X) {
    for (int i = X.tid; i < CONVK * 1536 / 4; i += 512) ((LAS f32x4*)(X.lds + SA_CW))[i] = ((const f32x4*)a.gdn_conv_w)[i];
}
__device__ __forceinline__ void phase_stepa(const Args& a, const Ctx& X) {
    unsigned char* ws = a.ws; const bf16_t* P = (const bf16_t*)(ws + WS_PROJ);
    const float* G = (const float*)(ws + WS_G); const float* BT = (const float*)(ws + WS_BETA);
    bf16_t* WN = (bf16_t*)(ws + WS_WN); bf16_t* QG = (bf16_t*)(ws + WS_QG); bf16_t* KDT = (bf16_t*)(ws + WS_KDT); bf16_t* QK = (bf16_t*)(ws + WS_QK);
    bf16_t* UF = (bf16_t*)(ws + WS_UF); float* EG = (float*)(ws + WS_EG);
    LAS unsigned char* L = X.lds;
    LAS float* GC = (LAS float*)(L + SA_GC); LAS float* BE = (LAS float*)(L + SA_BETA); LAS float* AM = (LAS float*)(L + SA_AM);
    const int w = X.wave;
    __syncthreads();
    u32x4 raw[3][4][2];
    stepa_load(raw, P, X.bid, X.tid >> 3, X.tid & 7);
    float gnx = 0.f, bnx = 0.f;
    if (w == 0) { const int n0_ = X.bid & 127, h0_ = (X.bid >> 7) & 3, b0_ = X.bid >> 9; const size_t mm = (size_t)b0_ * SEQ + (size_t)n0_ * 64; gnx = G[(mm + X.lane) * 4 + h0_]; bnx = BT[(mm + X.lane) * 4 + h0_]; }
    for (int ci = X.bid; ci < 2048; ci += X.G) {
        int tid_o = X.tid; asm volatile("" : "+v"(tid_o));
        const int t = tid_o >> 3, cp = tid_o & 7, lane = tid_o & 63, fr = lane & 15, fq = lane >> 4;
        const int n = ci & 127, h = (ci >> 7) & 3, b = ci >> 9;
        const size_t m0 = (size_t)b * SEQ + (size_t)n * 64;
        __syncthreads();
        if (w == 0) {
            float gv = gnx; const float bv = bnx;
            { const int cn_ = ci + X.G < 2048 ? ci + X.G : ci, n2 = cn_ & 127, h2 = (cn_ >> 7) & 3, b2 = cn_ >> 9; const size_t m2 = (size_t)b2 * SEQ + (size_t)n2 * 64;
              gnx = G[(m2 + lane) * 4 + h2]; bnx = BT[(m2 + lane) * 4 + h2]; }
#pragma unroll
            for (int o = 1; o < 64; o <<= 1) { const float up = __shfl_up(gv, o); if (lane >= o) gv += up; }
            GC[lane] = gv; BE[lane] = bv;
        }
        float val[3][16];
#pragma unroll
        for (int seg = 0; seg < 3; ++seg) {
            const int ch = seg * 512 + h * 128 + 16 * cp;
#pragma unroll
            for (int c = 0; c < 16; ++c) val[seg][c] = 0.f;
#pragma unroll
            for (int j = 0; j < CONVK; ++j) {
                {
                    const unsigned mk = (n * 64 + t - 3 + j >= 0) ? 0xffffffffu : 0u;
                    const u32x4 x0 = raw[seg][j][0], x1 = raw[seg][j][1]; const unsigned xx[8] = {x0.x & mk, x0.y & mk, x0.z & mk, x0.w & mk, x1.x & mk, x1.y & mk, x1.z & mk, x1.w & mk};
                    const LAS f32x4* cw = (const LAS f32x4*)(L + SA_CW) + (j * 1536 + ch) / 4;
#pragma unroll
                    for (int q4 = 0; q4 < 4; ++q4) { const f32x4 c4 = cw[q4];
                        val[seg][4 * q4] += c4.x * bflo(xx[2 * q4]); val[seg][4 * q4 + 1] += c4.y * bfhi(xx[2 * q4]); val[seg][4 * q4 + 2] += c4.z * bflo(xx[2 * q4 + 1]); val[seg][4 * q4 + 3] += c4.w * bfhi(xx[2 * q4 + 1]); }
                }
            }
            float ss = 0.f;
#pragma unroll
            for (int c = 0; c < 16; ++c) { val[seg][c] = silu_f(val[seg][c]); ss += val[seg][c] * val[seg][c]; }
            if (seg < 2) {
                ss += __shfl_xor(ss, 1); ss += __shfl_xor(ss, 2); ss += __shfl_xor(ss, 4);
                float sc = __builtin_amdgcn_rsqf(ss + EPS); if (seg == 0) sc *= 0.08838834764831845f;
#pragma unroll
                for (int c = 0; c < 16; ++c) val[seg][c] *= sc;
            }
        }
        stepa_load(raw, P, ci + X.G < 2048 ? ci + X.G : ci, t, cp);
        __syncthreads();
        {
            const float gct = GC[t], bt = BE[t], gl = GC[63];
            const float eg = __expf(gct), ekd = __expf(gl - gct);
#pragma unroll
            for (int hf = 0; hf < 2; ++hf) {
                u32x4 kq, qq, qg;
                kq.x = pk2(val[1][8 * hf], val[1][8 * hf + 1]); kq.y = pk2(val[1][8 * hf + 2], val[1][8 * hf + 3]); kq.z = pk2(val[1][8 * hf + 4], val[1][8 * hf + 5]); kq.w = pk2(val[1][8 * hf + 6], val[1][8 * hf + 7]);
                qq.x = pk2(val[0][8 * hf], val[0][8 * hf + 1]); qq.y = pk2(val[0][8 * hf + 2], val[0][8 * hf + 3]); qq.z = pk2(val[0][8 * hf + 4], val[0][8 * hf + 5]); qq.w = pk2(val[0][8 * hf + 6], val[0][8 * hf + 7]);
                qg.x = pk2(val[0][8 * hf] * eg, val[0][8 * hf + 1] * eg); qg.y = pk2(val[0][8 * hf + 2] * eg, val[0][8 * hf + 3] * eg); qg.z = pk2(val[0][8 * hf + 4] * eg, val[0][8 * hf + 5] * eg); qg.w = pk2(val[0][8 * hf + 6] * eg, val[0][8 * hf + 7] * eg);
                *(LAS u32x4*)(L + SA_KR + off256(t, 16 * cp + 8 * hf)) = kq;
                *(LAS u32x4*)(L + SA_QR + off256(t, 16 * cp + 8 * hf)) = qq;
                *(u32x4*)(QG + (size_t)ci * 8192 + t * 128 + 16 * cp + 8 * hf) = qg;
            }
#pragma unroll
            for (int c = 0; c < 16; ++c) {
                *(LAS bf16_t*)(L + SA_VBT + off128(16 * cp + c, t)) = (bf16_t)f2bf(bt * val[2][c]);
                *(LAS bf16_t*)(L + SA_KBGT + off128(16 * cp + c, t)) = (bf16_t)f2bf(bt * eg * val[1][c]);
                *(LAS bf16_t*)(L + SA_KDT + off128(16 * cp + c, t)) = (bf16_t)f2bf(val[1][c] * ekd);
            }
        }
        __syncthreads();
#pragma unroll
        for (int q2 = 0; q2 < 2; ++q2) {
            const int id = 2 * w + q2, it = id >> 2, jt = id & 3;
            if (jt > it) {
                *(u32x2*)(QK + (size_t)ci * 4096 + (16 * it + fr) * 64 + 16 * jt + 4 * fq) = (u32x2){0u, 0u};
            } else {
                f32x4 kk = {0.f, 0.f, 0.f, 0.f}, qk = {0.f, 0.f, 0.f, 0.f};
#pragma unroll
                for (int ks = 0; ks < 4; ++ks) {
                    const bf16x8 ki = frag256(L + SA_KR, 16 * it, ks, lane), kj = frag256(L + SA_KR, 16 * jt, ks, lane), qi = frag256(L + SA_QR, 16 * it, ks, lane);
                    kk = MFMA16(ki, kj, kk);
                    qk = MFMA16(kj, qi, qk);
                }
                {
                    const int j = 16 * jt + fr; const float gj = GC[j];
#pragma unroll
                    for (int r = 0; r < 4; ++r) { const int i = 16 * it + 4 * fq + r; AM[i * 64 + j] = (i > j) ? BE[i] * kk[r] * __expf(GC[i] - gj) : 0.f; }
                }
                {
                    const int i = 16 * it + fr; const float gi = GC[i]; float o[4];
#pragma unroll
                    for (int r = 0; r < 4; ++r) { const int j = 16 * jt + 4 * fq + r; o[r] = (i >= j) ? qk[r] * __expf(gi - GC[j]) : 0.f; }
                    *(u32x2*)(QK + (size_t)ci * 4096 + i * 64 + 16 * jt + 4 * fq) = (u32x2){pk2(o[0], o[1]), pk2(o[2], o[3])};
                }
            }
        }
        __syncthreads();
        if (w == 0) {
            const int hb = 32 * (lane >> 5), c = lane & 31;
            float Tc[32];
            f32x4 An[8];
#pragma unroll
            for (int q = 0; q < 8; ++q) An[q] = (f32x4){0.f, 0.f, 0.f, 0.f};
#pragma unroll
            for (int i = 0; i < 32; ++i) {
                f32x4 Ac[8];
#pragma unroll
                for (int q = 0; q < 8; ++q) Ac[q] = An[q];
                if (i + 1 < 32) {
#pragma unroll
                    for (int q = 0; q < 8; ++q) if (4 * q < i + 1) An[q] = *(const LAS f32x4*)(AM + (hb + i + 1) * 64 + hb + 4 * q);
                }
                float acc0 = (i == c) ? 1.f : 0.f, acc1 = 0.f;
#pragma unroll
                for (int q = 0; q < 8; ++q) {
                    const int j = 4 * q;
                    if (j < i) acc0 -= Ac[q].x * Tc[j];
                    if (j + 1 < i) acc1 -= Ac[q].y * Tc[j + 1];
                    if (j + 2 < i) acc0 -= Ac[q].z * Tc[j + 2];
                    if (j + 3 < i) acc1 -= Ac[q].w * Tc[j + 3];
                }
                Tc[i] = acc0 + acc1;
                asm volatile("" : "+v"(Tc[i]) :: "memory");
            }
#pragma unroll
            for (int i = 0; i < 32; ++i) {
                *(LAS bf16_t*)(L + SA_TM + off128(hb + i, hb + c)) = (bf16_t)f2bf(Tc[i]);
                if (hb) *(LAS bf16_t*)(L + SA_TM + off128(i, 32 + c)) = (bf16_t)0;
            }
            if (!hb) {
#pragma unroll
                for (int q4 = 0; q4 < 4; ++q4)
                    *(LAS u32x4*)(L + SA_TMT + c * 80 + q4 * 16) = (u32x4){pk2(Tc[8 * q4], Tc[8 * q4 + 1]), pk2(Tc[8 * q4 + 2], Tc[8 * q4 + 3]), pk2(Tc[8 * q4 + 4], Tc[8 * q4 + 5]), pk2(Tc[8 * q4 + 6], Tc[8 * q4 + 7])};
            }
        } else {
            for (int p = tid_o - 64; p < 512; p += 448) { const int rw = p >> 2, c0 = (p & 3) * 16; u32x4* kd = (u32x4*)(KDT + (size_t)ci * 8192 + rw * 64 + c0);
                kd[0] = *(const LAS u32x4*)(L + SA_KDT + off128(rw, c0)); kd[1] = *(const LAS u32x4*)(L + SA_KDT + off128(rw, c0 + 8)); }
            if (tid_o == 64) EG[ci] = __expf(GC[63]);
        }
        __syncthreads();
        if (w < 4) {
            const int it2 = w >> 1, ct2 = w & 1;
            const LAS float* ar = AM + (32 + 16 * it2 + fr) * 64 + 8 * fq;
            const f32x4 a0 = *(const LAS f32x4*)ar, a1 = *(const LAS f32x4*)(ar + 4);
            const u32x4 ap = {pk2(a0.x, a0.y), pk2(a0.z, a0.w), pk2(a1.x, a1.y), pk2(a1.z, a1.w)};
            const bf16x8 bq = *(const LAS bf16x8*)(L + SA_TMT + (16 * ct2 + fr) * 80 + fq * 16);
            f32x4 xa = {0.f, 0.f, 0.f, 0.f};
            xa = MFMA16(__builtin_bit_cast(bf16x8, ap), bq, xa);
            *(LAS u32x2*)(L + SA_XT + (16 * ct2 + fr) * 80 + (16 * it2 + 4 * fq) * 2) = (u32x2){pk2(xa[0], xa[1]), pk2(xa[2], xa[3])};
        }
        __syncthreads();
        if (w < 4) {
            const int it2 = w >> 1, ct2 = w & 1;
            const bf16x8 ta = *(const LAS bf16x8*)(L + SA_TM + off128(32 + 16 * it2 + fr, 32 + 8 * fq));
            const bf16x8 xb = *(const LAS bf16x8*)(L + SA_XT + (16 * ct2 + fr) * 80 + fq * 16);
            f32x4 ta2 = {0.f, 0.f, 0.f, 0.f};
            ta2 = MFMA16(ta, xb, ta2);
#pragma unroll
            for (int r = 0; r < 4; ++r) *(LAS bf16_t*)(L + SA_TM + off128(32 + 16 * it2 + 4 * fq + r, 16 * ct2 + fr)) = (bf16_t)f2bf(-ta2[r]);
        }
        __syncthreads();
        {
            const int tt = w >> 1, dh = w & 1;
            const bf16x8 t0 = frag128(L + SA_TM, 16 * tt, 0, lane), t1 = frag128(L + SA_TM, 16 * tt, 1, lane);
#pragma unroll
            for (int j = 0; j < 4; ++j) {
                const int ct = 4 * dh + j;
                f32x4 u = {0.f, 0.f, 0.f, 0.f}, wv = {0.f, 0.f, 0.f, 0.f};
                u = MFMA16(t0, frag128(L + SA_VBT, 16 * ct, 0, lane), u); u = MFMA16(t1, frag128(L + SA_VBT, 16 * ct, 1, lane), u);
                wv = MFMA16(frag128(L + SA_KBGT, 16 * ct, 0, lane), t0, wv); wv = MFMA16(frag128(L + SA_KBGT, 16 * ct, 1, lane), t1, wv);
                *(u32x2*)(UF + (((size_t)ci * 32 + tt * 8 + ct) * 64 + lane) * 4) = (u32x2){pk2(u[0], u[1]), pk2(u[2], u[3])};
                *(u32x2*)(WN + (size_t)ci * 8192 + (16 * tt + fr) * 128 + 16 * ct + 4 * fq) = (u32x2){pk2(-wv[0], -wv[1]), pk2(-wv[2], -wv[3])};
            }
        }
    }
}

constexpr int SL_ST = 0, SL_VT = 4096, SL_BUF = 8192, SL_BUFSZ = 34816;
struct ScanPre { u32x4 w[2], k[2], u; float eg; };
__device__ __forceinline__ void scan_fetch(ScanPre& p, const unsigned char* ws, size_t chunk, int sl, int tid) {
    const u32x4* wn = (const u32x4*)(ws + WS_WN + chunk * 16384); const u32x4* kd = (const u32x4*)(ws + WS_KDT + chunk * 16384);
    p.w[0] = wn[tid]; p.w[1] = wn[tid + 512]; p.k[0] = kd[tid]; p.k[1] = kd[tid + 512];
    const int t4 = tid & 127;
    p.u = *(const u32x4*)(ws + WS_UF + chunk * 16384 + (size_t)(((t4 >> 5) * 8 + sl) * 512 + (t4 & 31) * 16));
    p.eg = ((const float*)(ws + WS_EG))[chunk];
}
__device__ __forceinline__ void scan_stage(const ScanPre& p, LAS unsigned char* B, int tid) {
#pragma unroll
    for (int i = 0; i < 2; ++i) { const int c = tid + 512 * i, row = c >> 4, cc = c & 15; *(LAS u32x4*)(B + row * 256 + (((cc ^ row) & 15) << 4)) = p.w[i]; }
#pragma unroll
    for (int i = 0; i < 2; ++i) { const int c = tid + 512 * i, row = c >> 3, cc = c & 7; *(LAS u32x4*)(B + 16384 + row * 128 + (((cc ^ row ^ (row >> 4)) & 7) << 4)) = p.k[i]; }
    if (tid < 128) *(LAS u32x4*)(B + 32768 + tid * 16) = p.u;
}
__device__ __forceinline__ void phase_scan(const Args& a, const Ctx& X, unsigned long long& sub_t) {
#ifndef CV_SPLIT
#define CV_SPLIT 49664
#endif
    if (X.bid >= 128) {
#ifdef SUBPROBE
        const unsigned long long t0_ = __builtin_amdgcn_s_memrealtime();
#endif
        phase_gmlp(a, X, X.bid - 128, X.G - 128); __syncthreads();
#ifdef SUBPROBE
        const unsigned long long t1_ = __builtin_amdgcn_s_memrealtime();
#endif
        convert_experts(a, X, X.bid - 128, X.G - 128, 0, CV_SPLIT);
#ifdef SUBPROBE
        __syncthreads(); const unsigned long long t2_ = __builtin_amdgcn_s_memrealtime(); sub_t += (SUBPROBE == 1) ? (t1_ - t0_) : (t2_ - t1_);
#endif
        return; }
    unsigned char* ws = a.ws;
    LAS unsigned char* L = X.lds;
    const int xl = X.bid & 7, kq = X.bid >> 3, sl = kq & 7, bh = (kq >> 3) * 8 + xl;
    const int w = X.wave, lane = X.lane, fr = lane & 15, fq = lane >> 4, tt = w & 3;
    const size_t c0 = (size_t)bh * 128;
    bf16_t* SGp = (bf16_t*)(ws + WS_SG) + c0 * 16384 + (16 * sl + fr) * 128 + 16 * w + 4 * fq;
    bf16_t* VGp = (bf16_t*)(ws + WS_VG) + c0 * 8192 + (16 * sl + fr) * 64 + 16 * tt + 4 * fq;
    __syncthreads();
    if (X.tid < 256) ((LAS u32x4*)(L + SL_ST))[X.tid] = (u32x4){0u, 0u, 0u, 0u};
    f32x4 Sacc = {0.f, 0.f, 0.f, 0.f};
    *(u32x2*)SGp = (u32x2){0u, 0u};
    ScanPre pre;
    scan_fetch(pre, ws, c0, sl, X.tid);
    scan_stage(pre, L + SL_BUF, X.tid);
    float eg_cur = pre.eg;
    scan_fetch(pre, ws, c0 + 1, sl, X.tid);
    __syncthreads();
    for (int n = 0; n < 128; ++n) {
        LAS unsigned char* Bc = L + SL_BUF + (n & 1) * SL_BUFSZ;
        scan_stage(pre, L + SL_BUF + ((n + 1) & 1) * SL_BUFSZ, X.tid);
        const float eg_next = pre.eg;
        scan_fetch(pre, ws, c0 + (n + 2 < 128 ? n + 2 : 127), sl, X.tid);
        if (w < 4) {
            const u32x2 uu = *(const LAS u32x2*)(Bc + 32768 + tt * 512 + lane * 8);
            f32x4 vacc = {bflo(uu.x), bfhi(uu.x), bflo(uu.y), bfhi(uu.y)};
#pragma unroll
            for (int ks = 0; ks < 4; ++ks) vacc = MFMA16(frag256(Bc, 16 * tt, ks, lane), frag256(L + SL_ST, 0, ks, lane), vacc);
            const u32x2 pv = {pk2(vacc[0], vacc[1]), pk2(vacc[2], vacc[3])};
            *(LAS u32x2*)(L + SL_VT + off128(fr, 16 * tt + 4 * fq)) = pv;
            *(u32x2*)(VGp + (size_t)n * 8192) = pv;
        }
        __syncthreads();
        Sacc = Sacc * eg_cur;
#pragma unroll
        for (int ks = 0; ks < 2; ++ks) Sacc = MFMA16(frag128(Bc + 16384, 16 * w, ks, lane), frag128(L + SL_VT, 0, ks, lane), Sacc);
        {
            const u32x2 ps = {pk2(Sacc[0], Sacc[1]), pk2(Sacc[2], Sacc[3])};
            *(LAS u32x2*)(L + SL_ST + off256(fr, 16 * w + 4 * fq)) = ps;
            if (n + 1 < 128) *(u32x2*)(SGp + (size_t)(n + 1) * 16384) = ps;
        }
        __syncthreads();
        eg_cur = eg_next;
    }
    convert_experts(a, X, X.bid, 128, CV_SPLIT, 49664);
}

constexpr int OP_SG = 0, OP_VG = 32768, OP_QG = 49152, OP_QK = 65536, OP_OSS = 73728;
__device__ __forceinline__ void opass_load(u32x4 (&pre)[9], const unsigned char* ws, int ci, int tid) {
    const u32x4* sg = (const u32x4*)(ws + WS_SG + (size_t)ci * 32768); const u32x4* vg = (const u32x4*)(ws + WS_VG + (size_t)ci * 16384);
    const u32x4* qg = (const u32x4*)(ws + WS_QG + (size_t)ci * 16384); const u32x4* qk = (const u32x4*)(ws + WS_QK + (size_t)ci * 8192);
#pragma unroll
    for (int i = 0; i < 4; ++i) pre[i] = sg[tid + 512 * i];
    pre[4] = vg[tid]; pre[5] = vg[tid + 512]; pre[6] = qg[tid]; pre[7] = qg[tid + 512]; pre[8] = qk[tid];
}
__device__ __forceinline__ int op_prow(int dv) { return (dv & 0x43) | ((dv & 0x30) >> 2) | ((dv & 0x0c) << 2); }
__device__ __forceinline__ void opass_store(const u32x4 (&pre)[9], LAS unsigned char* L, int tid) {
#pragma unroll
    for (int i = 0; i < 4; ++i) { const int c = tid + 512 * i, row = op_prow(c >> 4), cc = c & 15; *(LAS u32x4*)(L + OP_SG + row * 256 + (((cc ^ row) & 15) << 4)) = pre[i]; }
#pragma unroll
    for (int i = 0; i < 2; ++i) { const int c = tid + 512 * i, row = op_prow(c >> 3), cc = c & 7; *(LAS u32x4*)(L + OP_VG + row * 128 + (((cc ^ row ^ (row >> 4)) & 7) << 4)) = pre[4 + i]; }
#pragma unroll
    for (int i = 0; i < 2; ++i) { const int c = tid + 512 * i, row = c >> 4, cc = c & 15; *(LAS u32x4*)(L + OP_QG + row * 256 + (((cc ^ row) & 15) << 4)) = pre[6 + i]; }
    { const int c = tid, row = c >> 3, cc = c & 7; *(LAS u32x4*)(L + OP_QK + row * 128 + (((cc ^ row ^ (row >> 4)) & 7) << 4)) = pre[8]; }
}
__device__ __forceinline__ void phase_opass(const Args& a, const Ctx& X) {
    unsigned char* ws = a.ws; bf16_t* MIX = (bf16_t*)(ws + WS_MIXIN); const bf16_t* P = (const bf16_t*)(ws + WS_PROJ);
    LAS unsigned char* L = X.lds; LAS float* OSS = (LAS float*)(L + OP_OSS);
    const int w = X.wave;
    f32x4 onwv[4];
#pragma unroll
    for (int j = 0; j < 4; ++j) onwv[j] = *(const f32x4*)(a.gdn_onorm_w + 64 * (w & 1) + 16 * ((X.tid & 63) >> 4) + 4 * j);
    u32x4 pre[9];
    opass_load(pre, ws, X.bid, X.tid);
    for (int ci = X.bid; ci < 2048; ci += X.G) {
        int tid_o = X.tid; asm volatile("" : "+v"(tid_o));
        const int lane = tid_o & 63, fr = lane & 15, fq = lane >> 4, tt = w >> 1, dh = w & 1;
        const int n = ci & 127, bh = ci >> 7, h = bh & 3, b = bh >> 2;
        const size_t m0 = (size_t)b * SEQ + (size_t)n * 64;
        __syncthreads();
        opass_store(pre, L, tid_o);
        __syncthreads();
        opass_load(pre, ws, ci + X.G < 2048 ? ci + X.G : ci, tid_o);
        u32x4 zz[2];
#pragma unroll
        for (int j = 0; j < 2; ++j) zz[j] = *(const u32x4*)(P + (m0 + 16 * tt + fr) * PROJ_N + 2560 + h * 128 + 64 * dh + 16 * fq + 8 * j);
        bf16x8 qg[4], qkf[2];
#pragma unroll
        for (int ks = 0; ks < 4; ++ks) qg[ks] = frag256(L + OP_QG, 16 * tt, ks, lane);
#pragma unroll
        for (int ks = 0; ks < 2; ++ks) qkf[ks] = frag128(L + OP_QK, 16 * tt, ks, lane);
        f32x4 oacc[4];
#pragma unroll
        for (int j = 0; j < 4; ++j) {
            const int dvr = 16 * (4 * dh + j);
            oacc[j] = (f32x4){0.f, 0.f, 0.f, 0.f};
#pragma unroll
            for (int ks = 0; ks < 4; ++ks) oacc[j] = MFMA16(frag256(L + OP_SG, dvr, ks, lane), qg[ks], oacc[j]);
#pragma unroll
            for (int ks = 0; ks < 2; ++ks) oacc[j] = MFMA16(frag128(L + OP_VG, dvr, ks, lane), qkf[ks], oacc[j]);
        }
        float ss = 0.f;
#pragma unroll
        for (int j = 0; j < 4; ++j) ss += (oacc[j][0] * oacc[j][0] + oacc[j][1] * oacc[j][1]) + (oacc[j][2] * oacc[j][2] + oacc[j][3] * oacc[j][3]);
        ss += __shfl_xor(ss, 16); ss += __shfl_xor(ss, 32);
        if (fq == 0) OSS[(16 * tt + fr) * 2 + dh] = ss;
        __syncthreads();
        const float tot = OSS[(16 * tt + fr) * 2] + OSS[(16 * tt + fr) * 2 + 1];
        const float rstd = __builtin_amdgcn_rsqf(tot * (1.f / HD) + EPS);
        unsigned char* op = (unsigned char*)MIX + (m0 + 16 * tt + fr) * DM + 512 + h * 128 + 64 * dh + 16 * fq;
        unsigned ow[4];
#pragma unroll
        for (int j = 0; j < 4; ++j) {
            const f32x4 onw = onwv[j];
            const unsigned za = (j & 1) ? zz[j >> 1].z : zz[j >> 1].x, zb = (j & 1) ? zz[j >> 1].w : zz[j >> 1].y;
            const float z0 = bflo(za), z1 = bfhi(za), z2 = bflo(zb), z3 = bfhi(zb);
            const float y0 = oacc[j][0] * rstd * onw[0] * silu_f(z0), y1 = oacc[j][1] * rstd * onw[1] * silu_f(z1), y2 = oacc[j][2] * rstd * onw[2] * silu_f(z2), y3 = oacc[j][3] * rstd * onw[3] * silu_f(z3);
            int w8_ = 0; w8_ = __builtin_amdgcn_cvt_pk_fp8_f32(y0, y1, w8_, false); w8_ = __builtin_amdgcn_cvt_pk_fp8_f32(y2, y3, w8_, true); ow[j] = (unsigned)w8_;
        }
        *(u32x4*)op = (u32x4){ow[0], ow[1], ow[2], ow[3]};
    }
}

constexpr int R2_WR = 0, R2_HT = 65536, R2_LGW = 131072, R2_TOP = 135168, R2_CNT = 139264;
__device__ __forceinline__ void router2_pre(const Args& a, const Ctx& X) {
    for (int idx = X.tid; idx < DM * NE; idx += 512) {
        const int k = idx >> 5, e = idx & 31, chunk = k >> 3, phys = (chunk & ~15) | ((chunk ^ e) & 15);
        *(LAS bf16_t*)(X.lds + R2_WR + e * 2048 + phys * 16 + (k & 7) * 2) = (bf16_t)f2bf(a.w_router[idx]);
    }
}
__device__ __forceinline__ void phase_router2(const Args& a, const Ctx& X) {
    unsigned char* ws = a.ws; const float* mod = (const float*)(ws + WS_MOD); const bf16_t* X1 = (const bf16_t*)(ws + WS_X1); unsigned char* H8 = ws + WS_H8;
    int* cnt = (int*)(ws + WS_CTL + CTL_CNT); int* list = (int*)(ws + WS_LIST); int* route = (int*)(ws + WS_ROUTE);
    LAS unsigned char* L = X.lds; LAS int* lcnt = (LAS int*)(L + R2_CNT); LAS int* gbase = lcnt + 32; float* LG = (float*)(ws + WS_LOGITS);
    const int w = X.wave;
    __syncthreads();
    for (int blk = X.bid; blk < NTOK / 128; blk += X.G) {
        int tid_o = X.tid; asm volatile("" : "+v"(tid_o));
        const int lane = tid_o & 63, fr = lane & 15, fq = lane >> 4;
        const int b = (blk * 128) / SEQ;
        f32x4 sc[4], sf[4];
#pragma unroll
        for (int j = 0; j < 4; ++j) { const int k0 = 8 * lane + 512 * (j >> 1) + 4 * (j & 1); const f32x4 nw = *(const f32x4*)(a.norm2_w + k0), s1 = *(const f32x4*)(mod + (size_t)b * 6144 + 4 * DM + k0);
            sc[j] = nw * (s1 + 1.0f); sf[j] = *(const f32x4*)(mod + (size_t)b * 6144 + 3 * DM + k0); }
        __syncthreads();
        if (tid_o < 32) lcnt[tid_o] = 0;
        LAS unsigned char* HTw = L + R2_HT + w * 8192;
        for (int rg = 0; rg < 4; ++rg) {
            const int mrow = blk * 128 + w * 16 + rg * 4;
            u32x4 xr[4][2];
#pragma unroll
            for (int r = 0; r < 4; ++r)
#pragma unroll
                for (int j = 0; j < 2; ++j) xr[r][j] = ((const u32x4*)(X1 + (size_t)(mrow + r) * DM))[lane + 64 * j];
#pragma unroll
            for (int r = 0; r < 4; ++r) {
                f32x4 v[4]; float ss = 0.f;
#pragma unroll
                for (int j = 0; j < 2; ++j) { const u32x4 t = xr[r][j]; v[2 * j] = (f32x4){bflo(t.x), bfhi(t.x), bflo(t.y), bfhi(t.y)}; v[2 * j + 1] = (f32x4){bflo(t.z), bfhi(t.z), bflo(t.w), bfhi(t.w)}; }
#pragma unroll
                for (int j = 0; j < 4; ++j) ss += (v[j].x * v[j].x + v[j].y * v[j].y) + (v[j].z * v[j].z + v[j].w * v[j].w);
                const float rstd = __builtin_amdgcn_rsqf(wave_sum(ss) * (1.f / DM) + EPS);
#pragma unroll
                for (int j = 0; j < 2; ++j) {
                    const f32x4 h0 = v[2 * j] * rstd * sc[2 * j] + sf[2 * j], h1 = v[2 * j + 1] * rstd * sc[2 * j + 1] + sf[2 * j + 1];
                    int w0 = 0, w1 = 0;
                    w0 = __builtin_amdgcn_cvt_pk_fp8_f32(h0.x, h0.y, w0, false); w0 = __builtin_amdgcn_cvt_pk_fp8_f32(h0.z, h0.w, w0, true);
                    w1 = __builtin_amdgcn_cvt_pk_fp8_f32(h1.x, h1.y, w1, false); w1 = __builtin_amdgcn_cvt_pk_fp8_f32(h1.z, h1.w, w1, true);
                    ((u32x2*)(H8 + (size_t)(mrow + r) * DM))[lane + 64 * j] = (u32x2){(unsigned)w0, (unsigned)w1};
                    const int chunk = lane + 64 * j;
                    *(LAS u32x4*)(HTw + r * 2048 + ((chunk ^ r) << 4)) = (u32x4){pk2(h0.x, h0.y), pk2(h0.z, h0.w), pk2(h1.x, h1.y), pk2(h1.z, h1.w)};
                }
            }
            f32x4 acc0 = {0.f, 0.f, 0.f, 0.f}, acc1 = {0.f, 0.f, 0.f, 0.f};
#pragma unroll 4
            for (int ks = 0; ks < 32; ++ks) {
                const int chunk = 4 * ks + fq;
                bf16x8 af = {0, 0, 0, 0, 0, 0, 0, 0};
                if (fr < 4) af = *(const LAS bf16x8*)(HTw + fr * 2048 + ((chunk ^ fr) << 4));
                const bf16x8 b0 = *(const LAS bf16x8*)(L + R2_WR + fr * 2048 + (((chunk & ~15) | ((chunk ^ fr) & 15)) << 4));
                const bf16x8 b1 = *(const LAS bf16x8*)(L + R2_WR + (16 + fr) * 2048 + (((chunk & ~15) | ((chunk ^ (16 + fr)) & 15)) << 4));
                acc0 = MFMA16(af, b0, acc0); acc1 = MFMA16(af, b1, acc1);
            }
            if (fq == 0) {
                const float br0 = a.b_router[fr], br1 = a.b_router[16 + fr];
#pragma unroll
                for (int r = 0; r < 4; ++r) { LG[(size_t)(mrow + r) * NE + fr] = acc0[r] + br0; LG[(size_t)(mrow + r) * NE + 16 + fr] = acc1[r] + br1; }
            }
        }
        asm volatile("s_waitcnt vmcnt(0)" ::: "memory");
        if (lane < 16) {
            const int mr = blk * 128 + w * 16 + lane;
            float v[32];
#pragma unroll
            for (int q = 0; q < 8; ++q) { const f32x4 t = *(const f32x4*)(LG + (size_t)mr * NE + 4 * q); v[4 * q] = t.x; v[4 * q + 1] = t.y; v[4 * q + 2] = t.z; v[4 * q + 3] = t.w; }
            int ei[4]; float ev[4];
#pragma unroll
            for (int k = 0; k < 4; ++k) {
                float best = -INFINITY; int bi = 0;
#pragma unroll
                for (int j = 0; j < 32; ++j) { if (v[j] > best) { best = v[j]; bi = j; } }
                ei[k] = bi; ev[k] = best;
#pragma unroll
                for (int j = 0; j < 32; ++j) if (j == bi) v[j] = -INFINITY;
            }
            float wv[4]; float sum = 0.f;
#pragma unroll
            for (int k = 0; k < 4; ++k) { wv[k] = __expf(ev[k] - ev[0]); sum += wv[k]; }
            const float inv = 1.0f / sum;
            LAS int* tp = (LAS int*)(L + R2_TOP) + (w * 16 + lane) * 8;
#pragma unroll
            for (int k = 0; k < 4; ++k) { tp[k] = ei[k]; ((LAS float*)tp)[4 + k] = wv[k] * inv; }
        }
        __syncthreads();
        {
            const int tok = tid_o >> 2, kk = tid_o & 3, m = blk * 128 + tok;
            const LAS int* tp = (const LAS int*)(L + R2_TOP) + tok * 8;
            const int e = tp[kk]; const float wk = ((const LAS float*)tp)[4 + kk];
            const int lrank = atomicAdd((int*)(lcnt + e), 1);
            __syncthreads();
            if (tid_o < 32) gbase[tid_o] = atomicAdd(cnt + 64 * tid_o, lcnt[tid_o]);
            __syncthreads();
            const int rank = gbase[e] + lrank;
            list[(size_t)e * LIST_CAP + rank] = m;
            route[(size_t)m * 12 + kk] = e; route[(size_t)m * 12 + 4 + kk] = rank; ((float*)route)[(size_t)m * 12 + 8 + kk] = wk;
        }
    }
}

__device__ __forceinline__ int moe_tables(const Args& a, const Ctx& X, pg8::MoeTab& T) {
    LAS int* tp = (LAS int*)(X.lds + LDS_MISC); LAS int* cn = (LAS int*)(X.lds + LDS_MISC + 256);
    const int* cnt = (const int*)(a.ws + WS_CTL + CTL_CNT);
    __syncthreads();
    LAS int* te = (LAS int*)(X.lds + 131072);
    if (X.tid < 64) {
        const int e = X.tid & 31; const int c = cnt[64 * e];
        int incl = (c + 255) >> 8;
#pragma unroll
        for (int o = 1; o < 32; o <<= 1) { const int up = __shfl_up(incl, o, 64); if ((X.tid & 63) >= o) incl += up; }
        if (X.tid < 32) { cn[e] = c; tp[e + 1] = incl; if (e == 0) tp[0] = 0; }
    }
    __syncthreads();
    for (int pm = X.tid; pm < tp[NE]; pm += 512) { int e = 0;
#pragma unroll
        for (int k = 1; k < NE; ++k) e += (tp[k] <= pm) ? 1 : 0;
        te[pm] = e; }
    __syncthreads();
    T.tp = tp; T.cnt = cn; T.te = te;
    return tp[NE];
}

__device__ __forceinline__ int moe_tables_reuse(const Ctx& X, pg8::MoeTab& T) {
    T.tp = (LAS int*)(X.lds + LDS_MISC); T.cnt = (LAS int*)(X.lds + LDS_MISC + 256); T.te = (LAS int*)(X.lds + 131072);
    __syncthreads();
    return T.tp[NE];
}

struct RouteRec { int e[4], rank[4]; float w[4]; };
__device__ __forceinline__ void combine_route(RouteRec& q, const Args& a, const Ctx& X, int m) {
    const int gw = X.bid * 8 + X.wave; const int* rp = (const int*)(a.ws + WS_ROUTE) + (size_t)(m < NTOK ? m : gw) * 12;
#pragma unroll
    for (int k = 0; k < 4; ++k) { q.e[k] = rp[k]; q.rank[k] = rp[4 + k]; q.w[k] = ((const float*)rp)[8 + k]; }
}
__device__ __forceinline__ void combine_pre(const Args& a, const Ctx& X, RouteRec& q0, RouteRec& q1) {
    const int gw = X.bid * 8 + X.wave, NGW = X.G * 8;
    combine_route(q0, a, X, gw);
    asm volatile("" ::: "memory");
    combine_route(q1, a, X, gw + NGW);
    asm volatile("" ::: "memory");
}
__device__ __forceinline__ void phase_combine(const Args& a, const Ctx& X, RouteRec& q0, RouteRec& q1) {
    unsigned char* ws = a.ws; pg8::MoeTab T; (void)moe_tables_reuse(X, T);
    const bf16_t* X1 = (const bf16_t*)(ws + WS_X1); const unsigned char* Y = ws + WS_Y; const int* route = (const int*)(ws + WS_ROUTE); const float* mod = (const float*)(ws + WS_MOD);
    const int gw = X.bid * 8 + X.wave, NGW = X.G * 8;
    struct RowDat { int y[4][4]; u32x2 xr[4]; f32x4 g2[4]; float w[4]; };
    f32x4 nfv[4];
#pragma unroll
    for (int j = 0; j < 4; ++j) nfv[j] = ((const f32x4*)a.norm_f_w)[X.lane + 64 * j];
    auto clampm = [&](int m) { return m < NTOK ? m : gw; };
    auto load_route = [&](RouteRec& q, int m) { combine_route(q, a, X, m); };
    auto load_row = [&](RowDat& d, const RouteRec& q, int m) {
        const int mc = clampm(m), b = mc / SEQ;
#pragma unroll
        for (int k = 0; k < 4; ++k) {
            const size_t slot = (size_t)T.tp[q.e[k]] * 256 + q.rank[k];
            const unsigned* yp = (const unsigned*)(Y + slot * DM) + X.lane;
#pragma unroll
            for (int j = 0; j < 4; ++j) d.y[k][j] = (int)yp[64 * j];
            d.w[k] = q.w[k];
        }
        const u32x2* xr = (const u32x2*)(X1 + (size_t)mc * DM) + X.lane;
        const f32x4* g2 = (const f32x4*)(mod + (size_t)b * 6144 + 5 * DM) + X.lane;
#pragma unroll
        for (int j = 0; j < 4; ++j) { d.xr[j] = xr[64 * j]; d.g2[j] = g2[64 * j]; }
    };
    auto finish_row = [&](const RowDat& d, int m) {
        f32x4 acc[4] = {{0, 0, 0, 0}, {0, 0, 0, 0}, {0, 0, 0, 0}, {0, 0, 0, 0}};
#pragma unroll
        for (int k = 0; k < 4; ++k) { const float w = d.w[k];
#pragma unroll
            for (int j = 0; j < 4; ++j) { const int t = d.y[k][j]; const f32x2 lo = __builtin_amdgcn_cvt_pk_f32_fp8(t, false), hi = __builtin_amdgcn_cvt_pk_f32_fp8(t, true);
                acc[j].x += w * lo.x; acc[j].y += w * lo.y; acc[j].z += w * hi.x; acc[j].w += w * hi.y; } }
        f32x4 v[4]; float ss = 0.f;
#pragma unroll
        for (int j = 0; j < 4; ++j) { const u32x2 t = d.xr[j]; v[j] = (f32x4){bflo(t.x), bfhi(t.x), bflo(t.y), bfhi(t.y)} + d.g2[j] * acc[j]; ss += (v[j].x * v[j].x + v[j].y * v[j].y) + (v[j].z * v[j].z + v[j].w * v[j].w); }
        const float rstd = __builtin_amdgcn_rsqf(wave_sum(ss) * (1.f / DM) + EPS);
        f32x4* orow = (f32x4*)(a.out + (size_t)m * DM) + X.lane;
#pragma unroll
        for (int j = 0; j < 4; ++j) orow[64 * j] = v[j] * rstd * nfv[j];
    };
    RowDat d0, d1;
    load_row(d0, q0, gw);
    for (int m = gw; ; ) {
        load_route(q0, m + 2 * NGW); load_row(d1, q1, m + NGW); finish_row(d0, m); m += NGW; if (m >= NTOK) break;
        load_route(q1, m + 2 * NGW); load_row(d0, q0, m + NGW); finish_row(d1, m); m += NGW; if (m >= NTOK) break;
    }
}


#define XB_TMO      128
#define XB_XCNT(j)  (256  + 64 * (j))
#define XB_XSUB(j)  (1280 + 64 * (j))
#define XB_XGEN(j)  (2304 + 64 * (j))
#define XB_TOP      3328
#define XB_TOPGEN   3392
#define XCD_BAR_WORDS 3456
#define XB_SPIN_CAP (1u << 18)
__device__ __forceinline__ unsigned xb_ld(unsigned* p)              { return __hip_atomic_load(p, __ATOMIC_RELAXED, __HIP_MEMORY_SCOPE_AGENT); }
__device__ __forceinline__ unsigned xb_add(unsigned* p, unsigned v) { return __hip_atomic_fetch_add(p, v, __ATOMIC_RELAXED, __HIP_MEMORY_SCOPE_AGENT); }
__device__ __forceinline__ unsigned xb_xcc_id() { return (unsigned)__builtin_amdgcn_s_getreg((3 << 11) | 20) & 0xFu; }
#define XB_SPIN(cond, bar) do { unsigned _sp = 0; while (cond) { __builtin_amdgcn_s_sleep(1); \
    if ((++_sp & 255u) == 0u) { if (xb_ld(&(bar)[XB_TMO])) break; if (_sp > XB_SPIN_CAP) { atomicAdd(&(bar)[XB_TMO], 1u); break; } } } } while (0)
#define XB_EXIT     3456
__device__ unsigned g_barw[XCD_BAR_WORDS + 64];
struct XcdBarrier { unsigned* bar; unsigned x; volatile LAS unsigned* st; };
__device__ __forceinline__ XcdBarrier xcd_barrier_post(unsigned* bar, volatile LAS unsigned* st) {
    XcdBarrier b; b.bar = bar; b.x = xb_xcc_id(); b.st = st;
    if (threadIdx.x == 0) (void)xb_add(&bar[XB_XCNT(b.x)], 1u);
    return b;
}
__device__ __forceinline__ void xcd_barrier_complete(unsigned* bar, unsigned x, unsigned& nloc, unsigned& nx) {
    const unsigned G = gridDim.x * gridDim.y * gridDim.z;
    unsigned sum, cnt, mine, sp = 0u;
    for (;;) {
        sum = 0u; cnt = 0u; mine = 0u;
#pragma unroll
        for (unsigned j = 0; j < 16; ++j) { const unsigned c = xb_ld(&bar[XB_XCNT(j)]); sum += c; cnt += (c > 0u) ? 1u : 0u; mine = (j == x) ? c : mine; }
        if (sum == G) break;
        __builtin_amdgcn_s_sleep(1);
        if ((++sp & 255u) == 0u) { if (xb_ld(&bar[XB_TMO])) break; if (sp > XB_SPIN_CAP) { atomicAdd(&bar[XB_TMO], 1u); break; } }
    }
    nloc = mine > 0u ? mine : 1u; nx = cnt > 0u ? cnt : 1u;
}
__device__ __forceinline__ unsigned xcd_barrier_arrive(const XcdBarrier& b) {
    asm volatile("s_waitcnt vmcnt(0)" ::: "memory");
    __syncthreads();
    unsigned tok = ~0u;
    if (threadIdx.x == 0) {
        unsigned* bar = b.bar;
        __builtin_amdgcn_s_waitcnt(0);
        unsigned nloc = b.st[0], nx = b.st[1];
        if (nloc == 0u) { xcd_barrier_complete(bar, b.x, nloc, nx); b.st[0] = nloc; b.st[1] = nx; }
        const unsigned old = xb_add(&bar[XB_XSUB(b.x)], 1u);
        const unsigned gen = old / nloc;
        if (old + 1u == (gen + 1u) * nloc) {
            __builtin_amdgcn_fence(__ATOMIC_RELEASE, "agent");
            asm volatile("s_waitcnt vmcnt(0)" ::: "memory");
            const unsigned og = xb_add(&bar[XB_TOP], 1u);
            const unsigned tg = og / nx;
            __builtin_amdgcn_fence(__ATOMIC_ACQUIRE, "agent");
            if (og + 1u == (tg + 1u) * nx) xb_add(&bar[XB_TOPGEN], 1u);
            else XB_SPIN(xb_ld(&bar[XB_TOPGEN]) == tg, bar);
            xb_add(&bar[XB_XGEN(b.x)], 1u);
            asm volatile("s_waitcnt vmcnt(0)" ::: "memory");
        } else {
            tok = gen;
            __builtin_amdgcn_fence(__ATOMIC_ACQUIRE, "agent");
        }
    }
    return tok;
}
__device__ __forceinline__ void xcd_barrier_wait(const XcdBarrier& b, unsigned tok) {
    if (threadIdx.x == 0 && tok != ~0u) {
        unsigned* bar = b.bar;
        XB_SPIN(xb_ld(&bar[XB_XGEN(b.x)]) == tok, bar);
        asm volatile("s_waitcnt vmcnt(0)" ::: "memory");
    }
    __syncthreads();
}
__device__ __forceinline__ void xcd_barrier(const XcdBarrier& b) {
    asm volatile("s_waitcnt vmcnt(0)" ::: "memory");
    __syncthreads();
    if (threadIdx.x == 0) {
        unsigned* bar = b.bar;
        __builtin_amdgcn_s_waitcnt(0);
        unsigned nloc = b.st[0], nx = b.st[1];
        if (nloc == 0u) { xcd_barrier_complete(bar, b.x, nloc, nx); b.st[0] = nloc; b.st[1] = nx; }
        const unsigned old = xb_add(&bar[XB_XSUB(b.x)], 1u);
        const unsigned gen = old / nloc;
        if (old + 1u == (gen + 1u) * nloc) {
            __builtin_amdgcn_fence(__ATOMIC_RELEASE, "agent");
            asm volatile("s_waitcnt vmcnt(0)" ::: "memory");
            const unsigned og = xb_add(&bar[XB_TOP], 1u);
            const unsigned tg = og / nx;
            __builtin_amdgcn_fence(__ATOMIC_ACQUIRE, "agent");
            if (og + 1u == (tg + 1u) * nx) xb_add(&bar[XB_TOPGEN], 1u);
            else XB_SPIN(xb_ld(&bar[XB_TOPGEN]) == tg, bar);
            xb_add(&bar[XB_XGEN(b.x)], 1u);
            asm volatile("s_waitcnt vmcnt(0)" ::: "memory");
        } else {
            __builtin_amdgcn_fence(__ATOMIC_ACQUIRE, "agent");
            XB_SPIN(xb_ld(&bar[XB_XGEN(b.x)]) == gen, bar);
            asm volatile("s_waitcnt vmcnt(0)" ::: "memory");
        }
    }
    __syncthreads();
}

enum { PH_PREP0 = 0, PH_ROWS1, PH_PROJ, PH_GMLP, PH_CONV, PH_SCAN, PH_OPASS, PH_MIX, PH_ROWS2, PH_ROUTER, PH_ROUTE, PH_MOE1, PH_MOE2, PH_COMBINE, PH_COUNT };

__global__ void __launch_bounds__(512, 2) mega(Args a) {
    extern __shared__ __attribute__((aligned(16))) unsigned char lds_raw[];
    Ctx X; X.lds = (LAS unsigned char*)lds_raw; X.tid = threadIdx.x; X.lane = X.tid & 63; X.wave = __builtin_amdgcn_readfirstlane(X.tid >> 6); X.G = gridDim.x; X.bid = blockIdx.x;
    unsigned char* ws = a.ws;
#if SINGLE_LAUNCH
    if (X.tid < 2) ((volatile LAS unsigned*)(X.lds + LDS_BARST))[X.tid] = 0u;
    __syncthreads();
    const XcdBarrier xbar = xcd_barrier_post(g_barw, (volatile LAS unsigned*)(X.lds + LDS_BARST));
#define SEAM(k) do { if (a.ph_lo <= (k) && (k) + 1 < a.ph_hi) { xcd_barrier(xbar); } } while (0)
#define SEAM_PRE(k, pre) do { if (a.ph_lo <= (k) && (k) + 1 < a.ph_hi) { const unsigned tok_ = xcd_barrier_arrive(xbar); pre; xcd_barrier_wait(xbar, tok_); } else { __syncthreads(); pre; } } while (0)
#else
#define SEAM(k) do { } while (0)
#define SEAM_PRE(k, pre) do { __syncthreads(); pre; } while (0)
#endif
#ifndef PHMASK
#define PHMASK 0xffffffffu
#endif
#ifndef TIMEPH
#define TIMEPH -1
#endif
#ifdef SUBPROBE
#define SUBADD(v) do { tp_acc += (v); } while (0)
#else
#define SUBADD(v) do { (void)(v); } while (0)
#endif
    unsigned long long tp_acc = 0, tp_t0 = 0;
#define TSTART(k) do { if ((k) == TIMEPH) tp_t0 = __builtin_amdgcn_s_memrealtime(); } while (0)
#ifdef TIMEPRE
#define TSTOP(k) do { } while (0)
#define TSTOP_PRE(k) do { if ((k) == TIMEPH) tp_acc += __builtin_amdgcn_s_memrealtime() - tp_t0; } while (0)
#else
#define TSTOP(k) do { if ((k) == TIMEPH) tp_acc += __builtin_amdgcn_s_memrealtime() - tp_t0; } while (0)
#define TSTOP_PRE(k) do { } while (0)
#endif
#define IN(k) (((PHMASK >> (k)) & 1u) && a.ph_lo <= (k) && (k) < a.ph_hi)
#ifndef REPMASK
#define REPMASK 0u
#endif
#define REP2(k, body) body if (((REPMASK) >> (k)) & 1u) { Ctx X0 = X; asm volatile("" : "+v"(X0.tid), "+v"(X0.lane), "+s"(X0.wave), "+s"(X0.bid)); const Ctx& X = X0; body }
#define BODY_PROJ { __syncthreads(); pg8::DenseSchedT<1024> S; S.init(ws + WS_H, ws + WS_WINT, NTOK, PROJ_N, X.G, X.bid); pg8::EpiProj E{(bf16_t*)(ws + WS_PROJ)}; pg8::gemm_phase<pg8::EpiProj, pg8::DenseSchedT<1024>, true>(X.lds, S, E); }
#define BODY_MIX { __syncthreads(); pg8::DenseSchedT<1024> S; S.init(ws + WS_MIXIN, ws + WS_WOUTT, NTOK, DM, X.G, X.bid); pg8::EpiMix E{a.x, (const float*)(ws + WS_MOD), (bf16_t*)(ws + WS_X1)}; pg8::gemm_phase<pg8::EpiMix, pg8::DenseSchedT<1024>, true>(X.lds, S, E); }
#define BODY_MOE1 { pg8::MoeTab T; const int nM = moe_tables(a, X, T); pg8::Moe1Sched<1024> S; S.init(ws + WS_H8, ws + WS_WGUT, (const int*)(ws + WS_LIST), T, nM, X.G, X.bid); pg8::EpiAct E{a.b_gu, (unsigned char*)(ws + WS_ACT)}; pg8::gemm_phase<pg8::EpiAct, pg8::Moe1Sched<1024>, true, ALIGN_MOE1>(X.lds, S, E); }
#define BODY_MOE2 { pg8::MoeTab T; const int nM = moe_tables_reuse(X, T); pg8::Moe2Sched<1024> S; S.init(ws + WS_ACT, ws + WS_WDT, T, nM, X.G, X.bid); pg8::EpiY E{a.b_down, ws + WS_Y}; pg8::gemm_phase<pg8::EpiY, pg8::Moe2Sched<1024>, true, ALIGN_MOE2>(X.lds, S, E); }
    f32x4 r1a[4], r1b[4];
    if (IN(PH_PREP0)) { TSTART(PH_PREP0); REP2(PH_PREP0, { __syncthreads(); phase_prep0(a, X); }) TSTOP_PRE(PH_PREP0); SEAM_PRE(PH_PREP0, rows1_pre(a, X, r1a, r1b)); TSTOP(PH_PREP0); }
    if (IN(PH_ROWS1)) { TSTART(PH_ROWS1); { __syncthreads(); if (a.ph_lo == PH_ROWS1) { rows1_pre(a, X, r1a, r1b); __syncthreads(); } phase_rows1(a, X, r1a, r1b); } TSTOP_PRE(PH_ROWS1); SEAM(PH_ROWS1); TSTOP(PH_ROWS1); }
    if (IN(PH_PROJ)) { TSTART(PH_PROJ); REP2(PH_PROJ, BODY_PROJ) TSTOP_PRE(PH_PROJ); SEAM_PRE(PH_PROJ, stepa_pre(a, X)); TSTOP(PH_PROJ); }
    if (IN(PH_CONV)) { TSTART(PH_CONV); REP2(PH_CONV, { phase_stepa(a, X); }) TSTOP_PRE(PH_CONV); SEAM(PH_CONV); TSTOP(PH_CONV); }
    if (IN(PH_SCAN)) { TSTART(PH_SCAN); REP2(PH_SCAN, { unsigned long long sub_ = 0; phase_scan(a, X, sub_); SUBADD(sub_); }) TSTOP_PRE(PH_SCAN); SEAM(PH_SCAN); TSTOP(PH_SCAN); }
    if (IN(PH_OPASS)) { TSTART(PH_OPASS); REP2(PH_OPASS, { phase_opass(a, X); }) TSTOP_PRE(PH_OPASS); SEAM(PH_OPASS); TSTOP(PH_OPASS); }
    if (IN(PH_MIX)) { TSTART(PH_MIX); REP2(PH_MIX, BODY_MIX) TSTOP_PRE(PH_MIX); SEAM_PRE(PH_MIX, router2_pre(a, X)); TSTOP(PH_MIX); }
    if (IN(PH_ROWS2)) { TSTART(PH_ROWS2); REP2(PH_ROWS2, { phase_router2(a, X); }) TSTOP_PRE(PH_ROWS2); SEAM(PH_ROWS2); TSTOP(PH_ROWS2); }
    if (IN(PH_MOE1)) { TSTART(PH_MOE1); REP2(PH_MOE1, BODY_MOE1) TSTOP_PRE(PH_MOE1); SEAM(PH_MOE1); TSTOP(PH_MOE1); }
    RouteRec cq0, cq1;
    if (IN(PH_MOE2)) { TSTART(PH_MOE2); REP2(PH_MOE2, BODY_MOE2) TSTOP_PRE(PH_MOE2); SEAM_PRE(PH_MOE2, combine_pre(a, X, cq0, cq1)); TSTOP(PH_MOE2); }
    if (IN(PH_COMBINE)) { TSTART(PH_COMBINE); { if (a.ph_lo == PH_COMBINE) combine_pre(a, X, cq0, cq1); phase_combine(a, X, cq0, cq1); } TSTOP(PH_COMBINE); }
#ifdef ROWS_PROBE
    { xcd_barrier(xbar); tp_t0 = __builtin_amdgcn_s_memrealtime(); __syncthreads(); rows1_pre(a, X, r1a, r1b); phase_rows1(a, X, r1a, r1b); xcd_barrier(xbar); tp_acc += __builtin_amdgcn_s_memrealtime() - tp_t0; }
#endif
#ifdef GEMM_PROBE
    { xcd_barrier(xbar); tp_t0 = __builtin_amdgcn_s_memrealtime();
      pg8::DenseSched S; S.init(ws + WS_H, ws + WS_WINT, NTOK, PROJ_N, X.G, X.bid); S.same_tile = (GEMM_PROBE == 2); pg8::EpiProj E{(bf16_t*)(ws + WS_PROJ)}; pg8::gemm_phase(X.lds, S, E);
      xcd_barrier(xbar); tp_acc += __builtin_amdgcn_s_memrealtime() - tp_t0; }
#endif
#ifndef TIMEBLK
#define TIMEBLK 0
#endif
#if defined(GEMM_PROBE) || defined(ROWS_PROBE) || defined(SUBPROBE)
    if (X.bid == TIMEBLK) {
#else
    if (TIMEPH >= 0 && X.bid == TIMEBLK) {
#endif
        const unsigned long long t1 = __builtin_amdgcn_s_memrealtime(); while (__builtin_amdgcn_s_memrealtime() - t1 < 8ull * tp_acc) __builtin_amdgcn_s_sleep(8); }
#if SINGLE_LAUNCH
    {
        volatile LAS unsigned* st = (volatile LAS unsigned*)(X.lds + LDS_BARST);
        __syncthreads();
        if (X.tid == 0) st[0] = (xb_add(&g_barw[XB_EXIT], 1u) + 1u == (unsigned)X.G) ? 1u : 0u;
        __syncthreads();
        if (st[0]) { for (int i = X.tid; i < XCD_BAR_WORDS + 64; i += 512) g_barw[i] = 0u; }
    }
#endif
#undef IN
#undef SEAM
#undef REP2
}

extern "C" void kernel_launch(void* const* d_in, const int* in_sizes, int n_in, void* d_out, int out_size, void* d_ws, size_t ws_size, hipStream_t stream) {
    static int grid = 0;
    if (grid == 0) {
        if (n_in != 22 || out_size != NTOK * DM || ws_size < WS_END) { fprintf(stderr, "kernel_launch: unexpected shapes (n_in %d out %d ws %zu)\n", n_in, out_size, ws_size); grid = -1; return; }
        int dev = 0, cus = 0, per_cu = 0;
        (void)hipGetDevice(&dev); (void)hipDeviceGetAttribute(&cus, hipDeviceAttributeMultiprocessorCount, dev);
        (void)hipFuncSetAttribute((const void*)mega, hipFuncAttributeMaxDynamicSharedMemorySize, LDS_BYTES);
        (void)hipOccupancyMaxActiveBlocksPerMultiprocessor(&per_cu, (const void*)mega, 512, LDS_BYTES);
        if (per_cu < 1) { fprintf(stderr, "kernel_launch: occupancy query says %d blocks per CU\n", per_cu); }
        (void)hipGetLastError();
        grid = cus > 0 ? cus : 256;
    }
    if (grid < 0) return;
#if !SINGLE_LAUNCH
    (void)hipMemsetAsync((char*)d_ws + WS_CTL, 0, CTL_ZERO, stream);
#endif
    Args a{};
    const float** p = (const float**)&a;
    for (int i = 0; i < 22; ++i) p[i] = (const float*)d_in[i];
    a.out = (float*)d_out; a.ws = (unsigned char*)d_ws;
#if SINGLE_LAUNCH
    a.ph_lo = 0; a.ph_hi = PH_COUNT;
    void* args[] = {&a};
    hipError_t e = hipLaunchCooperativeKernel((const void*)mega, dim3(grid), dim3(512), args, LDS_BYTES, stream);
    if (e != hipSuccess) fprintf(stderr, "cooperative launch failed: %s (grid %d)\n", hipGetErrorString(e), grid);
#else
    for (int ph = 0; ph < PH_COUNT; ++ph) { a.ph_lo = ph; a.ph_hi = ph + 1; hipLaunchKernelGGL(mega, dim3(grid), dim3(512), LDS_BYTES, stream, a); }
#endif
}
```
